# Optimizing an MI355X kernel written in HIP

```python
import math
import jax, jax.numpy as jnp
from jax import lax
import numpy as np

D_MODEL = 1024
BATCH = 2
SEQ = 16384
DEPTH = 2
DEC_BATCH = 16
DEC_SEQ = 32
PAST_LEN = 4096

CHUNK = 64
POOL_WIDTH = 512
POOL_WINDOWS = (2, 4, 8, 16)
POOL_GROUP = POOL_WIDTH // 4
POOL_HIST = 16 - 1
SSM_WIDTH = 512
SSM_GROUP = 16
SSM_GROUPS = SSM_WIDTH // SSM_GROUP
SSM_STATE = 64
SSM_BLOCK = 128
CONV_WIDTH = 512
CONV_K = 3
N_HEADS = 8
QK_HEAD_DIM = 64
V_HEAD_DIM = 2 * QK_HEAD_DIM
QK_WIDTH = N_HEADS * 2 * QK_HEAD_DIM
ATTN_WIDTH = N_HEADS * V_HEAD_DIM
ROT_DIM = QK_HEAD_DIM // 4
ROPE_THETA = 500000.0
Q_BLOCK = 128
N_BRANCH = 4
BRANCH_WIDTH = POOL_WIDTH + SSM_WIDTH + CONV_WIDTH + ATTN_WIDTH
IN_WIDTH = POOL_WIDTH + SSM_WIDTH + 3 * CONV_WIDTH + 2 * QK_WIDTH + ATTN_WIDTH + N_BRANCH * D_MODEL
D_FF = 4 * D_MODEL
DEEPNORM_ALPHA = (2 * DEPTH) ** 0.25
DEEPNORM_BETA = (8 * DEPTH) ** -0.25
LN_EPS = 1e-5

kernel_name = "hybrid_streaming_encoder_step"

F32 = jnp.float32


def _offsets(widths):
    return [int(o) for o in np.cumsum(widths)[:-1]]


def layer_norm(x, g, b):
    xf = x.astype(F32)
    mu = jnp.mean(xf, -1, keepdims=True)
    var = jnp.mean(jnp.square(xf - mu), -1, keepdims=True)
    return ((xf - mu) * lax.rsqrt(var + LN_EPS) * g.astype(F32) + b.astype(F32)).astype(x.dtype)


def pool_mixer(z, hist, pos, pool_w, pool_scale):
    L = z.shape[1]
    zp = jnp.concatenate([hist.astype(z.dtype), z], axis=1)
    cs = jnp.pad(jnp.cumsum(zp.astype(F32), axis=1), ((0, 0), (1, 0), (0, 0)))
    outs = []
    for g, w in enumerate(POOL_WINDOWS):
        sl = slice(g * POOL_GROUP, (g + 1) * POOL_GROUP)
        hi = cs[:, POOL_HIST + 1:POOL_HIST + 1 + L, sl]
        lo = cs[:, POOL_HIST + 1 - w:POOL_HIST + 1 - w + L, sl]
        cnt = jnp.minimum(w, pos + 1).astype(F32)
        u = (hi - lo) / cnt[None, :, None] - z[..., sl].astype(F32)
        outs.append(jnp.einsum('blc,cd->bld', u, pool_w[g].astype(F32)))
    out = jnp.concatenate(outs, axis=-1) * pool_scale.astype(F32)
    return out.astype(z.dtype), zp[:, -POOL_HIST:]


def _cmul_scan(e1, e2):
    a1r, a1i, b1r, b1i = e1
    a2r, a2i, b2r, b2i = e2
    return (a2r * a1r - a2i * a1i, a2r * a1i + a2i * a1r,
            a2r * b1r - a2i * b1i + b2r, a2r * b1i + a2i * b1r + b2i)


def s5_mixer(u, h_re, h_im, a_re, a_im, log_dt, b_re, b_im, c_re, c_im, d_skip, w_glu):
    bt, L, _ = u.shape
    uf = u.astype(F32).reshape(bt, L, SSM_GROUPS, SSM_GROUP)
    a_re = a_re.astype(F32); a_im = a_im.astype(F32)
    dt = jnp.exp(log_dt.astype(F32))[:, None]
    mag = jnp.exp(a_re * dt)
    ab_re = mag * jnp.cos(a_im * dt); ab_im = mag * jnp.sin(a_im * dt)
    den = a_re * a_re + a_im * a_im
    cr = ((ab_re - 1.0) * a_re + ab_im * a_im) / den
    ci = (ab_im * a_re - (ab_re - 1.0) * a_im) / den
    b_re = b_re.astype(F32); b_im = b_im.astype(F32)
    bb_re = cr[..., None] * b_re - ci[..., None] * b_im
    bb_im = cr[..., None] * b_im + ci[..., None] * b_re
    cm_re = c_re.astype(F32); cm_im = c_im.astype(F32)
    blk = min(SSM_BLOCK, L)
    nb = L // blk
    ub = jnp.swapaxes(uf.reshape(bt, nb, blk, SSM_GROUPS, SSM_GROUP), 0, 1)

    def step(carry, u_blk):
        s_re, s_im = carry
        bu_re = jnp.einsum('blgn,gpn->blgp', u_blk, bb_re)
        bu_im = jnp.einsum('blgn,gpn->blgp', u_blk, bb_im)
        a_r = jnp.broadcast_to(ab_re, bu_re.shape)
        a_i = jnp.broadcast_to(ab_im, bu_im.shape)
        pa_re, pa_im, sb_re, sb_im = lax.associative_scan(_cmul_scan, (a_r, a_i, bu_re, bu_im), axis=1)
        st_re = sb_re + pa_re * s_re[:, None] - pa_im * s_im[:, None]
        st_im = sb_im + pa_re * s_im[:, None] + pa_im * s_re[:, None]
        y = jnp.einsum('blgp,gnp->blgn', st_re, cm_re) - jnp.einsum('blgp,gnp->blgn', st_im, cm_im)
        return (st_re[:, -1], st_im[:, -1]), y

    (n_re, n_im), yb = lax.scan(step, (h_re.astype(F32), h_im.astype(F32)), ub)
    y = jnp.swapaxes(yb, 0, 1).reshape(bt, L, SSM_WIDTH) + d_skip.astype(F32) * uf.reshape(bt, L, SSM_WIDTH)
    v = jax.nn.gelu(y).astype(u.dtype)
    out = v * jax.nn.sigmoid((v @ w_glu).astype(F32)).astype(u.dtype)
    return out, n_re, n_im


def short_conv_mixer(h, b, c, hist, conv_w, conv_b):
    L = h.shape[1]
    z = c * h
    zp = jnp.concatenate([hist.astype(z.dtype), z], axis=1)
    y = conv_b + zp[:, 0:L] * conv_w[0]
    for i in range(1, CONV_K):
        y = y + zp[:, i:i + L] * conv_w[i]
    return b * y, zp[:, -(CONV_K - 1):]


def partial_rope(x, pos):
    half = ROT_DIM // 2
    inv = ROPE_THETA ** (-jnp.arange(0, ROT_DIM, 2, dtype=F32) / ROT_DIM)
    ang = pos.astype(F32)[:, None] * inv[None, :]
    cos = jnp.cos(ang)[None, :, None, None, :]
    sin = jnp.sin(ang)[None, :, None, None, :]
    xr = x[..., :ROT_DIM].astype(F32)
    x1, x2 = xr[..., :half], xr[..., half:]
    rot = jnp.concatenate([x1 * cos - x2 * sin, x2 * cos + x1 * sin], axis=-1).astype(x.dtype)
    return jnp.concatenate([rot, x[..., ROT_DIM:]], axis=-1)


def diff_attn_core(q, k, v, q_pos, k_pos, lam):
    s = jnp.einsum('bqhcd,bkhcd->bchqk', q, k, preferred_element_type=F32) * (QK_HEAD_DIM ** -0.5)
    visible = k_pos[None, :] < ((q_pos // CHUNK + 1) * CHUNK)[:, None]
    p = jax.nn.softmax(jnp.where(visible, s, -jnp.inf), axis=-1)
    a = p[:, 0] - lam * p[:, 1]
    return jnp.einsum('bhqk,bkhe->bqhe', a.astype(v.dtype), v)


def blocked_diff_attention(q, k, v, q_pos, k_pos, lam):
    bt, L = q.shape[0], q.shape[1]
    if L <= Q_BLOCK or L % Q_BLOCK:
        return diff_attn_core(q, k, v, q_pos, k_pos, lam)
    nb = L // Q_BLOCK
    qb = jnp.swapaxes(q.reshape(bt, nb, Q_BLOCK, N_HEADS, 2, QK_HEAD_DIM), 0, 1)
    pb = q_pos.reshape(nb, Q_BLOCK)
    ob = lax.map(lambda qp: diff_attn_core(qp[0], k, v, qp[1], k_pos, lam), (qb, pb))
    return jnp.swapaxes(ob, 0, 1).reshape(bt, L, N_HEADS, V_HEAD_DIM)


def trunk_layer(x, pos0, hist_pool, hist_conv, h_re, h_im, past_k, past_v, p, layer_idx):
    bt, L, _ = x.shape
    q_pos = pos0 + jnp.arange(L, dtype=jnp.int32)
    proj = x @ p['w_in']
    z_pool, u_ssm, h_conv, b_conv, c_conv, q, k, v, g = jnp.split(
        proj, _offsets([POOL_WIDTH, SSM_WIDTH, CONV_WIDTH, CONV_WIDTH, CONV_WIDTH,
                        QK_WIDTH, QK_WIDTH, ATTN_WIDTH, N_BRANCH * D_MODEL]), axis=-1)
    o_pool, new_pool = pool_mixer(z_pool, hist_pool, q_pos, p['pool_w'], p['pool_scale'])
    o_ssm, new_re, new_im = s5_mixer(u_ssm, h_re, h_im, p['ssm_a_re'], p['ssm_a_im'], p['ssm_log_dt'],
                                     p['ssm_b_re'], p['ssm_b_im'], p['ssm_c_re'], p['ssm_c_im'],
                                     p['ssm_d'], p['ssm_w_glu'])
    o_conv, new_conv = short_conv_mixer(h_conv, b_conv, c_conv, hist_conv, p['conv_w'], p['conv_b'])
    q = partial_rope(q.reshape(bt, L, N_HEADS, 2, QK_HEAD_DIM), q_pos)
    k = partial_rope(k.reshape(bt, L, N_HEADS, 2, QK_HEAD_DIM), q_pos)
    v = v.reshape(bt, L, N_HEADS, V_HEAD_DIM)
    if past_k is None:
        k_all, v_all = k, v
    else:
        k_all = jnp.concatenate([past_k.astype(k.dtype), k], axis=1)
        v_all = jnp.concatenate([past_v.astype(v.dtype), v], axis=1)
    k_pos = jnp.arange(k_all.shape[1], dtype=jnp.int32)
    lam_init = 0.8 - 0.6 * math.exp(-0.3 * layer_idx)
    lam = (jnp.exp(jnp.sum(p['lambda_q1'].astype(F32) * p['lambda_k1'].astype(F32)))
           - jnp.exp(jnp.sum(p['lambda_q2'].astype(F32) * p['lambda_k2'].astype(F32))) + lam_init)
    o = blocked_diff_attention(q, k_all, v_all, q_pos, k_pos, lam).astype(F32)
    o = o * lax.rsqrt(jnp.mean(o * o, -1, keepdims=True) + LN_EPS) * p['subln_w'].astype(F32) * (1.0 - lam_init)
    o_attn = o.reshape(bt, L, ATTN_WIDTH).astype(x.dtype)
    gates = jax.nn.sigmoid(g.astype(F32)).astype(x.dtype).reshape(bt, L, N_BRANCH, D_MODEL)
    wp, ws, wc, wa = jnp.split(p['w_branch'], _offsets([POOL_WIDTH, SSM_WIDTH, CONV_WIDTH, ATTN_WIDTH]), axis=0)
    merged = (gates[:, :, 0] * (o_pool @ wp) + gates[:, :, 1] * (o_ssm @ ws)
              + gates[:, :, 2] * (o_conv @ wc) + gates[:, :, 3] * (o_attn @ wa))
    x = layer_norm(DEEPNORM_ALPHA * x + merged @ p['w_out'], p['ln1_g'], p['ln1_b'])
    hid = jnp.square(jax.nn.relu(x @ p['w_up']))
    x = layer_norm(DEEPNORM_ALPHA * x + hid @ p['w_down'], p['ln2_g'], p['ln2_b'])
    return x, (k, v, new_re, new_im, new_conv, new_pool)


def setup_inputs(seed: int = 0) -> dict:
    key = jax.random.key(seed)
    ks = jax.random.split(key, 40)
    nrm = lambda i, shape, s=1.0: jax.random.normal(ks[i], shape, F32) * s
    branch_scale = jnp.concatenate([jnp.full((POOL_WIDTH + SSM_WIDTH + CONV_WIDTH,), (512.0) ** -0.5, F32),
                                    jnp.full((ATTN_WIDTH,), float(ATTN_WIDTH) ** -0.5, F32)])
    return {
        'x_prompt': nrm(0, (BATCH, SEQ, D_MODEL)),
        'x_sample': nrm(1, (DEC_BATCH, DEC_SEQ, D_MODEL)),
        'cache_k': nrm(2, (DEPTH, DEC_BATCH, PAST_LEN, N_HEADS, 2, QK_HEAD_DIM)),
        'cache_v': nrm(3, (DEPTH, DEC_BATCH, PAST_LEN, N_HEADS, V_HEAD_DIM)),
        'state_ssm_re': nrm(4, (DEPTH, DEC_BATCH, SSM_GROUPS, SSM_STATE), 0.1),
        'state_ssm_im': nrm(5, (DEPTH, DEC_BATCH, SSM_GROUPS, SSM_STATE), 0.1),
        'state_conv': nrm(6, (DEPTH, DEC_BATCH, CONV_K - 1, CONV_WIDTH)),
        'state_pool': nrm(7, (DEPTH, DEC_BATCH, POOL_HIST, POOL_WIDTH)),
        'w_in': nrm(8, (DEPTH, D_MODEL, IN_WIDTH), D_MODEL ** -0.5),
        'pool_w': nrm(9, (DEPTH, 4, POOL_GROUP, POOL_GROUP), POOL_GROUP ** -0.5),
        'pool_scale': 1.0 + nrm(10, (DEPTH, POOL_WIDTH), 0.02),
        'ssm_a_re': -0.5 + nrm(11, (DEPTH, SSM_GROUPS, SSM_STATE), 0.01),
        'ssm_a_im': math.pi * jnp.arange(SSM_STATE, dtype=F32) + nrm(12, (DEPTH, SSM_GROUPS, SSM_STATE), 0.01),
        'ssm_log_dt': jax.random.uniform(ks[13], (DEPTH, SSM_GROUPS), F32, math.log(1e-3), math.log(1e-1)),
        'ssm_b_re': nrm(14, (DEPTH, SSM_GROUPS, SSM_STATE, SSM_GROUP), (2 * SSM_GROUP) ** -0.5),
        'ssm_b_im': nrm(15, (DEPTH, SSM_GROUPS, SSM_STATE, SSM_GROUP), (2 * SSM_GROUP) ** -0.5),
        'ssm_c_re': nrm(16, (DEPTH, SSM_GROUPS, SSM_GROUP, SSM_STATE), SSM_STATE ** -0.5),
        'ssm_c_im': nrm(17, (DEPTH, SSM_GROUPS, SSM_GROUP, SSM_STATE), SSM_STATE ** -0.5),
        'ssm_d': nrm(18, (DEPTH, SSM_WIDTH)),
        'ssm_w_glu': nrm(19, (DEPTH, SSM_WIDTH, SSM_WIDTH), SSM_WIDTH ** -0.5),
        'conv_w': nrm(20, (DEPTH, CONV_K, CONV_WIDTH), CONV_K ** -0.5),
        'conv_b': nrm(21, (DEPTH, CONV_WIDTH), 0.01),
        'lambda_q1': nrm(22, (DEPTH, QK_HEAD_DIM), 0.1),
        'lambda_k1': nrm(23, (DEPTH, QK_HEAD_DIM), 0.1),
        'lambda_q2': nrm(24, (DEPTH, QK_HEAD_DIM), 0.1),
        'lambda_k2': nrm(25, (DEPTH, QK_HEAD_DIM), 0.1),
        'subln_w': 1.0 + nrm(26, (DEPTH, V_HEAD_DIM), 0.02),
        'w_branch': nrm(27, (DEPTH, BRANCH_WIDTH, D_MODEL)) * branch_scale[None, :, None],
        'w_out': nrm(28, (DEPTH, D_MODEL, D_MODEL), D_MODEL ** -0.5 * DEEPNORM_BETA),
        'ln1_g': 1.0 + nrm(29, (DEPTH, D_MODEL), 0.02),
        'ln1_b': nrm(30, (DEPTH, D_MODEL), 0.02),
        'w_up': nrm(31, (DEPTH, D_MODEL, D_FF), D_MODEL ** -0.5),
        'w_down': nrm(32, (DEPTH, D_FF, D_MODEL), D_FF ** -0.5 * DEEPNORM_BETA),
        'ln2_g': 1.0 + nrm(33, (DEPTH, D_MODEL), 0.02),
        'ln2_b': nrm(34, (DEPTH, D_MODEL), 0.02),
    }


def reference(x_prompt, x_sample, cache_k, cache_v, state_ssm_re, state_ssm_im, state_conv, state_pool,
              w_in, pool_w, pool_scale, ssm_a_re, ssm_a_im, ssm_log_dt, ssm_b_re, ssm_b_im, ssm_c_re, ssm_c_im,
              ssm_d, ssm_w_glu, conv_w, conv_b, lambda_q1, lambda_k1, lambda_q2, lambda_k2, subln_w,
              w_branch, w_out, ln1_g, ln1_b, w_up, w_down, ln2_g, ln2_b):
    def layer_params(l):
        return dict(w_in=w_in[l], pool_w=pool_w[l], pool_scale=pool_scale[l],
                    ssm_a_re=ssm_a_re[l], ssm_a_im=ssm_a_im[l], ssm_log_dt=ssm_log_dt[l],
                    ssm_b_re=ssm_b_re[l], ssm_b_im=ssm_b_im[l], ssm_c_re=ssm_c_re[l], ssm_c_im=ssm_c_im[l],
                    ssm_d=ssm_d[l], ssm_w_glu=ssm_w_glu[l], conv_w=conv_w[l], conv_b=conv_b[l],
                    lambda_q1=lambda_q1[l], lambda_k1=lambda_k1[l], lambda_q2=lambda_q2[l], lambda_k2=lambda_k2[l],
                    subln_w=subln_w[l], w_branch=w_branch[l], w_out=w_out[l], ln1_g=ln1_g[l], ln1_b=ln1_b[l],
                    w_up=w_up[l], w_down=w_down[l], ln2_g=ln2_g[l], ln2_b=ln2_b[l])

    bp = x_prompt.shape[0]
    zero_pool = jnp.zeros((bp, POOL_HIST, POOL_WIDTH), x_prompt.dtype)
    zero_conv = jnp.zeros((bp, CONV_K - 1, CONV_WIDTH), x_prompt.dtype)
    zero_ssm = jnp.zeros((bp, SSM_GROUPS, SSM_STATE), F32)
    xp = x_prompt
    pk, pv, pre, pim, pconv, ppool = [], [], [], [], [], []
    for l in range(DEPTH):
        xp, (k_l, v_l, re_l, im_l, c_l, p_l) = trunk_layer(
            xp, 0, zero_pool, zero_conv, zero_ssm, zero_ssm, None, None, layer_params(l), l)
        pk.append(k_l); pv.append(v_l); pre.append(re_l); pim.append(im_l); pconv.append(c_l); ppool.append(p_l)

    past = cache_k.shape[2]
    xs = x_sample
    sk, sv, sre, sim, sconv, spool = [], [], [], [], [], []
    for l in range(DEPTH):
        xs, (k_l, v_l, re_l, im_l, c_l, p_l) = trunk_layer(
            xs, past, state_pool[l], state_conv[l], state_ssm_re[l], state_ssm_im[l],
            cache_k[l], cache_v[l], layer_params(l), l)
        sk.append(k_l); sv.append(v_l); sre.append(re_l); sim.append(im_l); sconv.append(c_l); spool.append(p_l)

    return (xp, xs,
            jnp.stack(pk), jnp.stack(pv), jnp.stack(pre), jnp.stack(pim), jnp.stack(pconv), jnp.stack(ppool),
            jnp.stack(sk), jnp.stack(sv), jnp.stack(sre), jnp.stack(sim), jnp.stack(sconv), jnp.stack(spool))
```

```cpp
#include <hip/hip_runtime.h>
#include <hip/hip_bf16.h>
#include <cstdio>
#include <cstdint>
#include <cmath>

#define ATTN_DV128 1
#define KT_K 1
#define KT_V 1
#define REP_EPI 1
#define REP_GEMM 1
#define REP_THIN 1
#define REP_ATTN 1
#define REP_MIXA 1
#define REP_MIXC 1
#define REP_PRO 1
#define REP_WIN 1
#define REP_PG 1
#define REP_MERGE 1
#define REP_OUT 1
#define REP_UP 1
#define REP_DOWN 1
#define REP_SAMPLE 1

#ifndef MK_ONE_LAUNCH
#define MK_ONE_LAUNCH 1
#endif

constexpr int DM = 1024, NB_P = 2, SEQ = 16384, DEPTH = 2, NB_S = 16, SEQ_S = 32, PAST = 4096;
constexpr int M_P = NB_P * SEQ, M_S = NB_S * SEQ_S, M_T = M_P + M_S;
constexpr int N_IN = 9728, D_FF = 4096, BR_W = 2560;
constexpr int KS_ROWS = 4224;
constexpr int NCH_P = M_P / 64;
constexpr float LN_EPS = 1e-5f;
constexpr float DN_ALPHA = 1.41421356237309515f;

constexpr size_t O_YP = 0;
constexpr size_t O_YS = O_YP + (size_t)M_P * DM;
constexpr size_t O_KP = O_YS + (size_t)M_S * DM;
constexpr size_t O_VP = O_KP + (size_t)DEPTH * M_P * 1024;
constexpr size_t O_SRP = O_VP + (size_t)DEPTH * M_P * 1024;
constexpr size_t O_SIP = O_SRP + (size_t)DEPTH * NB_P * 2048;
constexpr size_t O_CP = O_SIP + (size_t)DEPTH * NB_P * 2048;
constexpr size_t O_PP = O_CP + (size_t)DEPTH * NB_P * 2 * 512;
constexpr size_t O_KS = O_PP + (size_t)DEPTH * NB_P * 15 * 512;
constexpr size_t O_VS = O_KS + (size_t)DEPTH * M_S * 1024;
constexpr size_t O_SRS = O_VS + (size_t)DEPTH * M_S * 1024;
constexpr size_t O_SIS = O_SRS + (size_t)DEPTH * NB_S * 2048;
constexpr size_t O_CS = O_SIS + (size_t)DEPTH * NB_S * 2048;
constexpr size_t O_PS = O_CS + (size_t)DEPTH * NB_S * 2 * 512;
constexpr size_t O_END = O_PS + (size_t)DEPTH * NB_S * 15 * 512;

constexpr size_t KiB = 1u << 10, MiB = 1u << 20;
constexpr size_t WS_CTL = 0, CTL_ZERO_BYTES = 64 * KiB;
constexpr size_t WS_W = 2 * MiB, W_LSTRIDE = 44 * MiB;
constexpr size_t W_IN = 0, W_BR = 19 * MiB, W_OUT = 24 * MiB, W_UP = 26 * MiB, W_DN = 34 * MiB, W_GLU = 42 * MiB, W_POOL = 42 * MiB + 512 * KiB;
constexpr size_t WS_ROPE = 90 * MiB;
constexpr size_t WS_SSMC = 91 * MiB, SSMC_LSTRIDE = 512 * KiB;
constexpr size_t SC_AB = 0, SC_A64 = 16 * KiB, SC_BB = 32 * KiB, SC_CM = 160 * KiB;
constexpr size_t WS_E = 92 * MiB, WS_H = 100 * MiB;
constexpr size_t WS_XB = 108 * MiB;
constexpr size_t WS_XF1 = 173 * MiB;
constexpr size_t WS_XMF = 303 * MiB, WS_XMB = 433 * MiB;
constexpr size_t WS_YF = 498 * MiB;
constexpr size_t WS_ZP = 628 * MiB, SZ_512 = (size_t)M_T * 512 * 2;
constexpr size_t WS_US = WS_ZP + SZ_512, WS_HC = WS_US + SZ_512, WS_BC = WS_HC + SZ_512, WS_CC = WS_BC + SZ_512, WS_UPOOL = WS_CC + SZ_512, WS_VSSM = WS_UPOOL + SZ_512;
constexpr size_t WS_Q = 856 * MiB, WS_K = 922 * MiB, WS_V = 986 * MiB;
constexpr size_t WS_KS = 1050 * MiB, WS_VS = 1182 * MiB;
constexpr size_t WS_G = 1314 * MiB;
constexpr size_t WS_OATT = 1574 * MiB;
constexpr size_t WS_OALL = 1704 * MiB;
constexpr size_t WS_MG = 1867 * MiB;
constexpr size_t WS_END = 1932 * MiB;
static_assert(WS_VSSM + SZ_512 <= WS_Q && WS_Q + (size_t)(M_T + 256) * 2048 <= WS_K && WS_KS + (size_t)NB_S * KS_ROWS * 2048 <= WS_VS && WS_VS + (size_t)NB_S * KS_ROWS * 2048 <= WS_G, "ws map 1");
static_assert(WS_G + (size_t)M_T * 8192 <= WS_OATT && WS_OATT + (size_t)M_T * 4096 <= WS_OALL && WS_OALL + (size_t)M_T * 5120 <= WS_MG && WS_MG + (size_t)M_T * 2048 <= WS_END, "ws map 2");
static_assert(WS_XB + (size_t)M_T * 2048 <= WS_XF1 && WS_XF1 + (size_t)M_T * 4096 <= WS_XMF && WS_XMF + (size_t)M_T * 4096 <= WS_XMB && WS_XMB + (size_t)M_T * 2048 <= WS_YF && WS_YF + (size_t)M_T * 4096 <= WS_ZP, "ws map 3");

#ifndef REP_EPI
#define REP_EPI 1
#endif
constexpr int EPI_REP = REP_EPI;
__device__ __forceinline__ int lane_id() { int l; asm volatile("v_mbcnt_lo_u32_b32 %0, -1, 0\n\tv_mbcnt_hi_u32_b32 %0, -1, %0" : "=v"(l)); return l; }
template <int X> __device__ __forceinline__ float swz_xor(float v) { return __int_as_float(__builtin_amdgcn_ds_swizzle(__float_as_int(v), 0x1f | (X << 10))); }
namespace pg8 {
#define PG8_LAS __attribute__((address_space(3)))
typedef unsigned short bf16_t;
typedef short bf16x8 __attribute__((ext_vector_type(8)));
typedef float f32x4 __attribute__((ext_vector_type(4)));
typedef unsigned u32x4 __attribute__((ext_vector_type(4)));
typedef unsigned u32x2 __attribute__((ext_vector_type(2)));
constexpr int BM = 256, BK = 64, HALF = 128, HTB = HALF * BK * 2  , STAGE_BYTES = 8 * HTB, NXCD = 8, WGM = 8;

__host__ __device__ __forceinline__ int lds_byte(int r, int c) { const int st = (r >> 4) * 2 + (c >> 5), rr = r & 15, cc = c & 31, ob = rr * 64 + cc * 2; return st * 1024 + (ob ^ (((ob >> 9) & 1) << 5)); }
__host__ __device__ __forceinline__ void stage_rc(int b, int& R, int& C) { const int st = b / 1024, sb = b % 1024, swz = sb ^ (((sb >> 9) & 1) << 5); R = (st >> 1) * 16 + swz / 64; C = (st & 1) * 32 + (swz % 64) / 2; }
__host__ __device__ __forceinline__ int perm32(int rho) { const int n = rho >> 4, i = rho & 15; return 8 * (i >> 2) + 4 * n + (i & 3); }

struct Unit { int pm, pn; };
struct Gemm { const bf16_t* A; const bf16_t* Bt; int M, N, K; };

template <int NM, int NN> struct StaticOrderT {
    static constexpr int nwg = NM * NN, TAIL = NM % WGM;
    static_assert(TAIL == 0 || TAIL == 1 || TAIL == 2 || TAIL == 4, "last row-panel group must be a power of two");
    int G, c, tid;
    __host__ __device__ void init(int, int, int G_, int c_) { G = G_; c = c_; tid = 0; }
    __host__ __device__ bool next(int i, Unit& u) const {
        const int L = i * G + c; if (L >= nwg) return false;
        int wgid = L; { constexpr int q = nwg / NXCD, r = nwg % NXCD; const int xcd = wgid % NXCD, off = wgid / NXCD; wgid = (xcd < r ? xcd * (q + 1) : r * (q + 1) + (xcd - r) * q) + off; }
        constexpr int nig = WGM * NN; const int gid = wgid / nig, fm = gid * WGM, x = wgid - gid * nig; const bool tail = (NM - fm) < WGM;
        const int sh = tail ? (TAIL == 4 ? 2 : TAIL == 2 ? 1 : 0) : 3;
        u.pm = fm + (x & ((1 << sh) - 1)); u.pn = x >> sh; return true;
    }
    __device__ __forceinline__ const char* abase(const Gemm& g, const Unit& u) const { return (const char*)g.A + (size_t)u.pm * (size_t)(BM * 2) * g.K; }
    __device__ __forceinline__ const char* bbase(const Gemm& g, const Unit& u) const { return (const char*)g.Bt + (size_t)u.pn * (size_t)(BM * 2) * g.K; }
    __device__ __forceinline__ void a_ready(const Unit&) const {}
    __device__ __forceinline__ void done(const Unit&) const {}
};
typedef float pkh_f2_t __attribute__((ext_vector_type(2))); typedef __bf16 pkh_b2_t __attribute__((ext_vector_type(2)));
__device__ __forceinline__ unsigned cvt_pk_bf16_hw(float lo, float hi);
__device__ __forceinline__ unsigned cvt_pk_bf16(float lo, float hi) { return cvt_pk_bf16_hw(lo, hi); }
__device__ __forceinline__ unsigned cvt_pk_bf16_hw(float lo, float hi) { const pkh_f2_t v = {lo, hi}; const pkh_b2_t b = __builtin_convertvector(v, pkh_b2_t); return __builtin_bit_cast(unsigned, b); }
__device__ __forceinline__ float bf_lo(unsigned w) { return __uint_as_float(w << 16); }
__device__ __forceinline__ float bf_hi(unsigned w) { return __uint_as_float(w & 0xffff0000u); }
__device__ __forceinline__ float fast_sigmoid(float x) { return __builtin_amdgcn_rcpf(1.0f + __builtin_amdgcn_exp2f(-1.4426950408889634f * x)); }

#define EPI_LOOP_ROWS for (int ai = 0; ai < 2; ++ai) _Pragma("unroll") for (int m = 0; m < 4; ++m)

struct EpiWin {
    static constexpr bool PERM = true, AFTER_DRAIN = false, MIDK = false, PROBE_REP = true; static constexpr bool PERM2 = false;
    unsigned char* ws; float* out; int l; float qscale;
    static __device__ __forceinline__ u32x4 pack8(const f32x4 v0, const f32x4 v1) { u32x4 w; w.x = cvt_pk_bf16_hw(v0[0], v0[1]); w.y = cvt_pk_bf16_hw(v0[2], v0[3]); w.z = cvt_pk_bf16_hw(v1[0], v1[1]); w.w = cvt_pk_bf16_hw(v1[2], v1[3]); return w; }
    template <bool GATE> __device__ __forceinline__ void plain(const f32x4 (&acc)[2][2][4][2], bf16_t* base, int ld, int row0, int col) const {
#pragma unroll
        EPI_LOOP_ROWS { bf16_t* rowp = base + (size_t)(row0 + ai * HALF + m * 16) * ld + col;
#pragma unroll
            for (int bj = 0; bj < 2; ++bj) { f32x4 v0 = acc[ai][bj][m][0], v1 = acc[ai][bj][m][1];
                if (GATE) {
#pragma unroll
                    for (int e = 0; e < 4; ++e) { v0[e] = fast_sigmoid(v0[e]); v1[e] = fast_sigmoid(v1[e]); } }
                *(u32x4*)(rowp + bj * HALF) = pack8(v0, v1); } }
    }
    __device__ __forceinline__ void gates(const f32x4 (&acc)[2][2][4][2], const Unit& u, int wave, int lane, int row0, int c8) const {
        const bool smp = u.pm >= M_P / BM;
        bf16_t* base = smp ? (bf16_t*)(ws + WS_G) + (size_t)row0 * 4096 + (u.pn - 22) * BM + c8 : (bf16_t*)(ws + WS_G) + ((size_t)u.pm * 16 + (u.pn - 22)) * 65536 + (size_t)(wave * 1024 + lane) * 8;
        const int sA = smp ? HALF * 4096 : 4096, sM = smp ? 16 * 4096 : 1024, sB = smp ? HALF : 512;
#pragma unroll
        EPI_LOOP_ROWS {
#pragma unroll
            for (int bj = 0; bj < 2; ++bj) { f32x4 v0 = acc[ai][bj][m][0], v1 = acc[ai][bj][m][1];
#pragma unroll
                for (int e = 0; e < 4; ++e) { v0[e] = fast_sigmoid(v0[e]); v1[e] = fast_sigmoid(v1[e]); }
                *(u32x4*)(base + (size_t)(ai * sA + m * sM + bj * sB)) = pack8(v0, v1); } }
    }
    template <int KIND, bool ROT> __device__ __forceinline__ void qkv(const f32x4 (&acc)[2][2][4][2], const Unit& u, int row0, int colt, int c8, int fq) const {
        const bool smp = u.pm >= M_P / BM;
        const float sg = fq == 0 ? -1.f : 1.f; const bool act = fq < 2;
#pragma unroll
        for (int ai = 0; ai < 2; ++ai) {
        f32x4 rt[4][4];
        if (ROT) {
#pragma unroll
            for (int m = 0; m < 4; ++m) { const int row = row0 + ai * HALF + m * 16, loc = row - M_P; const int pos = smp ? PAST + (loc & 31) : (row & (SEQ - 1)); const f32x4* rp = (const f32x4*)(ws + WS_ROPE) + (size_t)pos * 4;
                rt[m][0] = rp[0]; rt[m][1] = rp[1]; rt[m][2] = rp[2]; rt[m][3] = rp[3]; }
            __builtin_amdgcn_sched_barrier(0); }
#pragma unroll
        for (int m = 0; m < 4; ++m) {
            const int row = row0 + ai * HALF + m * 16, loc = row - M_P;
            f32x4 cs0, cs1, sn0, sn1;
            if (ROT) { cs0 = rt[m][0]; cs1 = rt[m][1]; sn0 = rt[m][2]; sn1 = rt[m][3];
#pragma unroll
                for (int e = 0; e < 4; ++e) { cs0[e] = act ? cs0[e] : 1.f; cs1[e] = act ? cs1[e] : 1.f; sn0[e] = act ? sg * sn0[e] : 0.f; sn1[e] = act ? sg * sn1[e] : 0.f; } }
            float* of = nullptr; bf16_t* ob;
            if (KIND == 0) ob = (bf16_t*)(ws + WS_Q) + (size_t)row * 1024 + colt + c8;
            else { const size_t fo = smp ? (KIND == 1 ? O_KS : O_VS) + (size_t)l * M_S * 1024 + (size_t)loc * 1024 : (KIND == 1 ? O_KP : O_VP) + (size_t)l * M_P * 1024 + (size_t)row * 1024;
                of = out + fo + colt + c8;
                ob = smp ? (bf16_t*)(ws + (KIND == 1 ? WS_KS : WS_VS)) + ((size_t)(loc >> 5) * KS_ROWS + PAST + (loc & 31)) * 1024 + colt + c8 : (bf16_t*)(ws + (KIND == 1 ? WS_K : WS_V)) + (size_t)row * 1024 + colt + c8; }
#pragma unroll
            for (int bj = 0; bj < 2; ++bj) { f32x4 v0 = acc[ai][bj][m][0], v1 = acc[ai][bj][m][1];
                if (ROT) { f32x4 p0, p1;
#pragma unroll
                    for (int e = 0; e < 4; ++e) { p0[e] = swz_xor<16>(v0[e]); p1[e] = swz_xor<16>(v1[e]); }
                    v0 = v0 * cs0 + p0 * sn0; v1 = v1 * cs1 + p1 * sn1; }
                if (KIND == 0) { v0 = v0 * qscale; v1 = v1 * qscale; }
                else { *(f32x4*)(of + bj * HALF) = v0; *(f32x4*)(of + bj * HALF + 4) = v1; }
                bf16_t* o2 = ob + bj * HALF;
                if (((KIND == 1 && KT_K) || (KIND == 2 && KT_V)) && !smp) {
                    const int col = colt + bj * HALF + c8, bt = row >> 14, tile = (row & (SEQ - 1)) >> 6, r = row & 63;
                    o2 = KIND == 1 ? (bf16_t*)(ws + WS_K) + ((((size_t)(bt * 16 + (col >> 6)) * 256 + tile) * 8 + ((col >> 3) & 7)) * 64 + r) * 8
                                   : (bf16_t*)(ws + WS_V) + ((((size_t)(bt * 8 + (col >> 7)) * 256 + tile) * 4 + ((col >> 5) & 3)) * 64 + r) * 32 + (col & 31); }
                *(u32x4*)o2 = pack8(v0, v1); } }
        }
    }
    __device__ __forceinline__ void operator()(const f32x4 (&acc)[2][2][4][2], const Unit& u, int wr, int wc, int fr, int fq) const {
        { const int ln_ = lane_id(); fr = ln_ & 15; fq = ln_ >> 4; }
        const int pn = u.pn, row0 = u.pm * BM + wr * 64 + fr, c8 = wc * 32 + 8 * fq;
        if (pn < 10) plain<false>(acc, (bf16_t*)(ws + WS_ZP + (size_t)(pn >> 1) * SZ_512), 512, row0, (pn & 1) * BM + c8);
        else if (pn >= 22) gates(acc, u, wr * 4 + wc, fq * 16 + fr, row0, c8);
        else { const bool rot = (wc & 1) == 0;
            if (pn < 14) { if (rot) qkv<0, true>(acc, u, row0, (pn - 10) * BM, c8, fq); else qkv<0, false>(acc, u, row0, (pn - 10) * BM, c8, fq); }
            else if (pn < 18) { if (rot) qkv<1, true>(acc, u, row0, (pn - 14) * BM, c8, fq); else qkv<1, false>(acc, u, row0, (pn - 14) * BM, c8, fq); }
            else qkv<2, false>(acc, u, row0, (pn - 18) * BM, c8, fq); }
    }
};

struct EpiGlu {
    static constexpr bool PERM = true, AFTER_DRAIN = false, MIDK = false; static constexpr bool PROBE_REP = false; static constexpr bool PERM2 = false;
    unsigned char* ws;
    __device__ __forceinline__ void operator()(const f32x4 (&acc)[2][2][4][2], const Unit& u, int wr, int wc, int fr, int fq) const {
        { const int ln_ = lane_id(); fr = ln_ & 15; fq = ln_ >> 4; }
        const int row0 = u.pm * BM + wr * 64 + fr, c8 = wc * 32 + 8 * fq, colt = u.pn * BM;
        u32x4 vv[2][4][2];
#pragma unroll
        EPI_LOOP_ROWS {
#pragma unroll
            for (int bj = 0; bj < 2; ++bj) vv[ai][m][bj] = *(const u32x4*)((const bf16_t*)(ws + WS_VSSM) + (size_t)(row0 + ai * HALF + m * 16) * 512 + colt + bj * HALF + c8); }
        __builtin_amdgcn_sched_barrier(0);
#pragma unroll
        EPI_LOOP_ROWS { const int row = row0 + ai * HALF + m * 16;
#pragma unroll
            for (int bj = 0; bj < 2; ++bj) { f32x4 v0 = acc[ai][bj][m][0], v1 = acc[ai][bj][m][1]; const int col = colt + bj * HALF + c8; const u32x4 x = vv[ai][m][bj];
#pragma unroll
                for (int e = 0; e < 4; ++e) { v0[e] = fast_sigmoid(v0[e]); v1[e] = fast_sigmoid(v1[e]); }
                v0[0] *= bf_lo(x.x); v0[1] *= bf_hi(x.x); v0[2] *= bf_lo(x.y); v0[3] *= bf_hi(x.y); v1[0] *= bf_lo(x.z); v1[1] *= bf_hi(x.z); v1[2] *= bf_lo(x.w); v1[3] *= bf_hi(x.w);
                u32x4 w; w.x = cvt_pk_bf16(v0[0], v0[1]); w.y = cvt_pk_bf16(v0[2], v0[3]); w.z = cvt_pk_bf16(v1[0], v1[1]); w.w = cvt_pk_bf16(v1[2], v1[3]);
                *(u32x4*)((bf16_t*)(ws + WS_OALL) + (size_t)row * BR_W + 512 + col) = w; } }
    }
};

struct EpiMerge {
    static constexpr bool PERM = true, AFTER_DRAIN = false, MIDK = true; static constexpr bool PROBE_REP = false; static constexpr bool PERM2 = false;
    unsigned char* ws; int tid;
    template <bool DEN> __device__ __forceinline__ void scale(f32x4 (&acc)[2][2][4][2], const Unit& u, int wr, int wc, int fr, int fq, int bnum, int bden) const {
        int tid_ = tid; asm volatile("" : "+v"(tid_));
        { const int l_ = tid_ & 63, w_ = tid_ >> 6; fr = l_ & 15; fq = l_ >> 4; wr = w_ >> 2; wc = w_ & 3; }
        const int wave = wr * 4 + wc, lane = fq * 16 + fr;
        const bf16_t* gb = (const bf16_t*)(ws + WS_G) + ((size_t)u.pm * 16 + u.pn) * 65536 + (size_t)(wave * 1024 + lane) * 8;
#pragma unroll
        for (int ai = 0; ai < 2; ++ai) {
            u32x4 ga[4][2], gd[4][2];
#pragma unroll
            for (int m = 0; m < 4; ++m)
#pragma unroll
                for (int bj = 0; bj < 2; ++bj) { const bf16_t* gp = gb + (size_t)(ai * 4096 + m * 1024 + bj * 512);
                    ga[m][bj] = *(const u32x4*)(gp + (size_t)bnum * 262144); if (DEN) gd[m][bj] = *(const u32x4*)(gp + (size_t)bden * 262144); }
            __builtin_amdgcn_sched_barrier(0);
#pragma unroll
            for (int m = 0; m < 4; ++m)
#pragma unroll
                for (int bj = 0; bj < 2; ++bj) { const u32x4 a = ga[m][bj];
                    f32x4 r0 = {bf_lo(a.x), bf_hi(a.x), bf_lo(a.y), bf_hi(a.y)}, r1 = {bf_lo(a.z), bf_hi(a.z), bf_lo(a.w), bf_hi(a.w)};
                    if (DEN) { const u32x4 b = gd[m][bj];
                        r0[0] *= __builtin_amdgcn_rcpf(bf_lo(b.x)); r0[1] *= __builtin_amdgcn_rcpf(bf_hi(b.x)); r0[2] *= __builtin_amdgcn_rcpf(bf_lo(b.y)); r0[3] *= __builtin_amdgcn_rcpf(bf_hi(b.y));
                        r1[0] *= __builtin_amdgcn_rcpf(bf_lo(b.z)); r1[1] *= __builtin_amdgcn_rcpf(bf_hi(b.z)); r1[2] *= __builtin_amdgcn_rcpf(bf_lo(b.w)); r1[3] *= __builtin_amdgcn_rcpf(bf_hi(b.w)); }
                    acc[ai][bj][m][0] *= r0; acc[ai][bj][m][1] *= r1; }
            __builtin_amdgcn_sched_barrier(0);
        }
    }
    __device__ __forceinline__ void mid(f32x4 (&acc)[2][2][4][2], const Unit& u, int wr, int wc, int fr, int fq, int t) const {
        if (t == 8 || t == 16 || t == 24) scale<true>(acc, u, wr, wc, fr, fq, (t >> 3) - 1, t >> 3);
    }
    __device__ __forceinline__ void operator()(f32x4 (&acc)[2][2][4][2], const Unit& u, int wr, int wc, int fr, int fq) const {
        { const int ln_ = lane_id(); fr = ln_ & 15; fq = ln_ >> 4; }
        scale<false>(acc, u, wr, wc, fr, fq, 3, -1);
        int row0 = u.pm * BM + wr * 64 + fr; const int c8 = wc * 32 + 8 * fq;
        asm volatile("" : "+v"(row0));
#pragma unroll
        EPI_LOOP_ROWS { bf16_t* rowp = (bf16_t*)(ws + WS_MG) + (size_t)(row0 + ai * HALF + m * 16) * 1024 + u.pn * BM + c8;
#pragma unroll
            for (int bj = 0; bj < 2; ++bj) { const f32x4 v0 = acc[ai][bj][m][0], v1 = acc[ai][bj][m][1];
                u32x4 w; w.x = cvt_pk_bf16(v0[0], v0[1]); w.y = cvt_pk_bf16(v0[2], v0[3]); w.z = cvt_pk_bf16(v1[0], v1[1]); w.w = cvt_pk_bf16(v1[2], v1[3]);
                *(u32x4*)(rowp + bj * HALF) = w; } }
    }
};

struct EpiResid {
    static constexpr bool PERM = true, AFTER_DRAIN = false, MIDK = false; static constexpr bool PROBE_REP = false; static constexpr bool PERM2 = false;
    const bf16_t* resP; unsigned char* ws; int ybf;
    __device__ __forceinline__ void operator()(const f32x4 (&acc)[2][2][4][2], const Unit& u, int wr, int wc, int fr, int fq) const {
        { const int ln_ = lane_id(); fr = ln_ & 15; fq = ln_ >> 4; }
        const int row0 = u.pm * BM + wr * 64 + fr, col0 = u.pn * BM + wc * 32 + 8 * fq;
        u32x4 rr[2][4][2];
#pragma unroll
        EPI_LOOP_ROWS {
#pragma unroll
            for (int bj = 0; bj < 2; ++bj) rr[ai][m][bj] = *(const u32x4*)(resP + (size_t)(row0 + ai * HALF + m * 16) * 1024 + col0 + bj * HALF); }
        __builtin_amdgcn_sched_barrier(0);
#pragma unroll
        EPI_LOOP_ROWS { const size_t yo = (size_t)(row0 + ai * HALF + m * 16) * 1024 + col0;
#pragma unroll
            for (int bj = 0; bj < 2; ++bj) { const u32x4 w = rr[ai][m][bj];
                const f32x4 y0 = (f32x4){bf_lo(w.x), bf_hi(w.x), bf_lo(w.y), bf_hi(w.y)} * DN_ALPHA + acc[ai][bj][m][0], y1 = (f32x4){bf_lo(w.z), bf_hi(w.z), bf_lo(w.w), bf_hi(w.w)} * DN_ALPHA + acc[ai][bj][m][1];
                if (ybf) { u32x4 o; o.x = cvt_pk_bf16(y0[0], y0[1]); o.y = cvt_pk_bf16(y0[2], y0[3]); o.z = cvt_pk_bf16(y1[0], y1[1]); o.w = cvt_pk_bf16(y1[2], y1[3]); *(u32x4*)((bf16_t*)(ws + WS_YF) + yo + bj * HALF) = o; }
                else { *(f32x4*)((float*)(ws + WS_YF) + yo + bj * HALF) = y0; *(f32x4*)((float*)(ws + WS_YF) + yo + bj * HALF + 4) = y1; } } }
    }
};

struct EpiUp {
    static constexpr bool PERM = true, AFTER_DRAIN = false, MIDK = false; static constexpr bool PROBE_REP = false; static constexpr bool PERM2 = false;
    unsigned char* ws;
    __device__ __forceinline__ void operator()(const f32x4 (&acc)[2][2][4][2], const Unit& u, int wr, int wc, int fr, int fq) const {
        { const int ln_ = lane_id(); fr = ln_ & 15; fq = ln_ >> 4; }
        const int row0 = u.pm * BM + wr * 64 + fr, c8 = wc * 32 + 8 * fq;
#pragma unroll
        EPI_LOOP_ROWS { bf16_t* rowp = (bf16_t*)(ws + WS_G) + (size_t)(row0 + ai * HALF + m * 16) * D_FF + u.pn * BM + c8;
#pragma unroll
            for (int bj = 0; bj < 2; ++bj) { f32x4 v0 = acc[ai][bj][m][0], v1 = acc[ai][bj][m][1];
#pragma unroll
                for (int e = 0; e < 4; ++e) { const float a = fmaxf(v0[e], 0.f), b = fmaxf(v1[e], 0.f); v0[e] = a * a; v1[e] = b * b; }
                u32x4 w; w.x = cvt_pk_bf16(v0[0], v0[1]); w.y = cvt_pk_bf16(v0[2], v0[3]); w.z = cvt_pk_bf16(v1[0], v1[1]); w.w = cvt_pk_bf16(v1[2], v1[3]);
                *(u32x4*)(rowp + bj * HALF) = w; } }
    }
};

template <class Epi, class Sched, bool ALIGN_EPI = false, bool SP2 = false>
__device__ __forceinline__ void gemm_phase(PG8_LAS unsigned char* lds, const Gemm g, const Sched& S, const Epi& E) {
    int tid0_ = S.tid; asm volatile("" : "+v"(tid0_));
    const int tid = tid0_, wid = __builtin_amdgcn_readfirstlane(tid >> 6), lane = tid & 63, wr = wid >> 2, wc = wid & 3, fr = lane & 15, fq = lane >> 4;
    const int K = g.K, nt = K / BK;
    unsigned voffA[2], voffB[2];
#pragma unroll
    for (int i = 0; i < 2; ++i) { int R, C; stage_rc(tid * 16 + i * 8192, R, C); const int Rb = Epi::PERM2 ? ((R >> 5) * 64 + perm32(R & 31)) : Epi::PERM ? ((R & ~31) + perm32(R & 31)) : R;
        voffA[i] = (unsigned)(R * K + C) * 2u; voffB[i] = (unsigned)(Rb * K + C) * 2u; }
    const size_t kstep = (size_t)(BK * 2);
    const size_t hstepB = Epi::PERM2 ? (size_t)32 * K * 2 : (size_t)HALF * K * 2;
    const size_t hstep = (size_t)HALF * K * 2;
    const unsigned ldsw = (unsigned)wid * 1024u;
    const int aoff = lds_byte(wr * 64 + fr, fq * 8), boff = lds_byte(wc * 32 + fr, fq * 8);
#define PG8_SA(b, h) (((b) * 2 + (h)) * HTB)
#define PG8_SB(b, h) ((4 + (b) * 2 + (h)) * HTB)
#define PG8_STAGE(bufoff, gbase, voff) do { _Pragma("unroll") for (int _i = 0; _i < 2; ++_i) \
        __builtin_amdgcn_global_load_lds((const unsigned*)((const char*)(gbase) + (voff)[_i]), (PG8_LAS unsigned*)(lds + (bufoff) + ldsw + _i * 8192), 16, 0, 0); } while (0)
#define PG8_LDA(dst, b, h) do { _Pragma("unroll") for (int m = 0; m < 4; ++m) _Pragma("unroll") for (int k = 0; k < 2; ++k) dst[m][k] = *(const PG8_LAS bf16x8*)(lds + PG8_SA(b, h) + aoff + m * 2048 + k * 1024); } while (0)
#define PG8_LDB(dst, b, h) do { _Pragma("unroll") for (int n = 0; n < 2; ++n) _Pragma("unroll") for (int k = 0; k < 2; ++k) dst[n][k] = *(const PG8_LAS bf16x8*)(lds + PG8_SB(b, h) + boff + n * 2048 + k * 1024); } while (0)
#define PG8_MMA(ai, bj, At, Bt) do { __builtin_amdgcn_s_setprio(1); _Pragma("unroll") for (int m = 0; m < 4; ++m) _Pragma("unroll") for (int n = 0; n < 2; ++n) _Pragma("unroll") for (int k = 0; k < 2; ++k) \
        acc[ai][bj][m][n] = __builtin_amdgcn_mfma_f32_16x16x32_bf16(Bt[n][k], At[m][k], acc[ai][bj][m][n], 0, 0, 0); __builtin_amdgcn_s_setprio(0); } while (0)
#define PG8_WAIT_V(n) asm volatile("s_waitcnt vmcnt(" #n ")" ::: "memory")
#define PG8_WAIT_L(n) asm volatile("s_waitcnt lgkmcnt(" #n ")" ::: "memory")
#define PG8_BAR __builtin_amdgcn_s_barrier()
#define PG8_SCHED __builtin_amdgcn_sched_barrier(0)
    Unit cur, nxt; int ui = 0;
    if (!S.next(0, cur)) return;
    f32x4 acc[2][2][4][2];
#pragma unroll
    for (int a = 0; a < 2; ++a)
#pragma unroll
        for (int b = 0; b < 2; ++b)
#pragma unroll
            for (int m = 0; m < 4; ++m)
#pragma unroll
                for (int n = 0; n < 2; ++n) acc[a][b][m][n] = (f32x4){0.f, 0.f, 0.f, 0.f};
    bf16x8 At[4][2], B0[2][2], B1[2][2];
    const char* cA = S.abase(g, cur); const char* cB = S.bbase(g, cur);
    S.a_ready(cur);
    if constexpr (SP2) {
        PG8_STAGE(PG8_SB(0, 0), cB, voffB); PG8_STAGE(PG8_SB(0, 1), cB + hstepB, voffB); PG8_STAGE(PG8_SA(0, 0), cA, voffA); PG8_STAGE(PG8_SA(0, 1), cA + hstep, voffA);
        if (wr == 1) PG8_BAR;
        PG8_WAIT_V(2); PG8_BAR;
        PG8_STAGE(PG8_SB(1, 0), cB + kstep, voffB); PG8_STAGE(PG8_SA(1, 0), cA + kstep, voffA); PG8_STAGE(PG8_SB(1, 1), cB + hstepB + kstep, voffB);
        PG8_WAIT_V(6); PG8_BAR;
    } else {
        PG8_STAGE(PG8_SB(0, 0), cB, voffB); PG8_STAGE(PG8_SA(0, 0), cA, voffA); PG8_STAGE(PG8_SB(0, 1), cB + hstepB, voffB); PG8_STAGE(PG8_SA(0, 1), cA + hstep, voffA);
        if (wr == 1) PG8_BAR;
        PG8_WAIT_V(4); PG8_BAR;
        PG8_STAGE(PG8_SB(1, 0), cB + kstep, voffB); PG8_STAGE(PG8_SA(1, 0), cA + kstep, voffA); PG8_STAGE(PG8_SB(1, 1), cB + hstepB + kstep, voffB);
        PG8_WAIT_V(6); PG8_BAR;
    }
    for (;;) {
        const bool has_next = S.next(ui + 1, nxt);
        const char* nA = has_next ? S.abase(g, nxt) : cA; const char* nB = has_next ? S.bbase(g, nxt) : cB;
        for (int t = 0; t < nt; t += 2) {
            const bool last = (t == nt - 2);
            const char* a1 = cA + (size_t)(t + 1) * kstep;
            const char* a2 = last ? nA : cA + (size_t)(t + 2) * kstep; const char* b2 = last ? nB : cB + (size_t)(t + 2) * kstep;
            const char* a3 = a2 + kstep; const char* b3 = b2 + kstep;
            if (last && has_next) S.a_ready(nxt);
            if constexpr (Epi::MIDK) E.mid(acc, cur, wr, wc, fr, fq, t);
            if constexpr (SP2) {
            PG8_LDB(B0, 0, 0); PG8_LDB(B1, 0, 1); PG8_SCHED; PG8_LDA(At, 0, 0); PG8_STAGE(PG8_SA(1, 1), a1 + hstep, voffA);
            PG8_WAIT_V(8); PG8_WAIT_L(0); PG8_BAR; PG8_MMA(0, 0, At, B0); PG8_MMA(0, 1, At, B1); PG8_BAR; PG8_SCHED;
            PG8_LDA(At, 0, 1); PG8_STAGE(PG8_SB(0, 0), b2, voffB); PG8_STAGE(PG8_SB(0, 1), b2 + hstepB, voffB); PG8_STAGE(PG8_SA(0, 0), a2, voffA);
            PG8_WAIT_V(8); PG8_WAIT_L(0); PG8_BAR; PG8_MMA(1, 0, At, B0); PG8_MMA(1, 1, At, B1); PG8_BAR; PG8_SCHED;
            PG8_LDB(B0, 1, 0); PG8_LDB(B1, 1, 1); PG8_SCHED; PG8_LDA(At, 1, 0); PG8_STAGE(PG8_SA(0, 1), a2 + hstep, voffA);
            PG8_WAIT_V(8); PG8_WAIT_L(0); PG8_BAR; PG8_MMA(0, 0, At, B0); PG8_MMA(0, 1, At, B1); PG8_BAR; PG8_SCHED;
            PG8_LDA(At, 1, 1); PG8_STAGE(PG8_SB(1, 0), b3, voffB); PG8_STAGE(PG8_SB(1, 1), b3 + hstepB, voffB); PG8_STAGE(PG8_SA(1, 0), a3, voffA);
            PG8_WAIT_V(8); PG8_WAIT_L(0); PG8_BAR; PG8_MMA(1, 0, At, B0); PG8_MMA(1, 1, At, B1); PG8_BAR; PG8_SCHED;
            } else {
            PG8_LDB(B0, 0, 0); PG8_SCHED; PG8_LDA(At, 0, 0); PG8_STAGE(PG8_SA(1, 1), a1 + hstep, voffA);
            PG8_WAIT_L(8); PG8_BAR; PG8_WAIT_L(0); PG8_MMA(0, 0, At, B0); PG8_BAR; PG8_SCHED;
            PG8_LDB(B1, 0, 1); PG8_STAGE(PG8_SB(0, 0), b2, voffB);
            PG8_BAR; PG8_WAIT_L(0); PG8_MMA(0, 1, At, B1); PG8_BAR;
            PG8_LDA(At, 0, 1); PG8_STAGE(PG8_SA(0, 0), a2, voffA);
            PG8_BAR; PG8_WAIT_L(0); PG8_MMA(1, 0, At, B0); PG8_BAR; PG8_SCHED;
            PG8_STAGE(PG8_SB(0, 1), b2 + hstepB, voffB);
            PG8_WAIT_V(6); PG8_BAR; PG8_MMA(1, 1, At, B1); PG8_BAR;
            PG8_LDB(B0, 1, 0); PG8_SCHED; PG8_LDA(At, 1, 0); PG8_STAGE(PG8_SA(0, 1), a2 + hstep, voffA);
            PG8_WAIT_L(8); PG8_BAR; PG8_WAIT_L(0); PG8_MMA(0, 0, At, B0); PG8_BAR; PG8_SCHED;
            PG8_LDB(B1, 1, 1); PG8_STAGE(PG8_SB(1, 0), b3, voffB);
            PG8_BAR; PG8_WAIT_L(0); PG8_MMA(0, 1, At, B1); PG8_BAR;
            PG8_LDA(At, 1, 1); PG8_STAGE(PG8_SA(1, 0), a3, voffA);
            PG8_BAR; PG8_WAIT_L(0); PG8_MMA(1, 0, At, B0); PG8_BAR; PG8_SCHED;
            PG8_STAGE(PG8_SB(1, 1), b3 + hstepB, voffB);
            PG8_WAIT_V(6); PG8_BAR; PG8_MMA(1, 1, At, B1); PG8_BAR;
            }
        }
        if constexpr (ALIGN_EPI) { if (wr == 0) PG8_BAR; }
        if constexpr (!Epi::AFTER_DRAIN) { E(acc, cur, wr, wc, fr, fq); if constexpr (EPI_REP > 1 && Epi::PROBE_REP) { _Pragma("unroll 1") for (int e_ = 1; e_ < EPI_REP; ++e_) { asm volatile("" ::: "memory"); E(acc, cur, wr, wc, fr, fq); } } S.done(cur); }
        if (!has_next) break;
#pragma unroll
        for (int a = 0; a < 2; ++a)
#pragma unroll
            for (int b = 0; b < 2; ++b)
#pragma unroll
                for (int m = 0; m < 4; ++m)
#pragma unroll
                    for (int n = 0; n < 2; ++n) acc[a][b][m][n] = (f32x4){0.f, 0.f, 0.f, 0.f};
        cur = nxt; cA = nA; cB = nB; ++ui;
        if constexpr (ALIGN_EPI) { if (wr == 1) PG8_BAR; }
    }
    PG8_WAIT_V(0);
    if constexpr (!ALIGN_EPI) { if (wr == 0) PG8_BAR; }
    PG8_BAR;
    if constexpr (Epi::AFTER_DRAIN) { E.fused(acc, cur, wr, wc, fr, fq, lds, wid, lane); S.done(cur); }
#undef PG8_SA
#undef PG8_SB
#undef PG8_STAGE
#undef PG8_LDA
#undef PG8_LDB
#undef PG8_MMA
#undef PG8_WAIT_V
#undef PG8_WAIT_L
#undef PG8_BAR
#undef PG8_SCHED
}
}

#include <hip/hip_bf16.h>
#include <cmath>
namespace attn_body {
using bf16=__hip_bfloat16;
using bf16x8=__attribute__((ext_vector_type(8)))short;
using s16x4=__attribute__((ext_vector_type(4)))short;
using f32x16=__attribute__((ext_vector_type(16)))float;
using u32x4=__attribute__((ext_vector_type(4)))unsigned;
constexpr int D=64,DM=1024,OPITCH=2048;
constexpr int NW=8,QBLK=32,QB=QBLK*NW,KVBLK=64;
constexpr int ATTN_UNIT_ROWS=QB;
__device__ __forceinline__ int crow(int r,int hi){return (r&3)+8*(r>>2)+4*hi;}
#define SBAR() __builtin_amdgcn_sched_barrier(0)
__device__ __forceinline__ void bmask(f32x16&p0,f32x16&p1,int jb,int wid,int mode){
  const float NEG=-INFINITY; bool m0,m1;
  if(mode==0){ m0=jb>(wid>>1); m1=m0; } else { m0=(jb==3); m1=(jb>=2); }
  if(m0){
    #pragma unroll
    for(int r=0;r<16;++r)p0[r]=NEG; }
  if(m1){
    #pragma unroll
    for(int r=0;r<16;++r)p1[r]=NEG; }
}

constexpr int NSLOT=3, SLOTB=8192;
constexpr int LDS_K=0, LDS_V=NSLOT*SLOTB, LDS_WS=3*NSLOT*SLOTB, LDS_OST=LDS_WS+NW*64*4, LDS_BYTES=LDS_OST+NW*4096;
constexpr float C2=0.125f*1.4426950408889634f;
__device__ __forceinline__ void glds16(const void*gsrc,unsigned lds_dst){unsigned keep;
  asm volatile("s_mov_b32 %0, m0\n\ts_mov_b32 m0, %2\n\ts_nop 0\n\tglobal_load_lds_dwordx4 %1, off\n\ts_mov_b32 m0, %0":"=&s"(keep):"v"(gsrc),"s"(lds_dst):"memory");}
__device__ __forceinline__ float max3f(float a,float b,float c){float r;asm("v_max3_f32 %0, %1, %2, %3":"=v"(r):"v"(a),"v"(b),"v"(c));return r;}
__device__ __forceinline__ float max2f(float a,float b){float r;asm("v_max_f32_e32 %0, %1, %2":"=v"(r):"v"(a),"v"(b));return r;}
__device__ __forceinline__ float fadd_s(float a,float b){float r;asm("v_add_f32_e32 %0, %1, %2":"=v"(r):"v"(a),"v"(b));return r;}
__device__ __forceinline__ float fsub_s(float a,float b){float r;asm("v_sub_f32_e32 %0, %1, %2":"=v"(r):"v"(a),"v"(b));return r;}
typedef float f32x2_t __attribute__((ext_vector_type(2))); typedef __bf16 bf16x2_t __attribute__((ext_vector_type(2)));
__device__ __forceinline__ unsigned cvtpk_s(float lo,float hi){f32x2_t v={lo,hi};bf16x2_t b=__builtin_convertvector(v,bf16x2_t);return __builtin_bit_cast(unsigned,b);}
#define WAIT_BAR(N) asm volatile("s_waitcnt vmcnt(" #N ") lgkmcnt(0)\n\ts_barrier":::"memory")

__device__ __forceinline__ void qkt(f32x16&p0,f32x16&p1,const char*Kslot,const bf16x8*qr,const f32x16&negm,int r32,int hi){
  const char*kb=Kslot+hi*1024+r32*16;
  #pragma unroll
  for(int d0=0;d0<4;++d0){
    const bf16x8 b0=*reinterpret_cast<const bf16x8*>(kb+d0*2048);
    const bf16x8 b1=*reinterpret_cast<const bf16x8*>(kb+d0*2048+512);
    if(d0==0){p0=__builtin_amdgcn_mfma_f32_32x32x16_bf16(b0,qr[0],negm,0,0,0);p1=__builtin_amdgcn_mfma_f32_32x32x16_bf16(b1,qr[0],negm,0,0,0);}
    else{p0=__builtin_amdgcn_mfma_f32_32x32x16_bf16(b0,qr[d0],p0,0,0,0);p1=__builtin_amdgcn_mfma_f32_32x32x16_bf16(b1,qr[d0],p1,0,0,0);}}
}
typedef __attribute__((address_space(3))) const char* lds_cptr;
typedef short v4i16_t __attribute__((ext_vector_type(4)));
__device__ __forceinline__ void kload8(bf16x8*kf,lds_cptr kp){
  kf[0]=*(const __attribute__((address_space(3))) bf16x8*)(kp);      kf[1]=*(const __attribute__((address_space(3))) bf16x8*)(kp+512);
  kf[2]=*(const __attribute__((address_space(3))) bf16x8*)(kp+2048); kf[3]=*(const __attribute__((address_space(3))) bf16x8*)(kp+2560);
  kf[4]=*(const __attribute__((address_space(3))) bf16x8*)(kp+4096); kf[5]=*(const __attribute__((address_space(3))) bf16x8*)(kp+4608);
  kf[6]=*(const __attribute__((address_space(3))) bf16x8*)(kp+6144); kf[7]=*(const __attribute__((address_space(3))) bf16x8*)(kp+6656);
}
__device__ __forceinline__ void kload2(bf16x8*kf,lds_cptr kp,int j){ kf[2*j]=*(const __attribute__((address_space(3))) bf16x8*)(kp+j*2048); kf[2*j+1]=*(const __attribute__((address_space(3))) bf16x8*)(kp+j*2048+512); }
__device__ __forceinline__ s16x4 vtr(lds_cptr p){ return __builtin_bit_cast(s16x4,__builtin_amdgcn_ds_read_tr16_b64_v4i16((__attribute__((address_space(3))) v4i16_t*)p)); }
__device__ __forceinline__ float rowmax(const f32x16&p0,const f32x16&p1){
  float a=max3f(p0[0],p0[1],p1[0]),b=max3f(p0[2],p0[3],p1[1]);a=max3f(a,p1[2],p1[3]);
  #pragma unroll
  for(int r=4;r<16;r+=4){a=max3f(a,p0[r],p0[r+1]);b=max3f(b,p0[r+2],p0[r+3]);a=max3f(a,p1[r],p1[r+1]);b=max3f(b,p1[r+2],p1[r+3]);}
  const float m=max2f(a,b);
  auto rr=__builtin_amdgcn_permlane32_swap(__float_as_uint(m),__float_as_uint(m),false,false);
  return max2f(__uint_as_float(rr[0]),__uint_as_float(rr[1]));
}
__device__ __forceinline__ void pv(f32x16*o,int vb,bf16x8 pa0,bf16x8 pa1,bf16x8 pa2,bf16x8 pa3){
  #pragma unroll
  for(int d0=0;d0<4;++d0){s16x4 lo[4],hi[4];
    #pragma unroll
    for(int ks=0;ks<4;++ks){
      asm volatile("ds_read_b64_tr_b16 %0,%1 offset:%c2":"=&v"(lo[ks]):"v"(vb),"i"(d0*4096+ks*1024):"memory");
      asm volatile("ds_read_b64_tr_b16 %0,%1 offset:%c2":"=&v"(hi[ks]):"v"(vb),"i"(d0*4096+ks*1024+512):"memory");}
    asm volatile("s_waitcnt lgkmcnt(0)":::"memory");SBAR();
    #define PK(k) (bf16x8){lo[k][0],lo[k][1],lo[k][2],lo[k][3],hi[k][0],hi[k][1],hi[k][2],hi[k][3]}
    o[d0]=__builtin_amdgcn_mfma_f32_32x32x16_bf16(pa0,PK(0),o[d0],0,0,0);
    o[d0]=__builtin_amdgcn_mfma_f32_32x32x16_bf16(pa1,PK(1),o[d0],0,0,0);
    o[d0]=__builtin_amdgcn_mfma_f32_32x32x16_bf16(pa2,PK(2),o[d0],0,0,0);
    o[d0]=__builtin_amdgcn_mfma_f32_32x32x16_bf16(pa3,PK(3),o[d0],0,0,0);
    #undef PK
  }
}

#ifndef ATTN_STORE16
#define ATTN_STORE16(p,v) (*(u32x4*)(p)=(v))
#endif

using f32x4=__attribute__((ext_vector_type(4)))float;
struct PChunk { f32x4 a, b; };
__device__ __forceinline__ void pchunk_geom(int id, int tk, int tv, int NT, bool& isk, bool& valid, int& kr, int& col, int& ldsoff) {
  isk = id < 512; const int v = id - 512;
  const int g = id & 7, rest = id >> 3, kc = (rest & 1) * 4 + (g & 3), krow = (rest >> 1) * 2 + (g >> 2);
  const int pc = v >> 6, ln = v & 63, vrow = 16 * (pc & 3) + (ln >> 2), vcol = (pc >> 2) * 32 + (ln & 3) * 8;
  const int tile = isk ? tk : tv, row = isk ? krow : vrow; col = isk ? kc * 8 : vcol;
  valid = (tile >= 0) && (tile < NT) && (id < 1536);
  kr = tile * 64 + row;
  const int slot = (tile + 3) % 3;
  ldsoff = isk ? LDS_K + slot * SLOTB + kc * 1024 + krow * 16 : LDS_V + slot * 2 * SLOTB + v * 16;
}
__device__ __forceinline__ PChunk pchunk_load(int id, int tk, int tv, int NT, const float* Kc, const float* Vc, const bf16* Kn, const bf16* Vn) {
  bool isk, valid; int kr, col, ldsoff; pchunk_geom(id, tk, tv, NT, isk, valid, kr, col, ldsoff);
  const char* pf = (const char*)((isk ? Kc : Vc) + (long)kr * 1024 + col);
  const char* pb = (const char*)((isk ? Kn : Vn) + (long)kr * 1024 + col);
  const char* p = (!valid || kr >= 4096 + 32) ? (const char*)Kc : (kr < 4096 ? pf : pb);
  PChunk c; c.a = *(const f32x4*)p; c.b = *(const f32x4*)(p + 16); return c;
}
__device__ __forceinline__ void pchunk_store(const PChunk& c, int id, int tk, int tv, int NT, char* shm) {
  bool isk, valid; int kr, col, ldsoff; pchunk_geom(id, tk, tv, NT, isk, valid, kr, col, ldsoff);
  u32x4 w; w.x = cvtpk_s(c.a[0], c.a[1]); w.y = cvtpk_s(c.a[2], c.a[3]); w.z = cvtpk_s(c.b[0], c.b[1]); w.w = cvtpk_s(c.b[2], c.b[3]);
  const u32x4 raw = __builtin_bit_cast(u32x4, c.a);
  const bool isnew = kr >= 4096 && kr < 4096 + 32, zero = kr >= 4096 + 32;
  w.x = zero ? 0u : isnew ? raw.x : w.x; w.y = zero ? 0u : isnew ? raw.y : w.y; w.z = zero ? 0u : isnew ? raw.z : w.z; w.w = zero ? 0u : isnew ? raw.w : w.w;
  if (valid) *(__attribute__((address_space(3))) u32x4*)((lds_cptr)shm + ldsoff) = w;
}
#define PBAR() asm volatile("s_waitcnt lgkmcnt(0)\n\ts_barrier":::"memory")
__device__ __forceinline__ void sample_producer(const int NT, const float* Kc, const float* Vc, const bf16* Kn, const bf16* Vn, char* shm, int wid, int lane) {
  const int p = (wid - 1) * 64 + lane;
  PChunk a0, a1, a2, a3, b0, b1, b2, b3, c0, c1, c2, c3;
  #define PLOAD(X,tk,tv) do{ X##0=pchunk_load(p,tk,tv,NT,Kc,Vc,Kn,Vn); X##1=pchunk_load(p+448,tk,tv,NT,Kc,Vc,Kn,Vn); X##2=pchunk_load(p+896,tk,tv,NT,Kc,Vc,Kn,Vn); X##3=pchunk_load(p+1344,tk,tv,NT,Kc,Vc,Kn,Vn); }while(0)
  #define PSTORE(X,tk,tv) do{ pchunk_store(X##0,p,tk,tv,NT,shm); pchunk_store(X##1,p+448,tk,tv,NT,shm); pchunk_store(X##2,p+896,tk,tv,NT,shm); pchunk_store(X##3,p+1344,tk,tv,NT,shm); }while(0)
  #define PSTEP(X,s) do{ PSTORE(X,(s)+3,(s)+1); PLOAD(X,(s)+6,(s)+4); PBAR(); }while(0)
  PLOAD(a,0,-1); PLOAD(b,1,0); PLOAD(c,2,-1);
  PSTORE(a,0,-1); PBAR();
  PLOAD(a,3,1);
  PSTORE(b,1,0); PSTORE(c,2,-1); PBAR();
  PLOAD(b,4,2); PLOAD(c,5,3);
  PSTORE(a,3,1); PLOAD(a,6,4); PBAR();
  int s = 1;
  for (; s + 2 <= NT - 2; s += 3) { PSTEP(b, s); PSTEP(c, s + 1); PSTEP(a, s + 2); }
  if (s <= NT - 2) { PSTEP(b, s); ++s; }
  if (s <= NT - 2) { PSTEP(c, s); ++s; }
  PBAR();
  #undef PLOAD
  #undef PSTORE
  #undef PSTEP
}
#undef PBAR
template<int THRL> __device__ __forceinline__ void attn_unit(const int mode,const int NT,const bf16*Qw0,const bf16*__restrict__ Kh,const bf16*__restrict__ Vh,bf16*Ow0,char*shm,const float*Kc,const float*Vc,const int tid_in,const bool pre,const bool pfN,const bf16*KhN,const bf16*VhN){
  int tid0_=tid_in; asm volatile("":"+v"(tid0_));
  const int tid=tid0_,lane=tid&63,r32=lane&31,hi=lane>>5; const int wid=__builtin_amdgcn_readfirstlane(tid>>6);
  const bf16*Qw=Qw0+(long)wid*QBLK*DM; const bool qvalid=(mode==0)||(wid==0); const bool dma=(mode==0);
  if(mode==1&&wid!=0){ sample_producer(NT,Kc,Vc,Kh,Vh,shm,wid,lane); return; }
  const unsigned lds0=(unsigned)(uintptr_t)shm;
  float*wsf=(float*)(shm+LDS_WS)+wid*64;
  const bf16*ksrc=Kh+wid*512+lane*8;
  const bf16*vsrc=Vh+(wid>>2)*2048+(wid&3)*512+lane*8;
  const unsigned kdst=lds0+LDS_K+wid*1024, vdst=lds0+LDS_V+wid*1024;
  #define DMA_K(t,slot) if(dma)glds16(ksrc+(long)(t)*4096,(unsigned)__builtin_amdgcn_readfirstlane(kdst+(slot)))
  #define DMA_V(t,slot) if(dma)do{ glds16(vsrc+(long)(t)*8192,(unsigned)__builtin_amdgcn_readfirstlane(vdst+2*(slot))); glds16(vsrc+(long)(t)*8192+4096,(unsigned)__builtin_amdgcn_readfirstlane(vdst+2*(slot)+8192)); }while(0)
  const int vb0=(int)(lds0+LDS_V)+((lane>>4)&1)*32+(lane&3)*8+(4*hi+((lane&15)>>2))*64;
  const char*Kbase=shm+LDS_K; bf16x8 kf[8];
  const lds_cptr shm3=(lds_cptr)shm; const lds_cptr kp0=shm3+LDS_K+hi*1024+r32*16; const lds_cptr vp0=shm3+LDS_V+((lane>>4)&1)*32+(lane&3)*8+(4*hi+((lane&15)>>2))*64;
  if(!pre){DMA_K(0,0);DMA_V(0,0);DMA_K(1,SLOTB);}
  bf16x8 qr[4];
  #pragma unroll
  for(int d0=0;d0<4;++d0){ if(qvalid)qr[d0]=*reinterpret_cast<const bf16x8*>(&Qw[(long)r32*DM+d0*16+hi*8]); else qr[d0]=bf16x8{}; }
  const lds_cptr qls=(lds_cptr)shm+LDS_OST+wid*4096+lane*16;
  #pragma unroll
  for(int d0=0;d0<4;++d0)*(__attribute__((address_space(3))) bf16x8*)((lds_cptr)qls+d0*1024)=qr[d0];
  #define QLD(d) (*(const __attribute__((address_space(3))) bf16x8*)(qls+(d)*1024))
  bf16x8 qa=qr[0],qb;
  float mhat=0.f,l_reg=0.f;f32x16 o[4];o[0]=f32x16{};o[1]=f32x16{};o[2]=f32x16{};o[3]=f32x16{};f32x16 negm=f32x16{};asm volatile("":"+v"(negm));
  #define CMASK(P0,P1,t) do{int jb_=(t)-(NT-4); if(jb_>=0)bmask(P0,P1,jb_,wid,mode);}while(0)
  bool resc=false;
  #define START(P0,P1) do{ const float rm=rowmax(P0,P1); resc=false; \
    { const float dl=rm; mhat=fadd_s(mhat,dl); \
      _Pragma("unroll") for(int r=0;r<16;++r){P0[r]=fsub_s(P0[r],dl);P1[r]=fsub_s(P1[r],dl);} \
      _Pragma("unroll") for(int r=0;r<16;++r)negm[r]=-mhat; asm volatile("":"+v"(negm)); } \
    _Pragma("unroll") for(int r=0;r<16;++r)P0[r]=__builtin_amdgcn_exp2f(P0[r]); }while(0)
  #define RESC() do{ if(resc){ asm volatile("s_waitcnt lgkmcnt(0)":::"memory"); \
      _Pragma("unroll") for(int d_=0;d_<4;++d_) _Pragma("unroll") for(int r=0;r<16;++r)o[d_][r]*=wsf[crow(r,hi)]; } }while(0)
  f32x16 pA0,pA1,pB0,pB1;
  int sl_prev=0,sl_cur=0,sl_next=SLOTB;
  #define ROT() do{sl_prev=sl_cur;sl_cur=sl_next;sl_next=(sl_next==(NSLOT-1)*SLOTB)?0:sl_next+SLOTB;}while(0)
  DMA_K(2,2*SLOTB);
  WAIT_BAR(4);
  qkt(pA0,pA1,Kbase,qr,negm,r32,hi);asm volatile("s_nop 15\n\ts_nop 7":"+v"(pA0),"+v"(pA1));CMASK(pA0,pA1,0);
  START(pA0,pA1);
  _Pragma("unroll") for(int r=0;r<16;++r)pA1[r]=__builtin_amdgcn_exp2f(pA1[r]);
  WAIT_BAR(0);
  DMA_K(3,0);DMA_V(1,SLOTB);
  ROT();
  kload8(kf,kp0+sl_cur);
  WAIT_BAR(3);
  s16x4 vlo[8],vhi[8]; u32x4 pw0,pw1,pw2,pw3;
  #define PKW(P,B) cvtpk_s(P[B],P[B+1])
  #define PAF(k) __builtin_bit_cast(bf16x8,pw##k)
  #define VFR(i) (bf16x8){vlo[i][0],vlo[i][1],vlo[i][2],vlo[i][3],vhi[i][0],vhi[i][1],vhi[i][2],vhi[i][3]}
  #define PIN(x) asm volatile("":"+v"(x))
  #define MX3(a,b,c) __builtin_fmaxf(__builtin_fmaxf((a),(b)),(c))
  #define GAPA(MF,A0,A1,A2,A3,W0,W1,PW) do{ MF; sacc+=A0; sacc+=A1; sacc+=A2; sacc+=A3; PIN(sacc); W0; W1; PIN(PW); SBAR(); }while(0)
  #define EX(v) __builtin_amdgcn_exp2f(v)
  #define GAPB(MF,X,B) do{ MF; X[B]=EX(X[B]); X[B+1]=EX(X[B+1]); X[B+2]=EX(X[B+2]); X[B+3]=EX(X[B+3]); PIN(X); SBAR(); }while(0)
  #define VRD(i) do{ vlo[i]=vtr(vp_+(((i)>>2)*4096+((i)&3)*1024)); vhi[i]=vtr(vp_+(((i)>>2)*4096+((i)&3)*1024+512)); }while(0)
  #define VRD2(s,i) do{ vlo[s]=vtr(vp_+(((i)>>2)*4096+((i)&3)*1024)); vhi[s]=vtr(vp_+(((i)>>2)*4096+((i)&3)*1024+512)); }while(0)
  #define GAPB2(MF,RD,X,B) do{ MF; RD; X[B]=EX(X[B]); X[B+1]=EX(X[B+1]); PIN(X); SBAR(); }while(0)
  #define KRD(G,j) do{ if(G){ kload2(kf,kp0+sl_next,j); SBAR(); } }while(0)
  #define STEP(C0,C1,P0,P1,t,GK,GV,GL) do{ SBAR(); \
    const lds_cptr vp_=vp0+2*sl_prev; \
    qb=QLD(1); VRD(0); SBAR(); float sacc=(P0[0]+P0[1]); \
    GAPA(C0=__builtin_amdgcn_mfma_f32_32x32x16_bf16(kf[0],qa,negm,0,0,0), P0[2],P0[3],P0[4],P0[5],     pw0[0]=PKW(P0,0), pw0[1]=PKW(P0,2), pw0); \
    VRD(4); SBAR(); GAPA(C1=__builtin_amdgcn_mfma_f32_32x32x16_bf16(kf[1],qa,negm,0,0,0), P0[6],P0[7],P0[8],P0[9],     pw0[2]=PKW(P0,4), pw0[3]=PKW(P0,6), pw0); \
    qa=QLD(2); VRD(1); SBAR(); GAPA(C0=__builtin_amdgcn_mfma_f32_32x32x16_bf16(kf[2],qb,C0,0,0,0),   P0[10],P0[11],P0[12],P0[13], pw1[0]=PKW(P0,8), pw1[1]=PKW(P0,10), pw1); \
    VRD(5); SBAR(); GAPA(C1=__builtin_amdgcn_mfma_f32_32x32x16_bf16(kf[3],qb,C1,0,0,0),   P0[14],P0[15],P1[0],P1[1],   pw1[2]=PKW(P0,12),pw1[3]=PKW(P0,14), pw1); \
    qb=QLD(3); VRD(2); SBAR(); GAPA(C0=__builtin_amdgcn_mfma_f32_32x32x16_bf16(kf[4],qa,C0,0,0,0),   P1[2],P1[3],P1[4],P1[5],     pw2[0]=PKW(P1,0), pw2[1]=PKW(P1,2), pw2); \
    VRD(6); SBAR(); GAPA(C1=__builtin_amdgcn_mfma_f32_32x32x16_bf16(kf[5],qa,C1,0,0,0),   P1[6],P1[7],P1[8],P1[9],     pw2[2]=PKW(P1,4), pw2[3]=PKW(P1,6), pw2); \
    VRD(3); SBAR(); GAPA(C0=__builtin_amdgcn_mfma_f32_32x32x16_bf16(kf[6],qb,C0,0,0,0),   P1[10],P1[11],P1[12],P1[13], pw3[0]=PKW(P1,8), pw3[1]=PKW(P1,10), pw3); \
    VRD(7); SBAR(); GAPA(C1=__builtin_amdgcn_mfma_f32_32x32x16_bf16(kf[7],qb,C1,0,0,0),   P1[14],P1[15],0.f,0.f,       pw3[2]=PKW(P1,12),pw3[3]=PKW(P1,14), pw3); \
    l_reg+=sacc; \
    if(GK){DMA_K((t)+3,sl_cur);} if(GV){DMA_V((t)+1,sl_next);} \
    CMASK(C0,C1,t); \
    SBAR(); float mxa_,mxb_,rm_; \
    do{ o[0]=__builtin_amdgcn_mfma_f32_32x32x16_bf16(PAF(0),VFR(0),o[0],0,0,0); VRD2(0,8); mxa_=MX3(C0[0],C0[1],C1[0]); mxb_=MX3(C0[2],C0[3],C1[1]); mxa_=MX3(mxa_,C1[2],C1[3]); mxa_=MX3(mxa_,C0[4],C0[5]); mxb_=MX3(mxb_,C0[6],C0[7]); PIN(mxa_); PIN(mxb_); SBAR(); }while(0); \
    do{ o[1]=__builtin_amdgcn_mfma_f32_32x32x16_bf16(PAF(0),VFR(4),o[1],0,0,0); VRD2(4,12); mxa_=MX3(mxa_,C1[4],C1[5]); mxb_=MX3(mxb_,C1[6],C1[7]); mxa_=MX3(mxa_,C0[8],C0[9]); mxb_=MX3(mxb_,C0[10],C0[11]); PIN(mxa_); PIN(mxb_); SBAR(); }while(0); \
    do{ o[0]=__builtin_amdgcn_mfma_f32_32x32x16_bf16(PAF(1),VFR(1),o[0],0,0,0); VRD2(1,9); mxa_=MX3(mxa_,C1[8],C1[9]); mxb_=MX3(mxb_,C1[10],C1[11]); mxa_=MX3(mxa_,C0[12],C0[13]); mxb_=MX3(mxb_,C0[14],C0[15]); PIN(mxa_); PIN(mxb_); SBAR(); }while(0); \
    do{ o[1]=__builtin_amdgcn_mfma_f32_32x32x16_bf16(PAF(1),VFR(5),o[1],0,0,0); VRD2(5,13); mxa_=MX3(mxa_,C1[12],C1[13]); mxb_=MX3(mxb_,C1[14],C1[15]); rm_=__builtin_fmaxf(mxa_,mxb_); { auto rr=__builtin_amdgcn_permlane32_swap(__float_as_uint(rm_),__float_as_uint(rm_),false,false); rm_=__builtin_fmaxf(__uint_as_float(rr[0]),__uint_as_float(rr[1])); } PIN(mxa_); PIN(mxb_); SBAR(); }while(0); \
    resc=false; \
    if(__builtin_expect(__any(rm_>(float)THRL),0)){ const float dl=__builtin_fmaxf(rm_,0.f); mhat+=dl; \
      _Pragma("unroll") for(int r=0;r<16;++r){C0[r]-=dl;C1[r]-=dl;} \
      _Pragma("unroll") for(int r=0;r<16;++r)negm[r]=-mhat; asm volatile("":"+v"(negm)); \
      const float f=__builtin_amdgcn_exp2f(-dl); l_reg*=f; if(hi==0)wsf[r32]=f; resc=true; } \
    SBAR(); \
    do{ o[0]=__builtin_amdgcn_mfma_f32_32x32x16_bf16(PAF(2),VFR(2),o[0],0,0,0); VRD2(2,10); C0[0]=EX(C0[0]); C0[1]=EX(C0[1]); PIN(C0); SBAR(); }while(0); \
    do{ o[1]=__builtin_amdgcn_mfma_f32_32x32x16_bf16(PAF(2),VFR(6),o[1],0,0,0); VRD2(6,14); C0[2]=EX(C0[2]); C0[3]=EX(C0[3]); PIN(C0); SBAR(); }while(0); \
    do{ o[0]=__builtin_amdgcn_mfma_f32_32x32x16_bf16(PAF(3),VFR(3),o[0],0,0,0); VRD2(3,11); C0[4]=EX(C0[4]); C0[5]=EX(C0[5]); PIN(C0); SBAR(); }while(0); \
    do{ o[1]=__builtin_amdgcn_mfma_f32_32x32x16_bf16(PAF(3),VFR(7),o[1],0,0,0); VRD2(7,15); C0[6]=EX(C0[6]); C0[7]=EX(C0[7]); PIN(C0); SBAR(); }while(0); \
    do{ o[2]=__builtin_amdgcn_mfma_f32_32x32x16_bf16(PAF(0),VFR(0),o[2],0,0,0); (void)0; C0[8]=EX(C0[8]); C0[9]=EX(C0[9]); C0[10]=EX(C0[10]); C0[11]=EX(C0[11]); PIN(C0); SBAR(); }while(0); \
    KRD(GL,0); do{ o[3]=__builtin_amdgcn_mfma_f32_32x32x16_bf16(PAF(0),VFR(4),o[3],0,0,0); (void)0; C0[12]=EX(C0[12]); C0[13]=EX(C0[13]); PIN(C0); SBAR(); }while(0); \
    KRD(GL,1); do{ o[2]=__builtin_amdgcn_mfma_f32_32x32x16_bf16(PAF(1),VFR(1),o[2],0,0,0); (void)0; C0[14]=EX(C0[14]); C0[15]=EX(C0[15]); PIN(C0); SBAR(); }while(0); \
    KRD(GL,2); do{ o[3]=__builtin_amdgcn_mfma_f32_32x32x16_bf16(PAF(1),VFR(5),o[3],0,0,0); (void)0; C1[0]=EX(C1[0]); C1[1]=EX(C1[1]); PIN(C1); SBAR(); }while(0); \
    KRD(GL,3); do{ o[2]=__builtin_amdgcn_mfma_f32_32x32x16_bf16(PAF(2),VFR(2),o[2],0,0,0); (void)0; C1[2]=EX(C1[2]); C1[3]=EX(C1[3]); PIN(C1); SBAR(); }while(0); \
    do{ o[3]=__builtin_amdgcn_mfma_f32_32x32x16_bf16(PAF(2),VFR(6),o[3],0,0,0); (void)0; C1[4]=EX(C1[4]); C1[5]=EX(C1[5]); C1[6]=EX(C1[6]); C1[7]=EX(C1[7]); PIN(C1); SBAR(); }while(0); \
    do{ o[2]=__builtin_amdgcn_mfma_f32_32x32x16_bf16(PAF(3),VFR(3),o[2],0,0,0); (void)0; C1[8]=EX(C1[8]); C1[9]=EX(C1[9]); C1[10]=EX(C1[10]); C1[11]=EX(C1[11]); PIN(C1); SBAR(); }while(0); \
    do{ o[3]=__builtin_amdgcn_mfma_f32_32x32x16_bf16(PAF(3),VFR(7),o[3],0,0,0); qa=QLD(0); C1[12]=EX(C1[12]); C1[13]=EX(C1[13]); C1[14]=EX(C1[14]); C1[15]=EX(C1[15]); PIN(C1); SBAR(); }while(0); \
    }while(0)
  int t=1;
  #undef CMASK
  #define CMASK(P0,P1,t) do{}while(0)
  for(;t+5<NT;t+=2){
    STEP(pB0,pB1,pA0,pA1,t,true,true,true);     WAIT_BAR(3); RESC(); ROT();
    STEP(pA0,pA1,pB0,pB1,t+1,true,true,true);   WAIT_BAR(3); RESC(); ROT();
  }
  #undef CMASK
  #define CMASK(P0,P1,t) do{int jb_=(t)-(NT-4); if(jb_>=0)bmask(P0,P1,jb_,wid,mode);}while(0)
  #define ENDW(tt) do{ if((tt)+3<NT){WAIT_BAR(3);} else if((tt)+2<NT){WAIT_BAR(2);} else {WAIT_BAR(0);} }while(0)
  for(;t+1<NT;t+=2){
    STEP(pB0,pB1,pA0,pA1,t,(t+3<NT),(t+1<NT),(t+1<NT));       ENDW(t);   RESC(); ROT();
    STEP(pA0,pA1,pB0,pB1,t+1,(t+4<NT),(t+2<NT),(t+2<NT));     ENDW(t+1); RESC(); ROT();
  }
  STEP(pB0,pB1,pA0,pA1,NT-1,false,false,false); RESC();
  { float sacc=pB0[0]+pB0[1]; _Pragma("unroll") for(int r=2;r<16;++r)sacc+=pB0[r]; _Pragma("unroll") for(int r=0;r<16;++r)sacc+=pB1[r]; l_reg+=sacc;
    pw0=(u32x4){PKW(pB0,0),PKW(pB0,2),PKW(pB0,4),PKW(pB0,6)};pw1=(u32x4){PKW(pB0,8),PKW(pB0,10),PKW(pB0,12),PKW(pB0,14)};pw2=(u32x4){PKW(pB1,0),PKW(pB1,2),PKW(pB1,4),PKW(pB1,6)};pw3=(u32x4){PKW(pB1,8),PKW(pB1,10),PKW(pB1,12),PKW(pB1,14)};
    SBAR(); pv(o,vb0+2*sl_cur,PAF(0),PAF(1),PAF(2),PAF(3)); }
  asm volatile("s_waitcnt lgkmcnt(0)\n\ts_barrier":::"memory");
  if(pfN){ const bf16*kn=KhN+wid*512+lane*8; const bf16*vn=VhN+(wid>>2)*2048+(wid&3)*512+lane*8;
    glds16(kn,(unsigned)__builtin_amdgcn_readfirstlane(kdst)); glds16(vn,(unsigned)__builtin_amdgcn_readfirstlane(vdst)); glds16(vn+4096,(unsigned)__builtin_amdgcn_readfirstlane(vdst+8192)); glds16(kn+4096,(unsigned)__builtin_amdgcn_readfirstlane(kdst+SLOTB)); }
  #undef PKW
  #undef PAF
  #undef VFR
  #undef PIN
  #undef MX3
  #undef GAPA
  #undef GAPB
  #undef EX
  #undef VRD
  #undef VRD2
  #undef QLD
  #undef GAPB2
  #undef KRD
  #undef STEP
  #undef ENDW
  {auto rr=__builtin_amdgcn_permlane32_swap(__float_as_uint(l_reg),__float_as_uint(l_reg),false,false);l_reg=__uint_as_float(rr[0])+__uint_as_float(rr[1]);}
  if(hi==0)wsf[32+r32]=l_reg;asm volatile("s_waitcnt lgkmcnt(0)":::"memory");
  float rli[16];
  #pragma unroll
  for(int r=0;r<16;++r)rli[r]=__builtin_amdgcn_rcpf(wsf[32+crow(r,hi)]);
  bf16*Ow=Ow0+(long)wid*QBLK*OPITCH;
  { bf16*stg=(bf16*)(shm+LDS_OST)+wid*2048;
    #pragma unroll
    for(int hp=0;hp<2;++hp){
      #pragma unroll
      for(int r=0;r<16;++r){const int orow=crow(r,hi);
        #pragma unroll
        for(int d0=0;d0<2;++d0)stg[orow*64+d0*32+r32]=__float2bfloat16(o[2*hp+d0][r]*rli[r]);}
      asm volatile("s_waitcnt lgkmcnt(0)":::"memory");
      #pragma unroll
      for(int i=0;i<4;++i){const int row=i*8+(lane>>3),ch=lane&7; const u32x4 v=*(const u32x4*)(stg+row*64+ch*8); if(qvalid)ATTN_STORE16(Ow+(long)row*OPITCH+hp*64+ch*8,v);}
      asm volatile("s_waitcnt lgkmcnt(0)":::"memory"); } }
  asm volatile("s_waitcnt lgkmcnt(0)":::"memory");
  #undef DMA_K
  #undef DMA_V
  #undef CMASK
  #undef START
  #undef RESC
  #undef ROT
}
constexpr int ATTN_LDS_BYTES=LDS_BYTES;
#undef SBAR
#undef WAIT_BAR
}

constexpr int NWAVES = 8;
constexpr int PH_PER_LAYER = 11, NPH = 1 + DEPTH * PH_PER_LAYER;
enum { P_WIN = 0, P_MIXA, P_ATTN, P_MIXC, P_PG, P_MERGE, P_OUT, P_LN1, P_UP, P_DOWN, P_LN2 };

constexpr int CW_TMO = 0, CW_CODE = 1, CW_BAR = 4096;

constexpr int RING_OFF = 0, RING_BYTES = 131072;
constexpr int LDSCTL_OFF = RING_BYTES, MISC_OFF = LDSCTL_OFF + 320;
constexpr int LDS_BYTES = 147456;
static_assert(MISC_OFF + 128 <= LDS_BYTES, "LDS map");

#define GAS __attribute__((address_space(1)))
#define LAS __attribute__((address_space(3)))
typedef unsigned short bf16;
typedef unsigned v4u __attribute__((ext_vector_type(4)));
typedef float f32x4 __attribute__((ext_vector_type(4)));
typedef float f32x16 __attribute__((ext_vector_type(16)));
typedef short bf16x8 __attribute__((ext_vector_type(8)));
typedef GAS unsigned gu32;
#define RLX_AGENT __ATOMIC_RELAXED, __HIP_MEMORY_SCOPE_AGENT
#define LDS_WAIT() asm volatile("s_waitcnt lgkmcnt(0)" ::: "memory")
#define VM_WAIT() asm volatile("s_waitcnt vmcnt(0)" ::: "memory")
__device__ __forceinline__ unsigned f2bf(float f) { unsigned u = __builtin_bit_cast(unsigned, f); return (u + 0x7fffu + ((u >> 16) & 1u)) >> 16; }
__device__ __forceinline__ unsigned pk2(float lo, float hi) { return f2bf(lo) | (f2bf(hi) << 16); }
typedef float pk_f2_t __attribute__((ext_vector_type(2))); typedef __bf16 pk_b2_t __attribute__((ext_vector_type(2)));
__device__ __forceinline__ unsigned pk2hw(float lo, float hi) { const pk_f2_t v = {lo, hi}; const pk_b2_t b = __builtin_convertvector(v, pk_b2_t); return __builtin_bit_cast(unsigned, b); }
__device__ __forceinline__ float bfl(unsigned w) { return __uint_as_float(w << 16); }
__device__ __forceinline__ float bfh(unsigned w) { return __uint_as_float(w & 0xffff0000u); }

#define XB_TMO      128
#define XB_XCNT(j)  (256  + 64 * (j))
#define XB_XSUB(j)  (1280 + 64 * (j))
#define XB_XGEN(j)  (2304 + 64 * (j))
#define XB_TOP      3328
#define XB_TOPGEN   3392
#define XCD_BAR_WORDS 3456
#define XB_SPIN_CAP (1u << 18)

__device__ __forceinline__ unsigned xb_ld(unsigned* p)              { return __hip_atomic_load(p, __ATOMIC_RELAXED, __HIP_MEMORY_SCOPE_AGENT); }
__device__ __forceinline__ unsigned xb_add(unsigned* p, unsigned v) { return __hip_atomic_fetch_add(p, v, __ATOMIC_RELAXED, __HIP_MEMORY_SCOPE_AGENT); }
__device__ __forceinline__ unsigned xb_xcc_id() { return (unsigned)__builtin_amdgcn_s_getreg((3 << 11) | 20) & 0xFu; }
#define XB_SPIN(cond, bar) do { unsigned _sp = 0; while (cond) { __builtin_amdgcn_s_sleep(1); \
    if ((++_sp & 255u) == 0u) { if (xb_ld(&(bar)[XB_TMO])) break; if (_sp > XB_SPIN_CAP) { atomicAdd(&(bar)[XB_TMO], 1u); break; } } } } while (0)

struct XcdBarrier {
    unsigned* bar; unsigned x; int tid;
    volatile LAS unsigned* st;
};

__device__ __forceinline__ XcdBarrier xcd_barrier_post(unsigned* bar, volatile LAS unsigned* st) {
    XcdBarrier b; b.bar = bar; b.x = xb_xcc_id(); b.st = st; b.tid = 0;
    if (threadIdx.x == 0) (void)xb_add(&bar[XB_XCNT(b.x)], 1u);
    return b;
}
__device__ __forceinline__ void xcd_barrier_complete(unsigned* bar, unsigned x, unsigned& nloc, unsigned& nx) {
    const unsigned G = gridDim.x * gridDim.y * gridDim.z;
    unsigned sum, cnt, mine, sp = 0u;
    for (;;) {
        sum = 0u; cnt = 0u; mine = 0u;
#pragma unroll
        for (unsigned j = 0; j < 16; ++j) { const unsigned c = xb_ld(&bar[XB_XCNT(j)]); sum += c; cnt += (c > 0u) ? 1u : 0u; mine = (j == x) ? c : mine; }
        if (sum == G) break;
        __builtin_amdgcn_s_sleep(1);
        if ((++sp & 255u) == 0u) { if (xb_ld(&bar[XB_TMO])) break; if (sp > XB_SPIN_CAP) { atomicAdd(&bar[XB_TMO], 1u); break; } }
    }
    nloc = mine > 0u ? mine : 1u; nx = cnt > 0u ? cnt : 1u;
}

__device__ __forceinline__ void xcd_barrier(const XcdBarrier& b) {
    asm volatile("s_waitcnt vmcnt(0)" ::: "memory");
    __syncthreads();
    if (b.tid == 0) {
        unsigned* bar = b.bar;
        __builtin_amdgcn_s_waitcnt(0);
        unsigned nloc = b.st[0], nx = b.st[1];
        if (nloc == 0u) { xcd_barrier_complete(bar, b.x, nloc, nx); b.st[0] = nloc; b.st[1] = nx; }
        const unsigned old = xb_add(&bar[XB_XSUB(b.x)], 1u);
        const unsigned gen = old / nloc;
        if (old + 1u == (gen + 1u) * nloc) {
            __builtin_amdgcn_fence(__ATOMIC_RELEASE, "agent");
            asm volatile("s_waitcnt vmcnt(0)" ::: "memory");
            const unsigned og = xb_add(&bar[XB_TOP], 1u);
            const unsigned tg = og / nx;
            if (og + 1u == (tg + 1u) * nx) xb_add(&bar[XB_TOPGEN], 1u);
            else XB_SPIN(xb_ld(&bar[XB_TOPGEN]) == tg, bar);
            __builtin_amdgcn_fence(__ATOMIC_ACQUIRE, "agent");
            xb_add(&bar[XB_XGEN(b.x)], 1u);
            asm volatile("s_waitcnt vmcnt(0)" ::: "memory");
        } else {
            XB_SPIN(xb_ld(&bar[XB_XGEN(b.x)]) == gen, bar);
            __builtin_amdgcn_fence(__ATOMIC_ACQUIRE, "agent");
            asm volatile("s_waitcnt vmcnt(0)" ::: "memory");
        }
    }
    __syncthreads();
}

struct Args { const float* in[35]; float* out; unsigned char* ws; int ph_lo, ph_hi, li, pad; };
struct Frame {
    LAS unsigned char* lds;
    volatile LAS unsigned* MISC;
    gu32* ctl;
    int tid, lane, wave;
    int vcu, G;
    float* out;
    unsigned char* ws;
};
__device__ __forceinline__ float wave_sum(float v) {
    v += swz_xor<1>(v); v += swz_xor<2>(v); v += swz_xor<4>(v); v += swz_xor<8>(v); v += swz_xor<16>(v);
    { auto rr = __builtin_amdgcn_permlane32_swap(__float_as_uint(v), __float_as_uint(v), false, false); v = __uint_as_float(rr[0]) + __uint_as_float(rr[1]); }
    return v;
}
__device__ __forceinline__ void p0_transpose_item(const float* W, int K, int N, bf16* WT, int row_off, LAS float* scr, int item, int lane) {
    const int nblk = N / 32, kb = item / nblk, nb = item % nblk, k0 = 64 * kb, n0 = 32 * nb;
#pragma unroll 8
    for (int i = 0; i < 32; ++i) { const int kk = 2 * i + (lane >> 5); scr[kk * 33 + (lane & 31)] = W[(size_t)(k0 + kk) * N + n0 + (lane & 31)]; }
    LDS_WAIT(); asm volatile("" ::: "memory");
    const int c = lane & 7;
#pragma unroll
    for (int j = 0; j < 4; ++j) { const int n = (lane >> 3) + 8 * j; const LAS float* s = scr + (8 * c) * 33 + n;
        v4u o; o.x = pk2(s[0 * 33], s[1 * 33]); o.y = pk2(s[2 * 33], s[3 * 33]); o.z = pk2(s[4 * 33], s[5 * 33]); o.w = pk2(s[6 * 33], s[7 * 33]);
        *(GAS v4u*)(WT + (size_t)(row_off + n0 + n) * K + k0 + 8 * c) = o; }
    LDS_WAIT(); asm volatile("" ::: "memory");
}

__device__ __forceinline__ void p0_transpose64(const float* W, int N, int nblk, bf16* WT, int ldo, int item, int lane) {
    const int kb = item / nblk, nb = item % nblk, k0 = 64 * kb, n0 = 64 * nb, n4 = lane & 15, kq = lane >> 4;
    f32x4 v[16];
#pragma unroll
    for (int j = 0; j < 16; ++j) v[j] = *(const GAS f32x4*)(W + (size_t)(k0 + kq * 16 + j) * N + n0 + 4 * n4);
#pragma unroll
    for (int e = 0; e < 4; ++e) { v4u c0, c1;
        c0.x = pk2hw(v[0][e], v[1][e]); c0.y = pk2hw(v[2][e], v[3][e]); c0.z = pk2hw(v[4][e], v[5][e]); c0.w = pk2hw(v[6][e], v[7][e]);
        c1.x = pk2hw(v[8][e], v[9][e]); c1.y = pk2hw(v[10][e], v[11][e]); c1.z = pk2hw(v[12][e], v[13][e]); c1.w = pk2hw(v[14][e], v[15][e]);
        bf16* o = WT + (size_t)(n0 + 4 * n4 + e) * ldo + k0 + kq * 16; *(GAS v4u*)o = c0; *(GAS v4u*)(o + 8) = c1; }
}

__device__ __forceinline__ void dsincos(double x, double& s, double& c) {
    const double TWO_PI = 6.283185307179586476925287, HALF_PI = 1.570796326794896619231322;
    x -= TWO_PI * __builtin_rint(x * (1.0 / TWO_PI));
    const double kq = __builtin_rint(x * (1.0 / HALF_PI)); const double r = x - kq * HALF_PI; const int k = ((int)kq) & 3; const double r2 = r * r;
    double sp = -1.0 / 1307674368000.0; sp = sp * r2 + 1.0 / 6227020800.0; sp = sp * r2 - 1.0 / 39916800.0; sp = sp * r2 + 1.0 / 362880.0; sp = sp * r2 - 1.0 / 5040.0; sp = sp * r2 + 1.0 / 120.0; sp = sp * r2 - 1.0 / 6.0; sp = sp * r2 * r + r;
    double cp = 1.0 / 20922789888000.0; cp = cp * r2 - 1.0 / 87178291200.0; cp = cp * r2 + 1.0 / 479001600.0; cp = cp * r2 - 1.0 / 3628800.0; cp = cp * r2 + 1.0 / 40320.0; cp = cp * r2 - 1.0 / 720.0; cp = cp * r2 + 1.0 / 24.0; cp = cp * r2 - 0.5; cp = cp * r2 + 1.0;
    s = (k == 0) ? sp : (k == 1) ? cp : (k == 2) ? -sp : -cp;
    c = (k == 0) ? cp : (k == 1) ? -sp : (k == 2) ? -cp : sp;
}
__device__ __forceinline__ double dexp(double x) {
    const double LN2 = 0.693147180559945309417232; const double n = __builtin_rint(x * (1.0 / LN2)); const double r = x - n * LN2;
    double p = 1.0 / 6227020800.0; p = p * r + 1.0 / 479001600.0; p = p * r + 1.0 / 39916800.0; p = p * r + 1.0 / 3628800.0; p = p * r + 1.0 / 362880.0; p = p * r + 1.0 / 40320.0; p = p * r + 1.0 / 5040.0;
    p = p * r + 1.0 / 720.0; p = p * r + 1.0 / 120.0; p = p * r + 1.0 / 24.0; p = p * r + 1.0 / 6.0; p = p * r + 0.5; p = p * r + 1.0; p = p * r + 1.0;
    return __builtin_ldexp(p, (int)n);
}

enum { I_XP = 0, I_XS, I_CK, I_CV, I_SRE, I_SIM, I_SCONV, I_SPOOL, I_WIN, I_POOLW, I_PSCALE, I_ARE, I_AIM, I_LOGDT, I_BRE, I_BIM, I_CRE, I_CIM, I_SD, I_WGLU, I_CONVW, I_CONVB,
       I_LQ1, I_LK1, I_LQ2, I_LK2, I_SUBLN, I_WBR, I_WOUT, I_LN1G, I_LN1B, I_WUP, I_WDN, I_LN2G, I_LN2B };

constexpr int I_IN0 = (DM / 64) * (N_IN / 64);
__device__ __forceinline__ void p0_weights(Frame& F, const Args& A, int first, int last, int wv, int nw) {
    unsigned char* ws = F.ws;
    constexpr int I_IN = (DM / 64) * (N_IN / 64), I_BR = (BR_W / 64) * (DM / 64), I_OUT = (DM / 64) * (DM / 64), I_UP = (DM / 64) * (D_FF / 64), I_DN = (D_FF / 64) * (DM / 64), I_GLU = (512 / 64) * (512 / 64), I_PF = (512 / 8) * (DM / 64);
    constexpr int PER_L = I_IN + I_BR + I_OUT + I_UP + I_DN + I_GLU + I_PF;
    if (last > DEPTH * PER_L) last = DEPTH * PER_L;
    for (int it = first + wv; it < last; it += nw) {
        const int l = it / PER_L; int r = it % PER_L; unsigned char* wl = ws + WS_W + (size_t)l * W_LSTRIDE;
        if (r < I_IN) { p0_transpose64(A.in[I_WIN] + (size_t)l * DM * N_IN, N_IN, N_IN / 64, (bf16*)(wl + W_IN), DM, r, F.lane); continue; } r -= I_IN;
        if (r < I_BR) { if (r >= 8 * (DM / 64)) p0_transpose64(A.in[I_WBR] + (size_t)l * BR_W * DM, DM, DM / 64, (bf16*)(wl + W_BR), BR_W, r, F.lane); continue; } r -= I_BR;
        if (r < I_OUT) { p0_transpose64(A.in[I_WOUT] + (size_t)l * DM * DM, DM, DM / 64, (bf16*)(wl + W_OUT), DM, r, F.lane); continue; } r -= I_OUT;
        if (r < I_UP) { p0_transpose64(A.in[I_WUP] + (size_t)l * DM * D_FF, D_FF, D_FF / 64, (bf16*)(wl + W_UP), DM, r, F.lane); continue; } r -= I_UP;
        if (r < I_DN) { p0_transpose64(A.in[I_WDN] + (size_t)l * D_FF * DM, DM, DM / 64, (bf16*)(wl + W_DN), D_FF, r, F.lane); continue; } r -= I_DN;
        if (r < I_GLU) { p0_transpose64(A.in[I_WGLU] + (size_t)l * 512 * 512, 512, 512 / 64, (bf16*)(wl + W_GLU), 512, r, F.lane); continue; } r -= I_GLU;
        {
            const int k0 = (r >> 4) * 8, d = (r & 15) * 64 + F.lane, g = k0 >> 7;
            const float* pw = A.in[I_POOLW] + (((size_t)l * 4 + g) * 128 + (k0 & 127)) * 128; const float* sc = A.in[I_PSCALE] + (size_t)l * 512 + g * 128; const float* wb = A.in[I_WBR] + ((size_t)l * BR_W + g * 128) * DM + d;
            float acc8[8];
#pragma unroll
            for (int e = 0; e < 8; ++e) acc8[e] = 0.f;
#pragma unroll 1
            for (int jb = 0; jb < 128; jb += 8) {
                float w8[8]; f32x4 s4[2], p4[8][2];
#pragma unroll
                for (int jj = 0; jj < 8; ++jj) w8[jj] = *(const GAS float*)(wb + (size_t)(jb + jj) * DM);
                s4[0] = *(const GAS f32x4*)(sc + jb); s4[1] = *(const GAS f32x4*)(sc + jb + 4);
#pragma unroll
                for (int e = 0; e < 8; ++e) { p4[e][0] = *(const GAS f32x4*)(pw + e * 128 + jb); p4[e][1] = *(const GAS f32x4*)(pw + e * 128 + jb + 4); }
                __builtin_amdgcn_sched_barrier(0);
#pragma unroll
                for (int jj = 0; jj < 8; ++jj) { const float wv = s4[jj >> 2][jj & 3] * w8[jj];
#pragma unroll
                    for (int e = 0; e < 8; ++e) acc8[e] += p4[e][jj >> 2][jj & 3] * wv; }
                __builtin_amdgcn_sched_barrier(0);
            }
            v4u o; o.x = pk2(acc8[0], acc8[1]); o.y = pk2(acc8[2], acc8[3]); o.z = pk2(acc8[4], acc8[5]); o.w = pk2(acc8[6], acc8[7]);
            *(GAS v4u*)((bf16*)(wl + W_BR) + (size_t)d * BR_W + k0) = o; }
    }
}
__device__ __forceinline__ void p0_prologue(Frame& F, const Args& A) {
    LAS float* scr = (LAS float*)(F.lds + RING_OFF + F.wave * 16384);
    const int gw = F.vcu * NWAVES + F.wave, NGW = F.G * NWAVES;
    const int gt = gw * 64 + F.lane, NGT = NGW * 64;
    unsigned char* ws = F.ws;
    p0_weights(F, A, 0, I_IN0, gw, NGW);
    for (int m = gw; m < M_T; m += NGW) {
        const float* xr = m < M_P ? A.in[I_XP] + (size_t)m * DM : A.in[I_XS] + (size_t)(m - M_P) * DM;
        const GAS f32x4* x4 = (const GAS f32x4*)xr + F.lane; GAS unsigned long long* o8 = (GAS unsigned long long*)((bf16*)(ws + WS_XB) + (size_t)m * DM) + F.lane;
        f32x4 v[4];
#pragma unroll
        for (int j = 0; j < 4; ++j) v[j] = x4[64 * j];
#pragma unroll
        for (int j = 0; j < 4; ++j) o8[64 * j] = (unsigned long long)pk2(v[j].x, v[j].y) | ((unsigned long long)pk2(v[j].z, v[j].w) << 32);
    }
    for (int i = gt; i < SEQ * 8; i += NGT) { const int pos = i >> 3, k = i & 7;
        const double inv = dexp(-(double)k * (13.122363377404328 / 8.0)); double s, c; dsincos((double)pos * inv, s, c);
        float* rp = (float*)(ws + WS_ROPE) + (size_t)pos * 16; rp[k] = (float)c; rp[8 + k] = (float)s; }
    for (int i = gt; i < DEPTH * 2048; i += NGT) { const int l = i >> 11, gp = i & 2047, g = gp >> 6, p = gp & 63;
        unsigned char* sc = ws + WS_SSMC + (size_t)l * SSMC_LSTRIDE;
        const double dt = dexp((double)A.in[I_LOGDT][l * 32 + g]), are = (double)A.in[I_ARE][i], aim = (double)A.in[I_AIM][i];
        const double mag = dexp(are * dt); double sn, cs; dsincos(aim * dt, sn, cs);
        const double abr = mag * cs, abi = mag * sn, den = are * are + aim * aim;
        const double cr = ((abr - 1.0) * are + abi * aim) / den, ci = (abi * are - (abr - 1.0) * aim) / den;
        ((float2*)(sc + SC_AB))[gp] = make_float2((float)abr, (float)abi);
        const double m64 = dexp(are * dt * 64.0); double s64, c64; dsincos(aim * dt * 64.0, s64, c64);
        ((float2*)(sc + SC_A64))[gp] = make_float2((float)(m64 * c64), (float)(m64 * s64));
        bf16* BB = (bf16*)(sc + SC_BB) + (size_t)g * 128 * 16;
#pragma unroll 4
        for (int n = 0; n < 16; ++n) { const double bre = (double)A.in[I_BRE][(size_t)i * 16 + n], bim = (double)A.in[I_BIM][(size_t)i * 16 + n];
            BB[p * 16 + n] = (bf16)f2bf((float)(cr * bre - ci * bim)); BB[(64 + p) * 16 + n] = (bf16)f2bf((float)(cr * bim + ci * bre)); }
    }
    for (int i = gt; i < DEPTH * 32 * 16 * 64; i += NGT) { const int l = i >> 15, r = i & 32767, gn = r >> 6, p = r & 63;
        bf16* CM = (bf16*)(ws + WS_SSMC + (size_t)l * SSMC_LSTRIDE + SC_CM) + (size_t)gn * 128;
        CM[2 * p] = (bf16)f2bf(A.in[I_CRE][i]); CM[2 * p + 1] = (bf16)f2bf(-A.in[I_CIM][i]); }
}

__device__ __forceinline__ float gelu_tanh(float y) {
    const float z = 0.7978845608028654f * (y + 0.044715f * y * y * y);
    const float e = __builtin_amdgcn_exp2f(2.885390081777927f * z);
    const float th = 1.0f - 2.0f * __builtin_amdgcn_rcpf(1.0f + e);
    return 0.5f * y * (1.0f + th);
}
struct SsmGrp { float2 ab; bf16x8 bfr[4]; bf16x8 afr0, afr1; float sre, sim; bf16x8 cfr[4]; float dsk; };
template <bool PASSB> __device__ __forceinline__ SsmGrp ssm_load_group(Frame& F, const Args& A, int l, int ch, int g, bool smp, int row0) {
    const int lane = F.lane, r32 = lane & 31, hi = lane >> 5, fr = lane & 15, fq = lane >> 4;
    const unsigned char* sc = F.ws + WS_SSMC + (size_t)l * SSMC_LSTRIDE;
    const bf16* BB = (const bf16*)(sc + SC_BB); const bf16* CM = (const bf16*)(sc + SC_CM); const bf16* US = (const bf16*)(F.ws + WS_US);
    SsmGrp d;
    d.ab = ((const float2*)(sc + SC_AB))[g * 64 + lane];
#pragma unroll
    for (int cb = 0; cb < 4; ++cb) d.bfr[cb] = *(const bf16x8*)(BB + ((size_t)g * 128 + cb * 32 + r32) * 16 + 8 * hi);
    d.afr0 = *(const bf16x8*)(US + (size_t)(row0 + r32) * 512 + g * 16 + 8 * hi);
    d.afr1 = smp ? d.afr0 : *(const bf16x8*)(US + (size_t)(row0 + 32 + r32) * 512 + g * 16 + 8 * hi);
    d.sre = 0.f; d.sim = 0.f; d.dsk = 0.f;
#pragma unroll
    for (int kb = 0; kb < 4; ++kb) d.cfr[kb] = bf16x8{};
    if (PASSB) {
        if (smp) { const size_t si = ((size_t)(l * NB_S + (ch - NCH_P)) * 32 + g) * 64 + lane; d.sre = A.in[I_SRE][si]; d.sim = A.in[I_SIM][si]; }
        else { const float2 h = ((const float2*)(F.ws + WS_H))[((size_t)ch * 32 + g) * 64 + lane]; d.sre = h.x; d.sim = h.y; }
#pragma unroll
        for (int kb = 0; kb < 4; ++kb) d.cfr[kb] = *(const bf16x8*)(CM + ((size_t)g * 16 + fr) * 128 + kb * 32 + 8 * fq);
        d.dsk = A.in[I_SD][l * 512 + g * 16 + fr];
    }
    return d;
}
template <bool PASSB> __device__ __forceinline__ void ssm_pass(Frame& F, const Args& A, int l) {
    LAS unsigned char* wl = F.lds + RING_OFF + F.wave * 9728;
    LAS unsigned* ST32 = (LAS unsigned*)wl; LAS unsigned short* ST = (LAS unsigned short*)wl; LAS unsigned short* UT = (LAS unsigned short*)(wl + 8704);
    const int lane = F.lane, r32 = lane & 31, hi = lane >> 5, fr = lane & 15, fq = lane >> 4;
    unsigned char* ws = F.ws;
    bf16* VS_ = (bf16*)(ws + WS_VSSM); float2* Eb = (float2*)(ws + WS_E);
    const int nprompt = (NCH_P - F.vcu + F.G - 1) / F.G; const int nsmp = PASSB ? (NB_S * 32 - (F.vcu * NWAVES + F.wave) + F.G * NWAVES - 1) / (F.G * NWAVES) : 0;
#pragma unroll 1
    for (int it = 0; it < nprompt + nsmp; ++it) {
        const bool smp = it >= nprompt; const int sidx = F.vcu * NWAVES + F.wave + (it - nprompt) * F.G * NWAVES;
        const int ch = smp ? NCH_P + (sidx >> 5) : F.vcu + it * F.G; const int row0 = smp ? M_P + (ch - NCH_P) * 32 : ch * 64; const int nhalf = smp ? 1 : 2;
        const int g0 = smp ? (sidx & 31) : F.wave * 4, ng = smp ? 1 : 4;
        SsmGrp cur = ssm_load_group<PASSB>(F, A, l, ch, g0, smp, row0);
#pragma unroll 1
        for (int gi = 0; gi < ng; ++gi) {
            const int g = g0 + gi;
            const SsmGrp nxt = ssm_load_group<PASSB>(F, A, l, ch, g0 + (gi < ng - 1 ? gi + 1 : ng - 1), smp, row0);
            const float2 ab = cur.ab; float sre = cur.sre, sim = cur.sim;
#pragma unroll 1
            for (int hf = 0; hf < nhalf; ++hf) {
                const int rbase = row0 + hf * 32;
                const bf16x8 afr = hf ? cur.afr1 : cur.afr0;
                if (PASSB) *(LAS bf16x8*)(UT + r32 * 16 + 8 * hi) = afr;
                f32x16 c[4];
#pragma unroll
                for (int cb = 0; cb < 4; ++cb) c[cb] = __builtin_amdgcn_mfma_f32_32x32x16_bf16(afr, cur.bfr[cb], (f32x16){}, 0, 0, 0);
#pragma unroll
                for (int i = 0; i < 16; ++i) {
                    { auto rr = __builtin_amdgcn_permlane32_swap(__float_as_uint(c[0][i]), __float_as_uint(c[1][i]), false, false); c[0][i] = __uint_as_float(rr[0]); c[1][i] = __uint_as_float(rr[1]); }
                    { auto rr = __builtin_amdgcn_permlane32_swap(__float_as_uint(c[2][i]), __float_as_uint(c[3][i]), false, false); c[2][i] = __uint_as_float(rr[0]); c[3][i] = __uint_as_float(rr[1]); } }
#pragma unroll
                for (int t = 0; t < 32; ++t) {
                    const int i = (t & 3) + 4 * (t >> 3), h = (t >> 2) & 1;
                    const float bre = c[h][i], bim = c[2 + h][i];
                    float nre = __builtin_fmaf(ab.x, sre, __builtin_fmaf(-ab.y, sim, bre)); asm volatile("" : "+v"(nre));
                    const float nim = __builtin_fmaf(ab.x, sim, __builtin_fmaf(ab.y, sre, bim)); sre = nre; sim = nim;
                    if (PASSB) ST32[t * 68 + lane] = pk2hw(sre, sim);
                }
                if (PASSB) {
#pragma unroll
                    for (int q = 0; q < 2; ++q) {
                        pg8::f32x4 y = {0.f, 0.f, 0.f, 0.f};
#pragma unroll
                        for (int kb = 0; kb < 4; ++kb) { const bf16x8 a = *(const LAS bf16x8*)(ST + (16 * q + fr) * 136 + kb * 32 + 8 * fq); y = __builtin_amdgcn_mfma_f32_16x16x32_bf16(a, cur.cfr[kb], y, 0, 0, 0); }
#pragma unroll
                        for (int j = 0; j < 4; ++j) { const int tok = 16 * q + fq * 4 + j;
                            const float u = __uint_as_float((unsigned)UT[tok * 16 + fr] << 16); UT[tok * 16 + fr] = (unsigned short)f2bf(gelu_tanh(y[j] + cur.dsk * u)); }
                    }
                    { const v4u w = *(const LAS v4u*)(UT + (lane >> 1) * 16 + (lane & 1) * 8); *(GAS v4u*)(VS_ + (size_t)(rbase + (lane >> 1)) * 512 + g * 16 + (lane & 1) * 8) = w; }
                }
            }
            if (!PASSB) Eb[((size_t)ch * 32 + g) * 64 + lane] = make_float2(sre, sim);
            else if (smp) { const size_t oi = ((size_t)(l * NB_S + (ch - NCH_P)) * 32 + g) * 64 + lane; F.out[O_SRS + oi] = sre; F.out[O_SIS + oi] = sim; }
            else if ((ch & 255) == 255) { const size_t oi = ((size_t)(l * NB_P + (ch >> 8)) * 32 + g) * 64 + lane; F.out[O_SRP + oi] = sre; F.out[O_SIP + oi] = sim; }
            cur = nxt;
        }
    }
}
__device__ __forceinline__ void ssm_carry(Frame& F, int l) {
    const int gw = F.vcu * NWAVES + F.wave; if (gw >= NB_P * 32) return;
    const int b = gw >> 5, g = gw & 31;
    const float2 a = ((const float2*)(F.ws + WS_SSMC + (size_t)l * SSMC_LSTRIDE + SC_A64))[g * 64 + F.lane];
    const float2* Eb = (const float2*)(F.ws + WS_E) + ((size_t)b * 256 * 32 + g) * 64 + F.lane; float2* Hb = (float2*)(F.ws + WS_H) + ((size_t)b * 256 * 32 + g) * 64 + F.lane;
    float hr = 0.f, hi_ = 0.f;
    float2 cur[32], nxt[32];
#pragma unroll
    for (int j = 0; j < 32; ++j) cur[j] = Eb[(size_t)j * 2048];
#pragma unroll 1
    for (int c0 = 0; c0 < 256; c0 += 32) {
        if (c0 + 32 < 256) {
#pragma unroll
            for (int j = 0; j < 32; ++j) nxt[j] = Eb[(size_t)(c0 + 32 + j) * 2048]; }
#pragma unroll
        for (int j = 0; j < 32; ++j) { Hb[(size_t)(c0 + j) * 2048] = make_float2(hr, hi_);
            const float nr = a.x * hr - a.y * hi_ + cur[j].x, ni = a.x * hi_ + a.y * hr + cur[j].y; hr = nr; hi_ = ni; }
#pragma unroll
        for (int j = 0; j < 32; ++j) cur[j] = nxt[j];
    }
}

__device__ __forceinline__ void ld8b(const bf16* p, float (&v)[8]) { const v4u w = *(const GAS v4u*)p; v[0] = bfl(w.x); v[1] = bfh(w.x); v[2] = bfl(w.y); v[3] = bfh(w.y); v[4] = bfl(w.z); v[5] = bfh(w.z); v[6] = bfl(w.w); v[7] = bfh(w.w); }
__device__ __forceinline__ void ld8f(const float* p, float (&v)[8]) { const f32x4 a = *(const GAS f32x4*)p, b = *(const GAS f32x4*)(p + 4); v[0] = a.x; v[1] = a.y; v[2] = a.z; v[3] = a.w; v[4] = b.x; v[5] = b.y; v[6] = b.z; v[7] = b.w; }
__device__ __forceinline__ void st8b(bf16* p, const float (&v)[8]) { v4u w; w.x = pk2(v[0], v[1]); w.y = pk2(v[2], v[3]); w.z = pk2(v[4], v[5]); w.w = pk2(v[6], v[7]); *(GAS v4u*)p = w; }
__device__ __forceinline__ void st8f(float* p, const float (&v)[8]) { *(GAS f32x4*)p = (f32x4){v[0], v[1], v[2], v[3]}; *(GAS f32x4*)(p + 4) = (f32x4){v[4], v[5], v[6], v[7]}; }
__device__ __forceinline__ void up8(const v4u w, float (&v)[8]) { v[0] = bfl(w.x); v[1] = bfh(w.x); v[2] = bfl(w.y); v[3] = bfh(w.y); v[4] = bfl(w.z); v[5] = bfh(w.z); v[6] = bfl(w.w); v[7] = bfh(w.w); }
__device__ __forceinline__ v4u ldrow_or_hist(const bf16* cur, const float* hist, bool use_cur, bool use_hist) {
    if (use_cur) return *(const GAS v4u*)cur;
    if (use_hist) { float h[8]; ld8f(hist, h); v4u w; w.x = pk2(h[0], h[1]); w.y = pk2(h[2], h[3]); w.z = pk2(h[4], h[5]); w.w = pk2(h[6], h[7]); return w; }
    return (v4u){0u, 0u, 0u, 0u};
}
template <int W> __device__ __forceinline__ void pool8(const bf16* ZP, const float* hist  , bf16* UP, float* st_out  , int st_t0  ,
                                                       int row0, int t0, bool smp, int c0) {
    v4u zr[W + 7];
#pragma unroll
    for (int k = 0; k < W + 7; ++k) { const int tk = t0 - (W - 1) + k;
        zr[k] = ldrow_or_hist(ZP + (size_t)(row0 - (W - 1) + k) * 512 + c0, hist + (size_t)(15 + tk) * 512 + c0, tk >= 0, smp && tk < 0); }
    float S[8];
#pragma unroll
    for (int e = 0; e < 8; ++e) S[e] = 0.f;
#pragma unroll
    for (int k = 0; k < W - 1; ++k) { float z[8]; up8(zr[k], z);
#pragma unroll
        for (int e = 0; e < 8; ++e) S[e] += z[e]; }
#pragma unroll
    for (int i = 0; i < 8; ++i) { float z[8]; up8(zr[i + W - 1], z);
#pragma unroll
        for (int e = 0; e < 8; ++e) S[e] += z[e];
        const int t = t0 + i; const int cnt = smp ? W : (t + 1 < W ? t + 1 : W); const float inv = 1.0f / (float)cnt;
        float uo[8];
#pragma unroll
        for (int e = 0; e < 8; ++e) uo[e] = S[e] * inv - z[e];
        st8b(UP + (size_t)(row0 + i) * BR_W + c0, uo);
        if (st_out && t >= st_t0) st8f(st_out + (size_t)(t - st_t0) * 512 + c0, z);
        float zo[8]; up8(zr[i], zo);
#pragma unroll
        for (int e = 0; e < 8; ++e) S[e] -= zo[e]; }
}
template <int W> __device__ __forceinline__ void pool8_fast(const bf16* ZP, bf16* UP, float* st_out, int st_t0, int row0, int t0, bool smp, int c0) {
    v4u zr[W + 7];
#pragma unroll
    for (int k = 0; k < W + 7; ++k) { const int rk = row0 - (W - 1) + k; zr[k] = *(const GAS v4u*)(ZP + (size_t)(rk < 0 ? 0 : rk) * 512 + c0); }
#pragma unroll
    for (int k = 0; k < W - 1; ++k) { const bool neg = t0 - (W - 1) + k < 0; zr[k].x = neg ? 0u : zr[k].x; zr[k].y = neg ? 0u : zr[k].y; zr[k].z = neg ? 0u : zr[k].z; zr[k].w = neg ? 0u : zr[k].w; }
    float S[8];
#pragma unroll
    for (int e = 0; e < 8; ++e) S[e] = 0.f;
#pragma unroll
    for (int k = 0; k < W - 1; ++k) { float z[8]; up8(zr[k], z);
#pragma unroll
        for (int e = 0; e < 8; ++e) S[e] += z[e]; }
#pragma unroll
    for (int i = 0; i < 8; ++i) { float z[8]; up8(zr[i + W - 1], z);
#pragma unroll
        for (int e = 0; e < 8; ++e) S[e] += z[e];
        const int t = t0 + i; const int cnt = smp ? W : (t + 1 < W ? t + 1 : W); const float inv = 1.0f / (float)cnt;
        float uo[8];
#pragma unroll
        for (int e = 0; e < 8; ++e) uo[e] = S[e] * inv - z[e];
        st8b(UP + (size_t)(row0 + i) * BR_W + c0, uo);
        if (st_out && t >= st_t0) st8f(st_out + (size_t)(t - st_t0) * 512 + c0, z);
        float zo[8]; up8(zr[i], zo);
#pragma unroll
        for (int e = 0; e < 8; ++e) S[e] -= zo[e]; }
}
__device__ __forceinline__ void mixa_elem(Frame& F, const Args& A, int l) {
    unsigned char* ws = F.ws;
    const bf16* ZP = (const bf16*)(ws + WS_ZP); const bf16* HC = (const bf16*)(ws + WS_HC); const bf16* BC = (const bf16*)(ws + WS_BC); const bf16* CC = (const bf16*)(ws + WS_CC);
    bf16* OALL = (bf16*)(ws + WS_OALL); bf16* UP = OALL;
    const int gi = F.wave & 3, c0 = (gi * 16 + (F.lane & 15)) * 8, rsub = (F.wave >> 2) * 4 + (F.lane >> 4);
    float cw0[8], cw1[8], cw2[8], cbias[8];
    ld8f(A.in[I_CONVW] + (size_t)(l * 3 + 0) * 512 + c0, cw0); ld8f(A.in[I_CONVW] + (size_t)(l * 3 + 1) * 512 + c0, cw1); ld8f(A.in[I_CONVW] + (size_t)(l * 3 + 2) * 512 + c0, cw2); ld8f(A.in[I_CONVB] + (size_t)l * 512 + c0, cbias);
    const int nptile = (M_P / 64 - F.vcu + F.G - 1) / F.G; const int nstile = (64 - F.vcu + F.G - 1) / F.G;
#pragma unroll 1
    for (int it = 0; it < nptile + nstile; ++it) {
        const bool stile = it >= nptile; const int sidx = F.vcu + (it - nptile) * F.G;
        if (stile && F.wave != (sidx & 7)) continue;
        const int tile = stile ? M_P / 64 + (sidx >> 3) : F.vcu + it * F.G;
        const int row0 = tile * 64 + rsub * 8; const bool smp = row0 >= M_P; const int loc = row0 - M_P;
        const int t0 = smp ? (loc & 31) : (row0 & (SEQ - 1)), b = smp ? (loc >> 5) : (row0 >> 14);
        const float* hist = smp ? A.in[I_SPOOL] + (size_t)(l * NB_S + b) * 15 * 512 : nullptr;
        float* st_out = smp ? F.out + O_PS + (size_t)(l * NB_S + b) * 15 * 512 : F.out + O_PP + (size_t)(l * NB_P + b) * 15 * 512;
        const int L = smp ? SEQ_S : SEQ;
        if (t0 + 8 <= L - 15) st_out = nullptr;
        if (smp && t0 < 15) {
            if (gi == 0) pool8<2>(ZP, hist, UP, st_out, L - 15, row0, t0, smp, c0);
            else if (gi == 1) pool8<4>(ZP, hist, UP, st_out, L - 15, row0, t0, smp, c0);
            else if (gi == 2) pool8<8>(ZP, hist, UP, st_out, L - 15, row0, t0, smp, c0);
            else pool8<16>(ZP, hist, UP, st_out, L - 15, row0, t0, smp, c0);
            const float* chist = smp ? A.in[I_SCONV] + (size_t)(l * NB_S + b) * 2 * 512 : nullptr;
            float* cst = smp ? F.out + O_CS + (size_t)(l * NB_S + b) * 2 * 512 : F.out + O_CP + (size_t)(l * NB_P + b) * 2 * 512;
            v4u hr[10], cr[10], br[8];
    #pragma unroll
            for (int k = 0; k < 10; ++k) { const int tk = t0 - 2 + k;
                if (tk >= 0) { hr[k] = *(const GAS v4u*)(HC + (size_t)(row0 - 2 + k) * 512 + c0); cr[k] = *(const GAS v4u*)(CC + (size_t)(row0 - 2 + k) * 512 + c0); }
                else { hr[k] = (v4u){0u, 0u, 0u, 0u}; cr[k] = hr[k]; } }
    #pragma unroll
            for (int k = 0; k < 8; ++k) br[k] = *(const GAS v4u*)(BC + (size_t)(row0 + k) * 512 + c0);
            float z2[8], z1[8];
            {   float h_[8], c_[8];
                if (t0 >= 2 || !smp) { up8(hr[0], h_); up8(cr[0], c_);
    #pragma unroll
                    for (int e = 0; e < 8; ++e) z2[e] = h_[e] * c_[e]; } else ld8f(chist + (size_t)(t0) * 512 + c0, z2);
                if (t0 >= 1 || !smp) { up8(hr[1], h_); up8(cr[1], c_);
    #pragma unroll
                    for (int e = 0; e < 8; ++e) z1[e] = h_[e] * c_[e]; } else ld8f(chist + (size_t)(t0 + 1) * 512 + c0, z1); }
    #pragma unroll
            for (int i = 0; i < 8; ++i) { float h_[8], c_[8], z0[8], bb[8], y[8]; up8(hr[i + 2], h_); up8(cr[i + 2], c_); up8(br[i], bb);
    #pragma unroll
                for (int e = 0; e < 8; ++e) { z0[e] = h_[e] * c_[e]; y[e] = (cbias[e] + z2[e] * cw0[e] + z1[e] * cw1[e] + z0[e] * cw2[e]) * bb[e]; }
                st8b(OALL + (size_t)(row0 + i) * BR_W + 1024 + c0, y);
                const int t = t0 + i; if (t >= L - 2) st8f(cst + (size_t)(t - (L - 2)) * 512 + c0, z0);
    #pragma unroll
                for (int e = 0; e < 8; ++e) { z2[e] = z1[e]; z1[e] = z0[e]; } }
        } else {
            if (gi == 0) pool8_fast<2>(ZP, UP, st_out, L - 15, row0, t0, smp, c0);
            else if (gi == 1) pool8_fast<4>(ZP, UP, st_out, L - 15, row0, t0, smp, c0);
            else if (gi == 2) pool8_fast<8>(ZP, UP, st_out, L - 15, row0, t0, smp, c0);
            else pool8_fast<16>(ZP, UP, st_out, L - 15, row0, t0, smp, c0);
            float* cst = smp ? F.out + O_CS + (size_t)(l * NB_S + b) * 2 * 512 : F.out + O_CP + (size_t)(l * NB_P + b) * 2 * 512;
            v4u hr[10], cr[10], br[8];
#pragma unroll
            for (int k = 0; k < 10; ++k) { const int rk = row0 - 2 + k; const size_t ro = (size_t)(rk < 0 ? 0 : rk) * 512 + c0; hr[k] = *(const GAS v4u*)(HC + ro); cr[k] = *(const GAS v4u*)(CC + ro); }
#pragma unroll
            for (int k = 0; k < 8; ++k) br[k] = *(const GAS v4u*)(BC + (size_t)(row0 + k) * 512 + c0);
#pragma unroll
            for (int k = 0; k < 2; ++k) { const bool neg = t0 - 2 + k < 0; hr[k].x = neg ? 0u : hr[k].x; hr[k].y = neg ? 0u : hr[k].y; hr[k].z = neg ? 0u : hr[k].z; hr[k].w = neg ? 0u : hr[k].w; }
            float z2[8], z1[8];
            {   float h_[8], c_[8]; up8(hr[0], h_); up8(cr[0], c_);
#pragma unroll
                for (int e = 0; e < 8; ++e) z2[e] = h_[e] * c_[e];
                up8(hr[1], h_); up8(cr[1], c_);
#pragma unroll
                for (int e = 0; e < 8; ++e) z1[e] = h_[e] * c_[e]; }
#pragma unroll
            for (int i = 0; i < 8; ++i) { float h_[8], c_[8], z0[8], bb[8], y[8]; up8(hr[i + 2], h_); up8(cr[i + 2], c_); up8(br[i], bb);
#pragma unroll
                for (int e = 0; e < 8; ++e) { z0[e] = h_[e] * c_[e]; y[e] = (cbias[e] + z2[e] * cw0[e] + z1[e] * cw1[e] + z0[e] * cw2[e]) * bb[e]; }
                st8b(OALL + (size_t)(row0 + i) * BR_W + 1024 + c0, y);
                const int t = t0 + i; if (t >= L - 2) st8f(cst + (size_t)(t - (L - 2)) * 512 + c0, z0);
#pragma unroll
                for (int e = 0; e < 8; ++e) { z2[e] = z1[e]; z1[e] = z0[e]; } }
        }
    }
}

__device__ __forceinline__ void diff_subln(Frame& F, const Args& A, int l) {
    const int lane = F.lane; const int gw = F.vcu * NWAVES + F.wave, NGW = F.G * NWAVES;
    const float s1 = wave_sum(A.in[I_LQ1][l * 64 + lane] * A.in[I_LK1][l * 64 + lane]), s2 = wave_sum(A.in[I_LQ2][l * 64 + lane] * A.in[I_LK2][l * 64 + lane]);
    const float lam_init = 0.8f - 0.6f * expf(-0.3f * (float)l);
    const float lam = expf(s1) - expf(s2) + lam_init, coef = 1.0f - lam_init;
    const int h = lane >> 3, e0 = (lane & 7) * 16;
    float sw0[8], sw1[8]; ld8f(A.in[I_SUBLN] + (size_t)l * 128 + e0, sw0); ld8f(A.in[I_SUBLN] + (size_t)l * 128 + e0 + 8, sw1);
    const bf16* OA = (const bf16*)(F.ws + WS_OATT); bf16* OALL = (bf16*)(F.ws + WS_OALL);
    for (int m0 = gw; m0 < M_T; m0 += 4 * NGW) {
        v4u ra[4][4];
#pragma unroll
        for (int r = 0; r < 4; ++r) { int m = m0 + r * NGW; m = m < M_T ? m : m0; const bf16* p1 = OA + (size_t)m * 2048 + (2 * h) * 128 + e0;
            ra[r][0] = *(const GAS v4u*)p1; ra[r][1] = *(const GAS v4u*)(p1 + 8); ra[r][2] = *(const GAS v4u*)(p1 + 128); ra[r][3] = *(const GAS v4u*)(p1 + 136); }
        __builtin_amdgcn_sched_barrier(0);
#pragma unroll
        for (int r = 0; r < 4; ++r) { int m = m0 + r * NGW; m = m < M_T ? m : m0;
            float a0[8], a1[8], b0[8], b1[8]; up8(ra[r][0], a0); up8(ra[r][1], a1); up8(ra[r][2], b0); up8(ra[r][3], b1);
            float ss = 0.f;
#pragma unroll
            for (int e = 0; e < 8; ++e) { a0[e] = a0[e] - lam * b0[e]; a1[e] = a1[e] - lam * b1[e]; ss += a0[e] * a0[e] + a1[e] * a1[e]; }
            ss += swz_xor<1>(ss); ss += swz_xor<2>(ss); ss += swz_xor<4>(ss);
            const float rs = coef / sqrtf(ss * (1.0f / 128.0f) + LN_EPS);
#pragma unroll
            for (int e = 0; e < 8; ++e) { a0[e] = a0[e] * rs * sw0[e]; a1[e] = a1[e] * rs * sw1[e]; }
            bf16* o = OALL + (size_t)m * BR_W + 1536 + h * 128 + e0;
            { v4u w; w.x = pk2hw(a0[0], a0[1]); w.y = pk2hw(a0[2], a0[3]); w.z = pk2hw(a0[4], a0[5]); w.w = pk2hw(a0[6], a0[7]); *(GAS v4u*)o = w; }
            { v4u w; w.x = pk2hw(a1[0], a1[1]); w.y = pk2hw(a1[2], a1[3]); w.z = pk2hw(a1[4], a1[5]); w.w = pk2hw(a1[6], a1[7]); *(GAS v4u*)(o + 8) = w; } }
    }
}

__device__ __forceinline__ void ln_load_row(const void* Yv, bool ybf, int m, int lane, f32x4 (&v)[4]) {
    if (ybf) { const GAS v4u* xr = (const GAS v4u*)((const bf16*)Yv + (size_t)m * DM) + lane;
#pragma unroll
        for (int jj = 0; jj < 2; ++jj) { const v4u w = xr[64 * jj]; v[2 * jj] = (f32x4){bfl(w.x), bfh(w.x), bfl(w.y), bfh(w.y)}; v[2 * jj + 1] = (f32x4){bfl(w.z), bfh(w.z), bfl(w.w), bfh(w.w)}; } }
    else { const GAS f32x4* xr = (const GAS f32x4*)((const float*)Yv + (size_t)m * DM) + 2 * lane;
#pragma unroll
        for (int j = 0; j < 4; ++j) v[j] = xr[128 * (j >> 1) + (j & 1)]; }
}
__device__ __forceinline__ void ln_finish_row(f32x4 (&v)[4], const f32x4 (&g4)[4], const f32x4 (&b4)[4], int m, int lane, float* outf, bf16* outb) {
    float s = 0.f;
#pragma unroll
    for (int j = 0; j < 4; ++j) s += (v[j].x + v[j].y) + (v[j].z + v[j].w);
    const float mean = wave_sum(s) * (1.f / DM); float s2 = 0.f;
#pragma unroll
    for (int j = 0; j < 4; ++j) { v[j] = v[j] - mean; s2 += (v[j].x * v[j].x + v[j].y * v[j].y) + (v[j].z * v[j].z + v[j].w * v[j].w); }
    const float rstd = 1.f / sqrtf(wave_sum(s2) * (1.f / DM) + LN_EPS);
#pragma unroll
    for (int j = 0; j < 4; ++j) { v[j] = v[j] * rstd * g4[j] + b4[j];
        if (outf) ((GAS f32x4*)(outf + (size_t)m * DM))[2 * lane + 128 * (j >> 1) + (j & 1)] = v[j]; }
    if (outb) {
#pragma unroll
        for (int jj = 0; jj < 2; ++jj) { v4u w; w.x = pk2hw(v[2 * jj].x, v[2 * jj].y); w.y = pk2hw(v[2 * jj].z, v[2 * jj].w); w.z = pk2hw(v[2 * jj + 1].x, v[2 * jj + 1].y); w.w = pk2hw(v[2 * jj + 1].z, v[2 * jj + 1].w);
            ((GAS v4u*)(outb + (size_t)m * DM))[lane + 64 * jj] = w; } }
}
__device__ __forceinline__ void ln_rows(Frame& F, const void* Yv, bool ybf, const float* gam, const float* bet, float* outf, bf16* outb) {
    const int gw = F.vcu * NWAVES + F.wave, NGW = F.G * NWAVES;
    f32x4 g4[4], b4[4];
#pragma unroll
    for (int j = 0; j < 4; ++j) { g4[j] = ((const GAS f32x4*)gam)[2 * F.lane + 128 * (j >> 1) + (j & 1)]; b4[j] = ((const GAS f32x4*)bet)[2 * F.lane + 128 * (j >> 1) + (j & 1)]; }
    for (int m = gw; m < M_T; m += 2 * NGW) {
        const int m2 = m + NGW < M_T ? m + NGW : m;
        f32x4 va[4], vb[4];
        ln_load_row(Yv, ybf, m, F.lane, va);
        ln_load_row(Yv, ybf, m2, F.lane, vb);
        ln_finish_row(va, g4, b4, m, F.lane, outf, outb);
        ln_finish_row(vb, g4, b4, m2, F.lane, outf, outb);
    }
}

template <int MODE, int N = DM> __device__ __forceinline__ void skinny_gemm(Frame& F, const bf16* A  , const bf16* Bt, int K, const void* resid  , bool rbf = false, bool ybf = false) {
    const int lane = F.lane, r32 = lane & 31, hi = lane >> 5, w = F.wave;
    LAS float* part = (LAS float*)(F.lds + RING_OFF);
    for (int tile = F.vcu; tile < (M_S / 64) * (N / 32); tile += F.G) {
        const int rb = tile & 7, cb = tile >> 3, row0 = rb * 64, col0 = cb * 32;
        int ks0, nks;
        if (MODE == 1) { ks0 = w < 6 ? w * 16 : 96 + (w - 6) * 32; nks = w < 6 ? 16 : 32; }
        else { nks = K / 128; ks0 = w * nks; }
        const bf16* a0 = A + (size_t)(row0 + r32) * K + ks0 * 16 + 8 * hi; const bf16* a1 = a0 + (size_t)32 * K; const bf16* bp = Bt + (size_t)(col0 + r32) * K + ks0 * 16 + 8 * hi;
        f32x16 acc0 = {}, acc1 = {};
        bf16x8 pa0[4], pa1[4], pb[4], qa0[4], qa1[4], qb_[4];
#define SK_LOAD(X0, X1, XB, kk) do { _Pragma("unroll") for (int u = 0; u < 4; ++u) { X0[u] = *(const bf16x8*)(a0 + ((kk) + u) * 16); X1[u] = *(const bf16x8*)(a1 + ((kk) + u) * 16); XB[u] = *(const bf16x8*)(bp + ((kk) + u) * 16); } } while (0)
#define SK_MMA(X0, X1, XB) do { _Pragma("unroll") for (int u = 0; u < 4; ++u) { acc0 = __builtin_amdgcn_mfma_f32_32x32x16_bf16(X0[u], XB[u], acc0, 0, 0, 0); acc1 = __builtin_amdgcn_mfma_f32_32x32x16_bf16(X1[u], XB[u], acc1, 0, 0, 0); } } while (0)
        SK_LOAD(pa0, pa1, pb, 0);
#pragma unroll 1
        for (int k = 0; k < nks; k += 8) {
            const bool two = k + 4 < nks;
            if (two) SK_LOAD(qa0, qa1, qb_, k + 4);
            SK_MMA(pa0, pa1, pb);
            if (k + 8 < nks) SK_LOAD(pa0, pa1, pb, k + 8);
            if (two) SK_MMA(qa0, qa1, qb_);
        }
#undef SK_LOAD
#undef SK_MMA
        LAS float* mine = part + w * 2048;
#pragma unroll
        for (int r = 0; r < 16; ++r) { const int row = (r & 3) + 8 * (r >> 2) + 4 * hi; mine[row * 32 + r32] = acc0[r]; mine[(32 + row) * 32 + r32] = acc1[r]; }
        __syncthreads();
        {
            const int row = 8 * w + (lane >> 3), c4 = (lane & 7) * 4; const int grow = row0 + row, gcol = col0 + c4;
            f32x4 sum = {0.f, 0.f, 0.f, 0.f};
            if (MODE == 1) {
                const bf16* gp = (const bf16*)(F.ws + WS_G) + (size_t)(M_P + grow) * 4096 + gcol;
#pragma unroll
                for (int b = 0; b < 4; ++b) { const unsigned long long gw = *(const GAS unsigned long long*)(gp + b * 1024);
                    const f32x4 gv = {bfl((unsigned)gw), bfh((unsigned)gw), bfl((unsigned)(gw >> 32)), bfh((unsigned)(gw >> 32))};
                    const f32x4 pb = *(const LAS f32x4*)(part + (2 * b) * 2048 + row * 32 + c4) + *(const LAS f32x4*)(part + (2 * b + 1) * 2048 + row * 32 + c4);
                    sum += gv * pb; }
                *(GAS unsigned long long*)((bf16*)(F.ws + WS_MG) + (size_t)(M_P + grow) * 1024 + gcol) = (unsigned long long)pk2(sum.x, sum.y) | ((unsigned long long)pk2(sum.z, sum.w) << 32);
            } else if (MODE == 3) {
#pragma unroll
                for (int ww = 0; ww < 8; ++ww) sum += *(const LAS f32x4*)(part + ww * 2048 + row * 32 + c4);
                const unsigned long long vw = *(const GAS unsigned long long*)((const bf16*)(F.ws + WS_VSSM) + (size_t)(M_P + grow) * 512 + gcol);
                const f32x4 vv = {bfl((unsigned)vw), bfh((unsigned)vw), bfl((unsigned)(vw >> 32)), bfh((unsigned)(vw >> 32))};
#pragma unroll
                for (int e = 0; e < 4; ++e) sum[e] = vv[e] * pg8::fast_sigmoid(sum[e]);
                *(GAS unsigned long long*)((bf16*)(F.ws + WS_OALL) + (size_t)(M_P + grow) * BR_W + 512 + gcol) = (unsigned long long)pk2(sum.x, sum.y) | ((unsigned long long)pk2(sum.z, sum.w) << 32);
            } else if (MODE == 2) {
#pragma unroll
                for (int ww = 0; ww < 8; ++ww) sum += *(const LAS f32x4*)(part + ww * 2048 + row * 32 + c4);
#pragma unroll
                for (int e = 0; e < 4; ++e) { const float a = fmaxf(sum[e], 0.f); sum[e] = a * a; }
                *(GAS unsigned long long*)((bf16*)(F.ws + WS_G) + (size_t)(M_P + grow) * N + gcol) = (unsigned long long)pk2(sum.x, sum.y) | ((unsigned long long)pk2(sum.z, sum.w) << 32);
            } else {
#pragma unroll
                for (int ww = 0; ww < 8; ++ww) sum += *(const LAS f32x4*)(part + ww * 2048 + row * 32 + c4);
                f32x4 rv; if (rbf) { const unsigned long long w = *(const GAS unsigned long long*)((const bf16*)resid + (size_t)grow * 1024 + gcol); rv = (f32x4){bfl((unsigned)w), bfh((unsigned)w), bfl((unsigned)(w >> 32)), bfh((unsigned)(w >> 32))}; }
                else rv = *(const GAS f32x4*)((const float*)resid + (size_t)grow * 1024 + gcol);
                const f32x4 y = rv * DN_ALPHA + sum;
                if (ybf) *(GAS unsigned long long*)((bf16*)(F.ws + WS_YF) + (size_t)(M_P + grow) * 1024 + gcol) = (unsigned long long)pk2(y.x, y.y) | ((unsigned long long)pk2(y.z, y.w) << 32);
                else *(GAS f32x4*)((float*)(F.ws + WS_YF) + (size_t)(M_P + grow) * 1024 + gcol) = y;
            }
        }
        __syncthreads();
    }
}

__device__ __forceinline__ void attn_all(Frame& F, const Args& A, int l, char* lds_generic) {
    using abf = attn_body::bf16;
    const abf* Q = (const abf*)(F.ws + WS_Q); const abf* K = (const abf*)(F.ws + WS_K); const abf* V = (const abf*)(F.ws + WS_V);
    const abf* KS = (const abf*)(F.ws + WS_KS); const abf* VS = (const abf*)(F.ws + WS_VS); abf* OA = (abf*)(F.ws + WS_OATT);
#if ATTN_DV128
    constexpr int NU_P = NB_P * 16 * 64, NU_S = NB_S * 16;
    const bool bal = (F.G == 256);
    const int nmine = bal ? 8 + REP_SAMPLE : (NU_P + NU_S - F.vcu + F.G - 1) / F.G;
    struct AU { int mode, NT; const abf* Q; const abf* Kh; const abf* Vh; abf* O; const float* Kc; const float* Vc; };
    auto mk = [&](int i) -> AU {
        int mode, b, ph, qb = 0;
        if (bal) {
            const int spos = F.vcu % 9, ip = i < spos ? i : i - REP_SAMPLE;
            if (i < spos || i >= spos + REP_SAMPLE) { mode = 0; const int bp = F.vcu >> 3, s = F.vcu & 7, j = ip >> 1; b = bp >> 4; ph = bp & 15; qb = (ip & 1) ? s + 8 * j : 63 - s - 8 * j; }
            else { mode = 1; b = F.vcu >> 4; ph = F.vcu & 15; }
        } else {
            const int u = F.vcu + i * F.G;
            if (u < NU_P) { mode = 0; const int bp = u >> 6; qb = 63 - (u & 63); b = bp >> 4; ph = bp & 15; }
            else { mode = 1; const int su = u - NU_P; b = su >> 4; ph = su & 15; }
        }
        const size_t qrow = mode == 0 ? (size_t)b * SEQ + (size_t)qb * 256 : (size_t)M_P + (size_t)b * SEQ_S;
        AU u_;
        u_.mode = mode; u_.NT = mode == 0 ? 4 * (qb + 1) : KS_ROWS / 64;
        u_.Kh = (mode == 0 && KT_K) ? K + ((size_t)(b * 16 + ph) * 256) * 4096 : (mode == 0 ? K + (size_t)b * SEQ * 1024 : KS + (size_t)b * KS_ROWS * 1024) + ph * 64;
        u_.Vh = (mode == 0 && KT_V) ? V + ((size_t)(b * 8 + (ph >> 1)) * 256) * 8192 : (mode == 0 ? V + (size_t)b * SEQ * 1024 : VS + (size_t)b * KS_ROWS * 1024) + (ph >> 1) * 128;
        u_.Kc = mode == 0 ? nullptr : A.in[I_CK] + ((size_t)(l * NB_S + b) * PAST) * 1024 + ph * 64;
        u_.Vc = mode == 0 ? nullptr : A.in[I_CV] + ((size_t)(l * NB_S + b) * PAST) * 1024 + (ph >> 1) * 128;
        u_.Q = Q + qrow * 1024 + ph * 64; u_.O = OA + qrow * 2048 + ph * 128;
        return u_;
    };
    AU cur = mk(0); bool pre = false;
#pragma unroll 1
    for (int i = 0; i < nmine; ++i) {
        const bool hasn = i + 1 < nmine; const AU nx = mk(hasn ? i + 1 : i);
        const bool pfN = hasn && cur.mode == 0 && nx.mode == 0 && KT_K && KT_V;
        attn_body::attn_unit<12>(cur.mode, cur.NT, cur.Q, cur.Kh, cur.Vh, cur.O, lds_generic, cur.Kc, cur.Vc, F.tid, pre, pfN, nx.Kh, nx.Vh);
        pre = pfN; cur = nx;
    }
}
#else
    constexpr int NU_P = NB_P * 32 * 64, NU_S = NB_S * 32;
    const bool bal = (F.G == 256);
    const int nmine = bal ? 18 : (NU_P + NU_S - F.vcu + F.G - 1) / F.G;
    for (int i = 0; i < nmine; ++i) {
        int mode, b, vhd, qb = 0;
        if (bal) {
            if (i < 16) { mode = 0; const int bv = F.vcu >> 2, s = F.vcu & 3, j = i >> 1; b = bv >> 5; vhd = bv & 31; qb = (i & 1) ? s + 4 * j : 63 - s - 4 * j; }
            else { mode = 1; const int su = F.vcu + 256 * (i - 16); b = su >> 5; vhd = su & 31; }
        } else {
            const int u = F.vcu + i * F.G;
            if (u < NU_P) { mode = 0; const int bv = u >> 6; qb = 63 - (u & 63); b = bv >> 5; vhd = bv & 31; }
            else { mode = 1; const int su = u - NU_P; b = su >> 5; vhd = su & 31; }
        }
        const int ph = vhd >> 1, vh = vhd & 1;
        const size_t qrow = mode == 0 ? (size_t)b * SEQ + (size_t)qb * 256 : (size_t)M_P + (size_t)b * SEQ_S;
        const abf* Kh = (mode == 0 ? K + (size_t)b * SEQ * 1024 : KS + (size_t)b * KS_ROWS * 1024) + ph * 64;
        const abf* Vh = (mode == 0 ? V + (size_t)b * SEQ * 1024 : VS + (size_t)b * KS_ROWS * 1024) + (ph >> 1) * 128 + vh * 64;
        const int NT = mode == 0 ? 4 * (qb + 1) : KS_ROWS / 64;
        attn_body::attn_unit<8>(mode, NT, Q + qrow * 1024 + ph * 64, Kh, Vh, OA + qrow * 2048 + ph * 128 + vh * 64, lds_generic);
    }
}
#endif

__device__ __forceinline__ int grid_bar(const XcdBarrier& bar, int wave) { XcdBarrier b = bar; b.tid = wave * 64 + lane_id(); xcd_barrier(b); return 1; }
#ifndef REP_SK
#define REP_SK 1
#endif
#if REP_SK > 1
#define REP_SKLOOP _Pragma("unroll 1") for (int rs_ = 0; rs_ < REP_SK; ++rs_)
#else
#define REP_SKLOOP
#endif
__global__ void __launch_bounds__(NWAVES * 64, 2) hse_fwd(Args args) {
    extern __shared__ __attribute__((aligned(16))) unsigned char lds[];
    Frame F;
    F.lds = (LAS unsigned char*)lds;
    F.MISC = (volatile LAS unsigned*)(F.lds + MISC_OFF);
    F.tid = threadIdx.x; F.lane = F.tid & 63; F.wave = __builtin_amdgcn_readfirstlane(F.tid >> 6);
    F.G = gridDim.x; { const int bx = blockIdx.x; F.vcu = (F.G % 8 == 0) ? (bx % 8) * (F.G / 8) + bx / 8 : bx; }
    F.out = args.out; F.ws = args.ws; F.ctl = (gu32*)(args.ws + WS_CTL);
    for (int u = F.tid; u < (LDS_BYTES - LDSCTL_OFF) / 4; u += NWAVES * 64) ((LAS unsigned*)(F.lds + LDSCTL_OFF))[u] = 0u;
    __syncthreads();
    XcdBarrier bar; bar.bar = (unsigned*)(F.ctl + CW_BAR); bar.x = 0; bar.st = nullptr; bar.tid = 0;
#if MK_ONE_LAUNCH
    bar = xcd_barrier_post((unsigned*)(F.ctl + CW_BAR), F.MISC + 8);
#define GRID_BAR() grid_bar(bar, F.wave)
#else
#define GRID_BAR() do { if (F.tid == 0) __hip_atomic_store(F.ctl + CW_TMO, 0xBADBA0u, RLX_AGENT); } while (0)
#endif
    const int lo = args.ph_lo, hi = args.ph_hi;
#define IN(k) (lo <= (k) && (k) < hi)
#define SEAM(k) do { if (IN(k) && IN((k) + 1)) GRID_BAR(); } while (0)
#if MK_ONE_LAUNCH
#define REPEAT(N) _Pragma("unroll 1") for (int rp_ = 0; rp_ < (N); ++rp_) for (int once_ = (rp_ > 0 ? grid_bar(bar, F.wave) : 1); once_; once_ = 0)
#else
#define REPEAT(N)
#endif
#define PHASE_ENTER() Frame P = F; unsigned char* ws; { int t_ = F.wave * 64 + lane_id(); asm volatile("" : "+v"(t_)); P.tid = t_; P.lane = t_ & 63; P.wave = F.wave; \
        GAS unsigned char* w_ = (GAS unsigned char*)args.ws; asm volatile("" : "+s"(w_)); ws = (unsigned char*)w_; P.ws = ws; GAS float* o_ = (GAS float*)args.out; asm volatile("" : "+s"(o_)); P.out = (float*)o_; } \
        unsigned char* wl = ws + WS_W + (size_t)l * W_LSTRIDE; (void)wl

    { const int l = 0; if (IN(0)) { PHASE_ENTER(); p0_prologue(P, args); } } SEAM(0);

    for (int l = 0; l < DEPTH; ++l) {
        const int pb = 1 + l * PH_PER_LAYER;
        if (IN(pb + P_WIN)) { PHASE_ENTER();
            pg8::Gemm g{(const bf16*)(ws + WS_XB), (const bf16*)(wl + W_IN), M_T, N_IN, DM}; typedef pg8::StaticOrderT<M_T / 256, N_IN / 256> SO; SO S; S.init(M_T, N_IN, P.G, (int)blockIdx.x); S.tid = P.tid;
            pg8::EpiWin E{ws, P.out, l, attn_body::C2};
            pg8::gemm_phase<pg8::EpiWin, SO, true, true>(P.lds + RING_OFF, g, S, E);
            if (l == 0) {
                constexpr int NU = (M_T / 256) * (N_IN / 256); const int rounds = (NU + P.G - 1) / P.G, nlast = NU - (rounds - 1) * P.G;
                const int bx = (int)blockIdx.x;
                if (nlast >= P.G) p0_weights(P, args, I_IN0, 1 << 30, bx * NWAVES + P.wave, P.G * NWAVES);
                else if (bx >= nlast) p0_weights(P, args, I_IN0, 1 << 30, (bx - nlast) * NWAVES + P.wave, (P.G - nlast) * NWAVES);
            }
        }
        SEAM(pb + P_WIN);
        if (IN(pb + P_MIXA)) { PHASE_ENTER(); ssm_pass<false>(P, args, l); mixa_elem(P, args, l); }
        SEAM(pb + P_MIXA);
        if (IN(pb + P_ATTN)) { PHASE_ENTER(); ssm_carry(P, l); attn_all(P, args, l, (char*)lds + RING_OFF); }
#if REP_ATTN > 1
        GRID_BAR(); if (IN(pb + P_ATTN)) { PHASE_ENTER(); attn_all(P, args, l, (char*)lds + RING_OFF); }
#endif
        SEAM(pb + P_ATTN);
        if (IN(pb + P_MIXC)) { PHASE_ENTER(); ssm_pass<true>(P, args, l); diff_subln(P, args, l); }
        SEAM(pb + P_MIXC);
        if (IN(pb + P_PG)) { PHASE_ENTER();
            pg8::Gemm g{(const bf16*)(ws + WS_VSSM), (const bf16*)(wl + W_GLU), M_P, 512, 512}; typedef pg8::StaticOrderT<M_P / 256, 2> SO; SO S; S.init(M_P, 512, P.G, (int)blockIdx.x); S.tid = P.tid;
            pg8::EpiGlu E{ws};
            pg8::gemm_phase<pg8::EpiGlu, SO, true, true>(P.lds + RING_OFF, g, S, E);
            REP_SKLOOP skinny_gemm<3, 512>(P, (const bf16*)(ws + WS_VSSM) + (size_t)M_P * 512, (const bf16*)(wl + W_GLU), 512, nullptr);
        }
        SEAM(pb + P_PG);
        if (IN(pb + P_MERGE)) { PHASE_ENTER();
            pg8::Gemm g{(const bf16*)(ws + WS_OALL), (const bf16*)(wl + W_BR), M_P, DM, BR_W}; typedef pg8::StaticOrderT<M_P / 256, DM / 256> SO; SO S; S.init(M_P, DM, P.G, (int)blockIdx.x); S.tid = P.tid;
            pg8::EpiMerge E{ws, P.tid};
            pg8::gemm_phase<pg8::EpiMerge, SO, true, true>(P.lds + RING_OFF, g, S, E);
            REP_SKLOOP skinny_gemm<1>(P, (const bf16*)(ws + WS_OALL) + (size_t)M_P * BR_W, (const bf16*)(wl + W_BR), BR_W, nullptr);
        }
        SEAM(pb + P_MERGE);
        if (IN(pb + P_OUT)) { PHASE_ENTER();
            pg8::Gemm g{(const bf16*)(ws + WS_MG), (const bf16*)(wl + W_OUT), M_P, DM, DM}; typedef pg8::StaticOrderT<M_P / 256, DM / 256> SO; SO S; S.init(M_P, DM, P.G, (int)blockIdx.x); S.tid = P.tid;
            const void* rs = l == 0 ? (const void*)args.in[I_XS] : (const void*)((const bf16*)(ws + WS_XB) + (size_t)M_P * DM);
            pg8::EpiResid E{(const pg8::bf16_t*)(ws + WS_XB), ws, 1};
            pg8::gemm_phase<pg8::EpiResid, SO, true, true>(P.lds + RING_OFF, g, S, E);
            REP_SKLOOP skinny_gemm<0>(P, (const bf16*)(ws + WS_MG) + (size_t)M_P * DM, (const bf16*)(wl + W_OUT), DM, rs, l != 0, true);
        }
        SEAM(pb + P_OUT);
        if (IN(pb + P_LN1)) { PHASE_ENTER(); ln_rows(P, (const void*)(ws + WS_YF), true, args.in[I_LN1G] + (size_t)l * DM, args.in[I_LN1B] + (size_t)l * DM, nullptr, (bf16*)(ws + WS_XMB)); }
        SEAM(pb + P_LN1);
        if (IN(pb + P_UP)) { PHASE_ENTER();
            pg8::Gemm g{(const bf16*)(ws + WS_XMB), (const bf16*)(wl + W_UP), M_T, D_FF, DM}; typedef pg8::StaticOrderT<M_T / 256, D_FF / 256> SO; SO S; S.init(M_T, D_FF, P.G, (int)blockIdx.x); S.tid = P.tid;
            pg8::EpiUp E{ws};
            pg8::gemm_phase<pg8::EpiUp, SO, true, true>(P.lds + RING_OFF, g, S, E);
        }
        SEAM(pb + P_UP);
        if (IN(pb + P_DOWN)) { PHASE_ENTER();
            pg8::Gemm g{(const bf16*)(ws + WS_G), (const bf16*)(wl + W_DN), M_P, DM, D_FF}; typedef pg8::StaticOrderT<M_P / 256, DM / 256> SO; SO S; S.init(M_P, DM, P.G, (int)blockIdx.x); S.tid = P.tid;
            pg8::EpiResid E{(const pg8::bf16_t*)(ws + WS_XMB), ws, l + 1 < DEPTH ? 1 : 0};
            pg8::gemm_phase<pg8::EpiResid, SO, true, true>(P.lds + RING_OFF, g, S, E);
            REP_SKLOOP skinny_gemm<0>(P, (const bf16*)(ws + WS_G) + (size_t)M_P * D_FF, (const bf16*)(wl + W_DN), D_FF, (const bf16*)(ws + WS_XMB) + (size_t)M_P * DM, true, l + 1 < DEPTH);
        }
        SEAM(pb + P_DOWN);
        if (IN(pb + P_LN2)) { PHASE_ENTER();
            if (l + 1 < DEPTH) ln_rows(P, (const void*)(ws + WS_YF), true, args.in[I_LN2G] + (size_t)l * DM, args.in[I_LN2B] + (size_t)l * DM, nullptr, (bf16*)(ws + WS_XB));
            else ln_rows(P, (const void*)(ws + WS_YF), false, args.in[I_LN2G] + (size_t)l * DM, args.in[I_LN2B] + (size_t)l * DM, P.out + O_YP, nullptr);
        }
        SEAM(pb + P_LN2);
    }
#undef IN
#undef SEAM
}

extern "C" void kernel_launch(void* const* d_in, const int* in_sizes, int n_in, void* d_out, int out_size, void* d_ws, size_t ws_size, hipStream_t stream) {
    static int grid = 0;
    if (grid == 0) {
        if (n_in != 35 || (size_t)out_size != O_END || ws_size < WS_END) { fprintf(stderr, "kernel_launch: unexpected shapes: n_in %d out %d (want %zu) ws %zu (want %zu)\n", n_in, out_size, (size_t)O_END, ws_size, (size_t)WS_END); grid = -1; return; }
        int dev = 0, cus = 0, per_cu = 0;
        if (hipGetDevice(&dev) != hipSuccess || hipDeviceGetAttribute(&cus, hipDeviceAttributeMultiprocessorCount, dev) != hipSuccess) { grid = -1; return; }
        if (hipFuncSetAttribute((const void*)hse_fwd, hipFuncAttributeMaxDynamicSharedMemorySize, LDS_BYTES) != hipSuccess) { fprintf(stderr, "kernel_launch: hipFuncSetAttribute failed\n"); grid = -1; return; }
        if (hipOccupancyMaxActiveBlocksPerMultiprocessor(&per_cu, (const void*)hse_fwd, NWAVES * 64, LDS_BYTES) != hipSuccess || per_cu < 1) fprintf(stderr, "kernel_launch: occupancy query reports %d\n", per_cu);
        (void)hipGetLastError();
        grid = cus;
    }
    if (grid < 0) return;
    (void)hipMemsetAsync((char*)d_ws + WS_CTL, 0, CTL_ZERO_BYTES, stream);
    Args a{};
    for (int i = 0; i < 35; ++i) a.in[i] = (const float*)d_in[i];
    a.out = (float*)d_out; a.ws = (unsigned char*)d_ws; a.pad = 0;
#if MK_ONE_LAUNCH
    a.ph_lo = 0; a.ph_hi = NPH; a.li = 0;
    hipLaunchKernelGGL(hse_fwd, dim3(grid), dim3(NWAVES * 64), LDS_BYTES, stream, a);
#else
    for (int p = 0; p < NPH; ++p) { a.ph_lo = p; a.ph_hi = p + 1; a.li = p; hipLaunchKernelGGL(hse_fwd, dim3(grid), dim3(NWAVES * 64), LDS_BYTES, stream, a); }
#endif
}
```

```cpp
#include <hip/hip_runtime.h>
#include <hip/hip_bf16.h>
#include <cstdio>
#include <cstdint>
#include <cmath>

#define ATTN_DV128 1
#define KT_K 1
#define KT_V 1
#define REP_EPI 1
#define REP_GEMM 1
#define REP_THIN 1
#define REP_ATTN 1
#define REP_MIXA 1
#define REP_MIXC 1
#define REP_PRO 1
#define REP_WIN 1
#define REP_PG 1
#define REP_MERGE 1
#define REP_OUT 1
#define REP_UP 1
#define REP_DOWN 1
#define REP_SAMPLE 1

#ifndef MK_ONE_LAUNCH
#define MK_ONE_LAUNCH 1
#endif

constexpr int DM = 1024, NB_P = 2, SEQ = 16384, DEPTH = 2, NB_S = 16, SEQ_S = 32, PAST = 4096;
constexpr int M_P = NB_P * SEQ, M_S = NB_S * SEQ_S, M_T = M_P + M_S;
constexpr int N_IN = 9728, D_FF = 4096, BR_W = 2560;
constexpr int KS_ROWS = 4224;
constexpr int NCH_P = M_P / 64;
constexpr float LN_EPS = 1e-5f;
constexpr float DN_ALPHA = 1.41421356237309515f;

constexpr size_t O_YP = 0;
constexpr size_t O_YS = O_YP + (size_t)M_P * DM;
constexpr size_t O_KP = O_YS + (size_t)M_S * DM;
constexpr size_t O_VP = O_KP + (size_t)DEPTH * M_P * 1024;
constexpr size_t O_SRP = O_VP + (size_t)DEPTH * M_P * 1024;
constexpr size_t O_SIP = O_SRP + (size_t)DEPTH * NB_P * 2048;
constexpr size_t O_CP = O_SIP + (size_t)DEPTH * NB_P * 2048;
constexpr size_t O_PP = O_CP + (size_t)DEPTH * NB_P * 2 * 512;
constexpr size_t O_KS = O_PP + (size_t)DEPTH * NB_P * 15 * 512;
constexpr size_t O_VS = O_KS + (size_t)DEPTH * M_S * 1024;
constexpr size_t O_SRS = O_VS + (size_t)DEPTH * M_S * 1024;
constexpr size_t O_SIS = O_SRS + (size_t)DEPTH * NB_S * 2048;
constexpr size_t O_CS = O_SIS + (size_t)DEPTH * NB_S * 2048;
constexpr size_t O_PS = O_CS + (size_t)DEPTH * NB_S * 2 * 512;
constexpr size_t O_END = O_PS + (size_t)DEPTH * NB_S * 15 * 512;

constexpr size_t KiB = 1u << 10, MiB = 1u << 20;
constexpr size_t WS_CTL = 0, CTL_ZERO_BYTES = 64 * KiB;
constexpr size_t WS_W = 2 * MiB, W_LSTRIDE = 44 * MiB;
constexpr size_t W_IN = 0, W_BR = 19 * MiB, W_OUT = 24 * MiB, W_UP = 26 * MiB, W_DN = 34 * MiB, W_GLU = 42 * MiB, W_POOL = 42 * MiB + 512 * KiB;
constexpr size_t WS_ROPE = 90 * MiB;
constexpr size_t WS_SSMC = 91 * MiB, SSMC_LSTRIDE = 512 * KiB;
constexpr size_t SC_AB = 0, SC_A64 = 16 * KiB, SC_BB = 32 * KiB, SC_CM = 160 * KiB;
constexpr size_t WS_E = 92 * MiB, WS_H = 100 * MiB;
constexpr size_t WS_XB = 108 * MiB;
constexpr size_t WS_XF1 = 173 * MiB;
constexpr size_t WS_XMF = 303 * MiB, WS_XMB = 433 * MiB;
constexpr size_t WS_YF = 498 * MiB;
constexpr size_t WS_ZP = 628 * MiB, SZ_512 = (size_t)M_T * 512 * 2;
constexpr size_t WS_US = WS_ZP + SZ_512, WS_HC = WS_US + SZ_512, WS_BC = WS_HC + SZ_512, WS_CC = WS_BC + SZ_512, WS_UPOOL = WS_CC + SZ_512, WS_VSSM = WS_UPOOL + SZ_512;
constexpr size_t WS_Q = 856 * MiB, WS_K = 922 * MiB, WS_V = 986 * MiB;
constexpr size_t WS_KS = 1050 * MiB, WS_VS = 1182 * MiB;
constexpr size_t WS_G = 1314 * MiB;
constexpr size_t WS_OATT = 1574 * MiB;
constexpr size_t WS_OALL = 1704 * MiB;
constexpr size_t WS_MG = 1867 * MiB;
constexpr size_t WS_END = 1932 * MiB;
static_assert(WS_VSSM + SZ_512 <= WS_Q && WS_Q + (size_t)(M_T + 256) * 2048 <= WS_K && WS_KS + (size_t)NB_S * KS_ROWS * 2048 <= WS_VS && WS_VS + (size_t)NB_S * KS_ROWS * 2048 <= WS_G, "ws map 1");
static_assert(WS_G + (size_t)M_T * 8192 <= WS_OATT && WS_OATT + (size_t)M_T * 4096 <= WS_OALL && WS_OALL + (size_t)M_T * 5120 <= WS_MG && WS_MG + (size_t)M_T * 2048 <= WS_END, "ws map 2");
static_assert(WS_XB + (size_t)M_T * 2048 <= WS_XF1 && WS_XF1 + (size_t)M_T * 4096 <= WS_XMF && WS_XMF + (size_t)M_T * 4096 <= WS_XMB && WS_XMB + (size_t)M_T * 2048 <= WS_YF && WS_YF + (size_t)M_T * 4096 <= WS_ZP, "ws map 3");

#ifndef REP_EPI
#define REP_EPI 1
#endif
constexpr int EPI_REP = REP_EPI;
__device__ __forceinline__ int lane_id() { int l; asm volatile("v_mbcnt_lo_u32_b32 %0, -1, 0\n\tv_mbcnt_hi_u32_b32 %0, -1, %0" : "=v"(l)); return l; }
template <int X> __device__ __forceinline__ float swz_xor(float v) { return __int_as_float(__builtin_amdgcn_ds_swizzle(__float_as_int(v), 0x1f | (X << 10))); }
namespace pg8 {
#define PG8_LAS __attribute__((address_space(3)))
typedef unsigned short bf16_t;
typedef short bf16x8 __attribute__((ext_vector_type(8)));
typedef float f32x4 __attribute__((ext_vector_type(4)));
typedef unsigned u32x4 __attribute__((ext_vector_type(4)));
typedef unsigned u32x2 __attribute__((ext_vector_type(2)));
constexpr int BM = 256, BK = 64, HALF = 128, HTB = HALF * BK * 2  , STAGE_BYTES = 8 * HTB, NXCD = 8, WGM = 8;

__host__ __device__ __forceinline__ int lds_byte(int r, int c) { const int st = (r >> 4) * 2 + (c >> 5), rr = r & 15, cc = c & 31, ob = rr * 64 + cc * 2; return st * 1024 + (ob ^ (((ob >> 9) & 1) << 5)); }
__host__ __device__ __forceinline__ void stage_rc(int b, int& R, int& C) { const int st = b / 1024, sb = b % 1024, swz = sb ^ (((sb >> 9) & 1) << 5); R = (st >> 1) * 16 + swz / 64; C = (st & 1) * 32 + (swz % 64) / 2; }
__host__ __device__ __forceinline__ int perm32(int rho) { const int n = rho >> 4, i = rho & 15; return 8 * (i >> 2) + 4 * n + (i & 3); }

struct Unit { int pm, pn; };
struct Gemm { const bf16_t* A; const bf16_t* Bt; int M, N, K; };

template <int NM, int NN> struct StaticOrderT {
    static constexpr int nwg = NM * NN, TAIL = NM % WGM;
    static_assert(TAIL == 0 || TAIL == 1 || TAIL == 2 || TAIL == 4, "last row-panel group must be a power of two");
    int G, c, tid;
    __host__ __device__ void init(int, int, int G_, int c_) { G = G_; c = c_; tid = 0; }
    __host__ __device__ bool next(int i, Unit& u) const {
        const int L = i * G + c; if (L >= nwg) return false;
        int wgid = L; { constexpr int q = nwg / NXCD, r = nwg % NXCD; const int xcd = wgid % NXCD, off = wgid / NXCD; wgid = (xcd < r ? xcd * (q + 1) : r * (q + 1) + (xcd - r) * q) + off; }
        constexpr int nig = WGM * NN; const int gid = wgid / nig, fm = gid * WGM, x = wgid - gid * nig; const bool tail = (NM - fm) < WGM;
        const int sh = tail ? (TAIL == 4 ? 2 : TAIL == 2 ? 1 : 0) : 3;
        u.pm = fm + (x & ((1 << sh) - 1)); u.pn = x >> sh; return true;
    }
    __device__ __forceinline__ const char* abase(const Gemm& g, const Unit& u) const { return (const char*)g.A + (size_t)u.pm * (size_t)(BM * 2) * g.K; }
    __device__ __forceinline__ const char* bbase(const Gemm& g, const Unit& u) const { return (const char*)g.Bt + (size_t)u.pn * (size_t)(BM * 2) * g.K; }
    __device__ __forceinline__ void a_ready(const Unit&) const {}
    __device__ __forceinline__ void done(const Unit&) const {}
};
typedef float pkh_f2_t __attribute__((ext_vector_type(2))); typedef __bf16 pkh_b2_t __attribute__((ext_vector_type(2)));
__device__ __forceinline__ unsigned cvt_pk_bf16_hw(float lo, float hi);
__device__ __forceinline__ unsigned cvt_pk_bf16(float lo, float hi) { return cvt_pk_bf16_hw(lo, hi); }
__device__ __forceinline__ unsigned cvt_pk_bf16_hw(float lo, float hi) { const pkh_f2_t v = {lo, hi}; const pkh_b2_t b = __builtin_convertvector(v, pkh_b2_t); return __builtin_bit_cast(unsigned, b); }
__device__ __forceinline__ float bf_lo(unsigned w) { return __uint_as_float(w << 16); }
__device__ __forceinline__ float bf_hi(unsigned w) { return __uint_as_float(w & 0xffff0000u); }
__device__ __forceinline__ float fast_sigmoid(float x) { return __builtin_amdgcn_rcpf(1.0f + __builtin_amdgcn_exp2f(-1.4426950408889634f * x)); }

#define EPI_LOOP_ROWS for (int ai = 0; ai < 2; ++ai) _Pragma("unroll") for (int m = 0; m < 4; ++m)

struct EpiWin {
    static constexpr bool PERM = true, AFTER_DRAIN = false, MIDK = false, PROBE_REP = true; static constexpr bool PERM2 = false;
    unsigned char* ws; float* out; int l; float qscale;
    static __device__ __forceinline__ u32x4 pack8(const f32x4 v0, const f32x4 v1) { u32x4 w; w.x = cvt_pk_bf16_hw(v0[0], v0[1]); w.y = cvt_pk_bf16_hw(v0[2], v0[3]); w.z = cvt_pk_bf16_hw(v1[0], v1[1]); w.w = cvt_pk_bf16_hw(v1[2], v1[3]); return w; }
    template <bool GATE> __device__ __forceinline__ void plain(const f32x4 (&acc)[2][2][4][2], bf16_t* base, int ld, int row0, int col) const {
#pragma unroll
        EPI_LOOP_ROWS { bf16_t* rowp = base + (size_t)(row0 + ai * HALF + m * 16) * ld + col;
#pragma unroll
            for (int bj = 0; bj < 2; ++bj) { f32x4 v0 = acc[ai][bj][m][0], v1 = acc[ai][bj][m][1];
                if (GATE) {
#pragma unroll
                    for (int e = 0; e < 4; ++e) { v0[e] = fast_sigmoid(v0[e]); v1[e] = fast_sigmoid(v1[e]); } }
                *(u32x4*)(rowp + bj * HALF) = pack8(v0, v1); } }
    }
    __device__ __forceinline__ void gates(const f32x4 (&acc)[2][2][4][2], const Unit& u, int wave, int lane, int row0, int c8) const {
        const bool smp = u.pm >= M_P / BM;
        bf16_t* base = smp ? (bf16_t*)(ws + WS_G) + (size_t)row0 * 4096 + (u.pn - 22) * BM + c8 : (bf16_t*)(ws + WS_G) + ((size_t)u.pm * 16 + (u.pn - 22)) * 65536 + (size_t)(wave * 1024 + lane) * 8;
        const int sA = smp ? HALF * 4096 : 4096, sM = smp ? 16 * 4096 : 1024, sB = smp ? HALF : 512;
#pragma unroll
        EPI_LOOP_ROWS {
#pragma unroll
            for (int bj = 0; bj < 2; ++bj) { f32x4 v0 = acc[ai][bj][m][0], v1 = acc[ai][bj][m][1];
#pragma unroll
                for (int e = 0; e < 4; ++e) { v0[e] = fast_sigmoid(v0[e]); v1[e] = fast_sigmoid(v1[e]); }
                *(u32x4*)(base + (size_t)(ai * sA + m * sM + bj * sB)) = pack8(v0, v1); } }
    }
    template <int KIND, bool ROT> __device__ __forceinline__ void qkv(const f32x4 (&acc)[2][2][4][2], const Unit& u, int row0, int colt, int c8, int fq) const {
        const bool smp = u.pm >= M_P / BM;
        const float sg = fq == 0 ? -1.f : 1.f; const bool act = fq < 2;
#pragma unroll
        for (int ai = 0; ai < 2; ++ai) {
        f32x4 rt[4][4];
        if (ROT) {
#pragma unroll
            for (int m = 0; m < 4; ++m) { const int row = row0 + ai * HALF + m * 16, loc = row - M_P; const int pos = smp ? PAST + (loc & 31) : (row & (SEQ - 1)); const f32x4* rp = (const f32x4*)(ws + WS_ROPE) + (size_t)pos * 4;
                rt[m][0] = rp[0]; rt[m][1] = rp[1]; rt[m][2] = rp[2]; rt[m][3] = rp[3]; }
            __builtin_amdgcn_sched_barrier(0); }
#pragma unroll
        for (int m = 0; m < 4; ++m) {
            const int row = row0 + ai * HALF + m * 16, loc = row - M_P;
            f32x4 cs0, cs1, sn0, sn1;
            if (ROT) { cs0 = rt[m][0]; cs1 = rt[m][1]; sn0 = rt[m][2]; sn1 = rt[m][3];
#pragma unroll
                for (int e = 0; e < 4; ++e) { cs0[e] = act ? cs0[e] : 1.f; cs1[e] = act ? cs1[e] : 1.f; sn0[e] = act ? sg * sn0[e] : 0.f; sn1[e] = act ? sg * sn1[e] : 0.f; } }
            float* of = nullptr; bf16_t* ob;
            if (KIND == 0) ob = (bf16_t*)(ws + WS_Q) + (size_t)row * 1024 + colt + c8;
            else { const size_t fo = smp ? (KIND == 1 ? O_KS : O_VS) + (size_t)l * M_S * 1024 + (size_t)loc * 1024 : (KIND == 1 ? O_KP : O_VP) + (size_t)l * M_P * 1024 + (size_t)row * 1024;
                of = out + fo + colt + c8;
                ob = smp ? (bf16_t*)(ws + (KIND == 1 ? WS_KS : WS_VS)) + ((size_t)(loc >> 5) * KS_ROWS + PAST + (loc & 31)) * 1024 + colt + c8 : (bf16_t*)(ws + (KIND == 1 ? WS_K : WS_V)) + (size_t)row * 1024 + colt + c8; }
#pragma unroll
            for (int bj = 0; bj < 2; ++bj) { f32x4 v0 = acc[ai][bj][m][0], v1 = acc[ai][bj][m][1];
                if (ROT) { f32x4 p0, p1;
#pragma unroll
                    for (int e = 0; e < 4; ++e) { p0[e] = swz_xor<16>(v0[e]); p1[e] = swz_xor<16>(v1[e]); }
                    v0 = v0 * cs0 + p0 * sn0; v1 = v1 * cs1 + p1 * sn1; }
                if (KIND == 0) { v0 = v0 * qscale; v1 = v1 * qscale; }
                else { *(f32x4*)(of + bj * HALF) = v0; *(f32x4*)(of + bj * HALF + 4) = v1; }
                bf16_t* o2 = ob + bj * HALF;
                if (((KIND == 1 && KT_K) || (KIND == 2 && KT_V)) && !smp) {
                    const int col = colt + bj * HALF + c8, bt = row >> 14, tile = (row & (SEQ - 1)) >> 6, r = row & 63;
                    o2 = KIND == 1 ? (bf16_t*)(ws + WS_K) + ((((size_t)(bt * 16 + (col >> 6)) * 256 + tile) * 8 + ((col >> 3) & 7)) * 64 + r) * 8
                                   : (bf16_t*)(ws + WS_V) + ((((size_t)(bt * 8 + (col >> 7)) * 256 + tile) * 4 + ((col >> 5) & 3)) * 64 + r) * 32 + (col & 31); }
                *(u32x4*)o2 = pack8(v0, v1); } }
        }
    }
    __device__ __forceinline__ void operator()(const f32x4 (&acc)[2][2][4][2], const Unit& u, int wr, int wc, int fr, int fq) const {
        { const int ln_ = lane_id(); fr = ln_ & 15; fq = ln_ >> 4; }
        const int pn = u.pn, row0 = u.pm * BM + wr * 64 + fr, c8 = wc * 32 + 8 * fq;
        if (pn < 10) plain<false>(acc, (bf16_t*)(ws + WS_ZP + (size_t)(pn >> 1) * SZ_512), 512, row0, (pn & 1) * BM + c8);
        else if (pn >= 22) gates(acc, u, wr * 4 + wc, fq * 16 + fr, row0, c8);
        else { const bool rot = (wc & 1) == 0;
            if (pn < 14) { if (rot) qkv<0, true>(acc, u, row0, (pn - 10) * BM, c8, fq); else qkv<0, false>(acc, u, row0, (pn - 10) * BM, c8, fq); }
            else if (pn < 18) { if (rot) qkv<1, true>(acc, u, row0, (pn - 14) * BM, c8, fq); else qkv<1, false>(acc, u, row0, (pn - 14) * BM, c8, fq); }
            else qkv<2, false>(acc, u, row0, (pn - 18) * BM, c8, fq); }
    }
};

struct EpiGlu {
    static constexpr bool PERM = true, AFTER_DRAIN = false, MIDK = false; static constexpr bool PROBE_REP = false; static constexpr bool PERM2 = false;
    unsigned char* ws;
    __device__ __forceinline__ void operator()(const f32x4 (&acc)[2][2][4][2], const Unit& u, int wr, int wc, int fr, int fq) const {
        { const int ln_ = lane_id(); fr = ln_ & 15; fq = ln_ >> 4; }
        const int row0 = u.pm * BM + wr * 64 + fr, c8 = wc * 32 + 8 * fq, colt = u.pn * BM;
        u32x4 vv[2][4][2];
#pragma unroll
        EPI_LOOP_ROWS {
#pragma unroll
            for (int bj = 0; bj < 2; ++bj) vv[ai][m][bj] = *(const u32x4*)((const bf16_t*)(ws + WS_VSSM) + (size_t)(row0 + ai * HALF + m * 16) * 512 + colt + bj * HALF + c8); }
        __builtin_amdgcn_sched_barrier(0);
#pragma unroll
        EPI_LOOP_ROWS { const int row = row0 + ai * HALF + m * 16;
#pragma unroll
            for (int bj = 0; bj < 2; ++bj) { f32x4 v0 = acc[ai][bj][m][0], v1 = acc[ai][bj][m][1]; const int col = colt + bj * HALF + c8; const u32x4 x = vv[ai][m][bj];
#pragma unroll
                for (int e = 0; e < 4; ++e) { v0[e] = fast_sigmoid(v0[e]); v1[e] = fast_sigmoid(v1[e]); }
                v0[0] *= bf_lo(x.x); v0[1] *= bf_hi(x.x); v0[2] *= bf_lo(x.y); v0[3] *= bf_hi(x.y); v1[0] *= bf_lo(x.z); v1[1] *= bf_hi(x.z); v1[2] *= bf_lo(x.w); v1[3] *= bf_hi(x.w);
                u32x4 w; w.x = cvt_pk_bf16(v0[0], v0[1]); w.y = cvt_pk_bf16(v0[2], v0[3]); w.z = cvt_pk_bf16(v1[0], v1[1]); w.w = cvt_pk_bf16(v1[2], v1[3]);
                *(u32x4*)((bf16_t*)(ws + WS_OALL) + (size_t)row * BR_W + 512 + col) = w; } }
    }
};

struct EpiMerge {
    static constexpr bool PERM = true, AFTER_DRAIN = false, MIDK = true; static constexpr bool PROBE_REP = false; static constexpr bool PERM2 = false;
    unsigned char* ws; int tid;
    template <bool DEN> __device__ __forceinline__ void scale(f32x4 (&acc)[2][2][4][2], const Unit& u, int wr, int wc, int fr, int fq, int bnum, int bden) const {
        int tid_ = tid; asm volatile("" : "+v"(tid_));
        { const int l_ = tid_ & 63, w_ = tid_ >> 6; fr = l_ & 15; fq = l_ >> 4; wr = w_ >> 2; wc = w_ & 3; }
        const int wave = wr * 4 + wc, lane = fq * 16 + fr;
        const bf16_t* gb = (const bf16_t*)(ws + WS_G) + ((size_t)u.pm * 16 + u.pn) * 65536 + (size_t)(wave * 1024 + lane) * 8;
#pragma unroll
        for (int ai = 0; ai < 2; ++ai) {
            u32x4 ga[4][2], gd[4][2];
#pragma unroll
            for (int m = 0; m < 4; ++m)
#pragma unroll
                for (int bj = 0; bj < 2; ++bj) { const bf16_t* gp = gb + (size_t)(ai * 4096 + m * 1024 + bj * 512);
                    ga[m][bj] = *(const u32x4*)(gp + (size_t)bnum * 262144); if (DEN) gd[m][bj] = *(const u32x4*)(gp + (size_t)bden * 262144); }
            __builtin_amdgcn_sched_barrier(0);
#pragma unroll
            for (int m = 0; m < 4; ++m)
#pragma unroll
                for (int bj = 0; bj < 2; ++bj) { const u32x4 a = ga[m][bj];
                    f32x4 r0 = {bf_lo(a.x), bf_hi(a.x), bf_lo(a.y), bf_hi(a.y)}, r1 = {bf_lo(a.z), bf_hi(a.z), bf_lo(a.w), bf_hi(a.w)};
                    if (DEN) { const u32x4 b = gd[m][bj];
                        r0[0] *= __builtin_amdgcn_rcpf(bf_lo(b.x)); r0[1] *= __builtin_amdgcn_rcpf(bf_hi(b.x)); r0[2] *= __builtin_amdgcn_rcpf(bf_lo(b.y)); r0[3] *= __builtin_amdgcn_rcpf(bf_hi(b.y));
                        r1[0] *= __builtin_amdgcn_rcpf(bf_lo(b.z)); r1[1] *= __builtin_amdgcn_rcpf(bf_hi(b.z)); r1[2] *= __builtin_amdgcn_rcpf(bf_lo(b.w)); r1[3] *= __builtin_amdgcn_rcpf(bf_hi(b.w)); }
                    acc[ai][bj][m][0] *= r0; acc[ai][bj][m][1] *= r1; }
            __builtin_amdgcn_sched_barrier(0);
        }
    }
    __device__ __forceinline__ void mid(f32x4 (&acc)[2][2][4][2], const Unit& u, int wr, int wc, int fr, int fq, int t) const {
        if (t == 8 || t == 16 || t == 24) scale<true>(acc, u, wr, wc, fr, fq, (t >> 3) - 1, t >> 3);
    }
    __device__ __forceinline__ void operator()(f32x4 (&acc)[2][2][4][2], const Unit& u, int wr, int wc, int fr, int fq) const {
        { const int ln_ = lane_id(); fr = ln_ & 15; fq = ln_ >> 4; }
        scale<false>(acc, u, wr, wc, fr, fq, 3, -1);
        int row0 = u.pm * BM + wr * 64 + fr; const int c8 = wc * 32 + 8 * fq;
        asm volatile("" : "+v"(row0));
#pragma unroll
        EPI_LOOP_ROWS { bf16_t* rowp = (bf16_t*)(ws + WS_MG) + (size_t)(row0 + ai * HALF + m * 16) * 1024 + u.pn * BM + c8;
#pragma unroll
            for (int bj = 0; bj < 2; ++bj) { const f32x4 v0 = acc[ai][bj][m][0], v1 = acc[ai][bj][m][1];
                u32x4 w; w.x = cvt_pk_bf16(v0[0], v0[1]); w.y = cvt_pk_bf16(v0[2], v0[3]); w.z = cvt_pk_bf16(v1[0], v1[1]); w.w = cvt_pk_bf16(v1[2], v1[3]);
                *(u32x4*)(rowp + bj * HALF) = w; } }
    }
};

struct EpiResid {
    static constexpr bool PERM = true, AFTER_DRAIN = false, MIDK = false; static constexpr bool PROBE_REP = false; static constexpr bool PERM2 = false;
    const bf16_t* resP; unsigned char* ws; int ybf;
    __device__ __forceinline__ void operator()(const f32x4 (&acc)[2][2][4][2], const Unit& u, int wr, int wc, int fr, int fq) const {
        { const int ln_ = lane_id(); fr = ln_ & 15; fq = ln_ >> 4; }
        const int row0 = u.pm * BM + wr * 64 + fr, col0 = u.pn * BM + wc * 32 + 8 * fq;
        u32x4 rr[2][4][2];
#pragma unroll
        EPI_LOOP_ROWS {
#pragma unroll
            for (int bj = 0; bj < 2; ++bj) rr[ai][m][bj] = *(const u32x4*)(resP + (size_t)(row0 + ai * HALF + m * 16) * 1024 + col0 + bj * HALF); }
        __builtin_amdgcn_sched_barrier(0);
#pragma unroll
        EPI_LOOP_ROWS { const size_t yo = (size_t)(row0 + ai * HALF + m * 16) * 1024 + col0;
#pragma unroll
            for (int bj = 0; bj < 2; ++bj) { const u32x4 w = rr[ai][m][bj];
                const f32x4 y0 = (f32x4){bf_lo(w.x), bf_hi(w.x), bf_lo(w.y), bf_hi(w.y)} * DN_ALPHA + acc[ai][bj][m][0], y1 = (f32x4){bf_lo(w.z), bf_hi(w.z), bf_lo(w.w), bf_hi(w.w)} * DN_ALPHA + acc[ai][bj][m][1];
                if (ybf) { u32x4 o; o.x = cvt_pk_bf16(y0[0], y0[1]); o.y = cvt_pk_bf16(y0[2], y0[3]); o.z = cvt_pk_bf16(y1[0], y1[1]); o.w = cvt_pk_bf16(y1[2], y1[3]); *(u32x4*)((bf16_t*)(ws + WS_YF) + yo + bj * HALF) = o; }
                else { *(f32x4*)((float*)(ws + WS_YF) + yo + bj * HALF) = y0; *(f32x4*)((float*)(ws + WS_YF) + yo + bj * HALF + 4) = y1; } } }
    }
};

struct EpiUp {
    static constexpr bool PERM = true, AFTER_DRAIN = false, MIDK = false; static constexpr bool PROBE_REP = false; static constexpr bool PERM2 = false;
    unsigned char* ws;
    __device__ __forceinline__ void operator()(const f32x4 (&acc)[2][2][4][2], const Unit& u, int wr, int wc, int fr, int fq) const {
        { const int ln_ = lane_id(); fr = ln_ & 15; fq = ln_ >> 4; }
        const int row0 = u.pm * BM + wr * 64 + fr, c8 = wc * 32 + 8 * fq;
#pragma unroll
        EPI_LOOP_ROWS { bf16_t* rowp = (bf16_t*)(ws + WS_G) + (size_t)(row0 + ai * HALF + m * 16) * D_FF + u.pn * BM + c8;
#pragma unroll
            for (int bj = 0; bj < 2; ++bj) { f32x4 v0 = acc[ai][bj][m][0], v1 = acc[ai][bj][m][1];
#pragma unroll
                for (int e = 0; e < 4; ++e) { const float a = fmaxf(v0[e], 0.f), b = fmaxf(v1[e], 0.f); v0[e] = a * a; v1[e] = b * b; }
                u32x4 w; w.x = cvt_pk_bf16(v0[0], v0[1]); w.y = cvt_pk_bf16(v0[2], v0[3]); w.z = cvt_pk_bf16(v1[0], v1[1]); w.w = cvt_pk_bf16(v1[2], v1[3]);
                *(u32x4*)(rowp + bj * HALF) = w; } }
    }
};

template <class Epi, class Sched, bool ALIGN_EPI = false, bool SP2 = false>
__device__ __forceinline__ void gemm_phase(PG8_LAS unsigned char* lds, const Gemm g, const Sched& S, const Epi& E) {
    int tid0_ = S.tid; asm volatile("" : "+v"(tid0_));
    const int tid = tid0_, wid = __builtin_amdgcn_readfirstlane(tid >> 6), lane = tid & 63, wr = wid >> 2, wc = wid & 3, fr = lane & 15, fq = lane >> 4;
    const int K = g.K, nt = K / BK;
    unsigned voffA[2], voffB[2];
#pragma unroll
    for (int i = 0; i < 2; ++i) { int R, C; stage_rc(tid * 16 + i * 8192, R, C); const int Rb = Epi::PERM2 ? ((R >> 5) * 64 + perm32(R & 31)) : Epi::PERM ? ((R & ~31) + perm32(R & 31)) : R;
        voffA[i] = (unsigned)(R * K + C) * 2u; voffB[i] = (unsigned)(Rb * K + C) * 2u; }
    const size_t kstep = (size_t)(BK * 2);
    const size_t hstepB = Epi::PERM2 ? (size_t)32 * K * 2 : (size_t)HALF * K * 2;
    const size_t hstep = (size_t)HALF * K * 2;
    const unsigned ldsw = (unsigned)wid * 1024u;
    const int aoff = lds_byte(wr * 64 + fr, fq * 8), boff = lds_byte(wc * 32 + fr, fq * 8);
#define PG8_SA(b, h) (((b) * 2 + (h)) * HTB)
#define PG8_SB(b, h) ((4 + (b) * 2 + (h)) * HTB)
#define PG8_STAGE(bufoff, gbase, voff) do { _Pragma("unroll") for (int _i = 0; _i < 2; ++_i) \
        __builtin_amdgcn_global_load_lds((const unsigned*)((const char*)(gbase) + (voff)[_i]), (PG8_LAS unsigned*)(lds + (bufoff) + ldsw + _i * 8192), 16, 0, 0); } while (0)
#define PG8_LDA(dst, b, h) do { _Pragma("unroll") for (int m = 0; m < 4; ++m) _Pragma("unroll") for (int k = 0; k < 2; ++k) dst[m][k] = *(const PG8_LAS bf16x8*)(lds + PG8_SA(b, h) + aoff + m * 2048 + k * 1024); } while (0)
#define PG8_LDB(dst, b, h) do { _Pragma("unroll") for (int n = 0; n < 2; ++n) _Pragma("unroll") for (int k = 0; k < 2; ++k) dst[n][k] = *(const PG8_LAS bf16x8*)(lds + PG8_SB(b, h) + boff + n * 2048 + k * 1024); } while (0)
#define PG8_MMA(ai, bj, At, Bt) do { __builtin_amdgcn_s_setprio(1); _Pragma("unroll") for (int m = 0; m < 4; ++m) _Pragma("unroll") for (int n = 0; n < 2; ++n) _Pragma("unroll") for (int k = 0; k < 2; ++k) \
        acc[ai][bj][m][n] = __builtin_amdgcn_mfma_f32_16x16x32_bf16(Bt[n][k], At[m][k], acc[ai][bj][m][n], 0, 0, 0); __builtin_amdgcn_s_setprio(0); } while (0)
#define PG8_WAIT_V(n) asm volatile("s_waitcnt vmcnt(" #n ")" ::: "memory")
#define PG8_WAIT_L(n) asm volatile("s_waitcnt lgkmcnt(" #n ")" ::: "memory")
#define PG8_BAR __builtin_amdgcn_s_barrier()
#define PG8_SCHED __builtin_amdgcn_sched_barrier(0)
    Unit cur, nxt; int ui = 0;
    if (!S.next(0, cur)) return;
    f32x4 acc[2][2][4][2];
#pragma unroll
    for (int a = 0; a < 2; ++a)
#pragma unroll
        for (int b = 0; b < 2; ++b)
#pragma unroll
            for (int m = 0; m < 4; ++m)
#pragma unroll
                for (int n = 0; n < 2; ++n) acc[a][b][m][n] = (f32x4){0.f, 0.f, 0.f, 0.f};
    bf16x8 At[4][2], B0[2][2], B1[2][2];
    const char* cA = S.abase(g, cur); const char* cB = S.bbase(g, cur);
    S.a_ready(cur);
    if constexpr (SP2) {
        PG8_STAGE(PG8_SB(0, 0), cB, voffB); PG8_STAGE(PG8_SB(0, 1), cB + hstepB, voffB); PG8_STAGE(PG8_SA(0, 0), cA, voffA); PG8_STAGE(PG8_SA(0, 1), cA + hstep, voffA);
        if (wr == 1) PG8_BAR;
        PG8_WAIT_V(2); PG8_BAR;
        PG8_STAGE(PG8_SB(1, 0), cB + kstep, voffB); PG8_STAGE(PG8_SA(1, 0), cA + kstep, voffA); PG8_STAGE(PG8_SB(1, 1), cB + hstepB + kstep, voffB);
        PG8_WAIT_V(6); PG8_BAR;
    } else {
        PG8_STAGE(PG8_SB(0, 0), cB, voffB); PG8_STAGE(PG8_SA(0, 0), cA, voffA); PG8_STAGE(PG8_SB(0, 1), cB + hstepB, voffB); PG8_STAGE(PG8_SA(0, 1), cA + hstep, voffA);
        if (wr == 1) PG8_BAR;
        PG8_WAIT_V(4); PG8_BAR;
        PG8_STAGE(PG8_SB(1, 0), cB + kstep, voffB); PG8_STAGE(PG8_SA(1, 0), cA + kstep, voffA); PG8_STAGE(PG8_SB(1, 1), cB + hstepB + kstep, voffB);
        PG8_WAIT_V(6); PG8_BAR;
    }
    for (;;) {
        const bool has_next = S.next(ui + 1, nxt);
        const char* nA = has_next ? S.abase(g, nxt) : cA; const char* nB = has_next ? S.bbase(g, nxt) : cB;
        for (int t = 0; t < nt; t += 2) {
            const bool last = (t == nt - 2);
            const char* a1 = cA + (size_t)(t + 1) * kstep;
            const char* a2 = last ? nA : cA + (size_t)(t + 2) * kstep; const char* b2 = last ? nB : cB + (size_t)(t + 2) * kstep;
            const char* a3 = a2 + kstep; const char* b3 = b2 + kstep;
            if (last && has_next) S.a_ready(nxt);
            if constexpr (Epi::MIDK) E.mid(acc, cur, wr, wc, fr, fq, t);
            if constexpr (SP2) {
            PG8_LDB(B0, 0, 0); PG8_LDB(B1, 0, 1); PG8_SCHED; PG8_LDA(At, 0, 0); PG8_STAGE(PG8_SA(1, 1), a1 + hstep, voffA);
            PG8_WAIT_V(8); PG8_WAIT_L(0); PG8_BAR; PG8_MMA(0, 0, At, B0); PG8_MMA(0, 1, At, B1); PG8_BAR; PG8_SCHED;
            PG8_LDA(At, 0, 1); PG8_STAGE(PG8_SB(0, 0), b2, voffB); PG8_STAGE(PG8_SB(0, 1), b2 + hstepB, voffB); PG8_STAGE(PG8_SA(0, 0), a2, voffA);
            PG8_WAIT_V(8); PG8_WAIT_L(0); PG8_BAR; PG8_MMA(1, 0, At, B0); PG8_MMA(1, 1, At, B1); PG8_BAR; PG8_SCHED;
            PG8_LDB(B0, 1, 0); PG8_LDB(B1, 1, 1); PG8_SCHED; PG8_LDA(At, 1, 0); PG8_STAGE(PG8_SA(0, 1), a2 + hstep, voffA);
            PG8_WAIT_V(8); PG8_WAIT_L(0); PG8_BAR; PG8_MMA(0, 0, At, B0); PG8_MMA(0, 1, At, B1); PG8_BAR; PG8_SCHED;
            PG8_LDA(At, 1, 1); PG8_STAGE(PG8_SB(1, 0), b3, voffB); PG8_STAGE(PG8_SB(1, 1), b3 + hstepB, voffB); PG8_STAGE(PG8_SA(1, 0), a3, voffA);
            PG8_WAIT_V(8); PG8_WAIT_L(0); PG8_BAR; PG8_MMA(1, 0, At, B0); PG8_MMA(1, 1, At, B1); PG8_BAR; PG8_SCHED;
            } else {
            PG8_LDB(B0, 0, 0); PG8_SCHED; PG8_LDA(At, 0, 0); PG8_STAGE(PG8_SA(1, 1), a1 + hstep, voffA);
            PG8_WAIT_L(8); PG8_BAR; PG8_WAIT_L(0); PG8_MMA(0, 0, At, B0); PG8_BAR; PG8_SCHED;
            PG8_LDB(B1, 0, 1); PG8_STAGE(PG8_SB(0, 0), b2, voffB);
            PG8_BAR; PG8_WAIT_L(0); PG8_MMA(0, 1, At, B1); PG8_BAR;
            PG8_LDA(At, 0, 1); PG8_STAGE(PG8_SA(0, 0), a2, voffA);
            PG8_BAR; PG8_WAIT_L(0); PG8_MMA(1, 0, At, B0); PG8_BAR; PG8_SCHED;
            PG8_STAGE(PG8_SB(0, 1), b2 + hstepB, voffB);
            PG8_WAIT_V(6); PG8_BAR; PG8_MMA(1, 1, At, B1); PG8_BAR;
            PG8_LDB(B0, 1, 0); PG8_SCHED; PG8_LDA(At, 1, 0); PG8_STAGE(PG8_SA(0, 1), a2 + hstep, voffA);
            PG8_WAIT_L(8); PG8_BAR; PG8_WAIT_L(0); PG8_MMA(0, 0, At, B0); PG8_BAR; PG8_SCHED;
            PG8_LDB(B1, 1, 1); PG8_STAGE(PG8_SB(1, 0), b3, voffB);
            PG8_BAR; PG8_WAIT_L(0); PG8_MMA(0, 1, At, B1); PG8_BAR;
            PG8_LDA(At, 1, 1); PG8_STAGE(PG8_SA(1, 0), a3, voffA);
            PG8_BAR; PG8_WAIT_L(0); PG8_MMA(1, 0, At, B0); PG8_BAR; PG8_SCHED;
            PG8_STAGE(PG8_SB(1, 1), b3 + hstepB, voffB);
            PG8_WAIT_V(6); PG8_BAR; PG8_MMA(1, 1, At, B1); PG8_BAR;
            }
        }
        if constexpr (ALIGN_EPI) { if (wr == 0) PG8_BAR; }
        if constexpr (!Epi::AFTER_DRAIN) { E(acc, cur, wr, wc, fr, fq); if constexpr (EPI_REP > 1 && Epi::PROBE_REP) { _Pragma("unroll 1") for (int e_ = 1; e_ < EPI_REP; ++e_) { asm volatile("" ::: "memory"); E(acc, cur, wr, wc, fr, fq); } } S.done(cur); }
        if (!has_next) break;
#pragma unroll
        for (int a = 0; a < 2; ++a)
#pragma unroll
            for (int b = 0; b < 2; ++b)
#pragma unroll
                for (int m = 0; m < 4; ++m)
#pragma unroll
                    for (int n = 0; n < 2; ++n) acc[a][b][m][n] = (f32x4){0.f, 0.f, 0.f, 0.f};
        cur = nxt; cA = nA; cB = nB; ++ui;
        if constexpr (ALIGN_EPI) { if (wr == 1) PG8_BAR; }
    }
    PG8_WAIT_V(0);
    if constexpr (!ALIGN_EPI) { if (wr == 0) PG8_BAR; }
    PG8_BAR;
    if constexpr (Epi::AFTER_DRAIN) { E.fused(acc, cur, wr, wc, fr, fq, lds, wid, lane); S.done(cur); }
#undef PG8_SA
#undef PG8_SB
#undef PG8_STAGE
#undef PG8_LDA
#undef PG8_LDB
#undef PG8_MMA
#undef PG8_WAIT_V
#undef PG8_WAIT_L
#undef PG8_BAR
#undef PG8_SCHED
}
}

#include <hip/hip_bf16.h>
#include <cmath>
namespace attn_body {
using bf16=__hip_bfloat16;
using bf16x8=__attribute__((ext_vector_type(8)))short;
using s16x4=__attribute__((ext_vector_type(4)))short;
using f32x16=__attribute__((ext_vector_type(16)))float;
using u32x4=__attribute__((ext_vector_type(4)))unsigned;
constexpr int D=64,DM=1024,OPITCH=2048;
constexpr int NW=8,QBLK=32,QB=QBLK*NW,KVBLK=64;
constexpr int ATTN_UNIT_ROWS=QB;
__device__ __forceinline__ int crow(int r,int hi){return (r&3)+8*(r>>2)+4*hi;}
#define SBAR() __builtin_amdgcn_sched_barrier(0)
__device__ __forceinline__ void bmask(f32x16&p0,f32x16&p1,int jb,int wid,int mode){
  const float NEG=-INFINITY; bool m0,m1;
  if(mode==0){ m0=jb>(wid>>1); m1=m0; } else { m0=(jb==3); m1=(jb>=2); }
  if(m0){
    #pragma unroll
    for(int r=0;r<16;++r)p0[r]=NEG; }
  if(m1){
    #pragma unroll
    for(int r=0;r<16;++r)p1[r]=NEG; }
}

constexpr int NSLOT=3, SLOTB=8192;
constexpr int LDS_K=0, LDS_V=NSLOT*SLOTB, LDS_WS=3*NSLOT*SLOTB, LDS_OST=LDS_WS+NW*64*4, LDS_BYTES=LDS_OST+NW*4096;
constexpr float C2=0.125f*1.4426950408889634f;
__device__ __forceinline__ void glds16(const void*gsrc,unsigned lds_dst){unsigned keep;
  asm volatile("s_mov_b32 %0, m0\n\ts_mov_b32 m0, %2\n\ts_nop 0\n\tglobal_load_lds_dwordx4 %1, off\n\ts_mov_b32 m0, %0":"=&s"(keep):"v"(gsrc),"s"(lds_dst):"memory");}
__device__ __forceinline__ float max3f(float a,float b,float c){float r;asm("v_max3_f32 %0, %1, %2, %3":"=v"(r):"v"(a),"v"(b),"v"(c));return r;}
__device__ __forceinline__ float max2f(float a,float b){float r;asm("v_max_f32_e32 %0, %1, %2":"=v"(r):"v"(a),"v"(b));return r;}
__device__ __forceinline__ float fadd_s(float a,float b){float r;asm("v_add_f32_e32 %0, %1, %2":"=v"(r):"v"(a),"v"(b));return r;}
__device__ __forceinline__ float fsub_s(float a,float b){float r;asm("v_sub_f32_e32 %0, %1, %2":"=v"(r):"v"(a),"v"(b));return r;}
typedef float f32x2_t __attribute__((ext_vector_type(2))); typedef __bf16 bf16x2_t __attribute__((ext_vector_type(2)));
__device__ __forceinline__ unsigned cvtpk_s(float lo,float hi){f32x2_t v={lo,hi};bf16x2_t b=__builtin_convertvector(v,bf16x2_t);return __builtin_bit_cast(unsigned,b);}
#define WAIT_BAR(N) asm volatile("s_waitcnt vmcnt(" #N ") lgkmcnt(0)\n\ts_barrier":::"memory")

__device__ __forceinline__ void qkt(f32x16&p0,f32x16&p1,const char*Kslot,const bf16x8*qr,const f32x16&negm,int r32,int hi){
  const char*kb=Kslot+hi*1024+r32*16;
  #pragma unroll
  for(int d0=0;d0<4;++d0){
    const bf16x8 b0=*reinterpret_cast<const bf16x8*>(kb+d0*2048);
    const bf16x8 b1=*reinterpret_cast<const bf16x8*>(kb+d0*2048+512);
    if(d0==0){p0=__builtin_amdgcn_mfma_f32_32x32x16_bf16(b0,qr[0],negm,0,0,0);p1=__builtin_amdgcn_mfma_f32_32x32x16_bf16(b1,qr[0],negm,0,0,0);}
    else{p0=__builtin_amdgcn_mfma_f32_32x32x16_bf16(b0,qr[d0],p0,0,0,0);p1=__builtin_amdgcn_mfma_f32_32x32x16_bf16(b1,qr[d0],p1,0,0,0);}}
}
typedef __attribute__((address_space(3))) const char* lds_cptr;
typedef short v4i16_t __attribute__((ext_vector_type(4)));
__device__ __forceinline__ void kload8(bf16x8*kf,lds_cptr kp){
  kf[0]=*(const __attribute__((address_space(3))) bf16x8*)(kp);      kf[1]=*(const __attribute__((address_space(3))) bf16x8*)(kp+512);
  kf[2]=*(const __attribute__((address_space(3))) bf16x8*)(kp+2048); kf[3]=*(const __attribute__((address_space(3))) bf16x8*)(kp+2560);
  kf[4]=*(const __attribute__((address_space(3))) bf16x8*)(kp+4096); kf[5]=*(const __attribute__((address_space(3))) bf16x8*)(kp+4608);
  kf[6]=*(const __attribute__((address_space(3))) bf16x8*)(kp+6144); kf[7]=*(const __attribute__((address_space(3))) bf16x8*)(kp+6656);
}
__device__ __forceinline__ void kload2(bf16x8*kf,lds_cptr kp,int j){ kf[2*j]=*(const __attribute__((address_space(3))) bf16x8*)(kp+j*2048); kf[2*j+1]=*(const __attribute__((address_space(3))) bf16x8*)(kp+j*2048+512); }
__device__ __forceinline__ s16x4 vtr(lds_cptr p){ return __builtin_bit_cast(s16x4,__builtin_amdgcn_ds_read_tr16_b64_v4i16((__attribute__((address_space(3))) v4i16_t*)p)); }
__device__ __forceinline__ float rowmax(const f32x16&p0,const f32x16&p1){
  float a=max3f(p0[0],p0[1],p1[0]),b=max3f(p0[2],p0[3],p1[1]);a=max3f(a,p1[2],p1[3]);
  #pragma unroll
  for(int r=4;r<16;r+=4){a=max3f(a,p0[r],p0[r+1]);b=max3f(b,p0[r+2],p0[r+3]);a=max3f(a,p1[r],p1[r+1]);b=max3f(b,p1[r+2],p1[r+3]);}
  const float m=max2f(a,b);
  auto rr=__builtin_amdgcn_permlane32_swap(__float_as_uint(m),__float_as_uint(m),false,false);
  return max2f(__uint_as_float(rr[0]),__uint_as_float(rr[1]));
}
__device__ __forceinline__ void pv(f32x16*o,int vb,bf16x8 pa0,bf16x8 pa1,bf16x8 pa2,bf16x8 pa3){
  #pragma unroll
  for(int d0=0;d0<4;++d0){s16x4 lo[4],hi[4];
    #pragma unroll
    for(int ks=0;ks<4;++ks){
      asm volatile("ds_read_b64_tr_b16 %0,%1 offset:%c2":"=&v"(lo[ks]):"v"(vb),"i"(d0*4096+ks*1024):"memory");
      asm volatile("ds_read_b64_tr_b16 %0,%1 offset:%c2":"=&v"(hi[ks]):"v"(vb),"i"(d0*4096+ks*1024+512):"memory");}
    asm volatile("s_waitcnt lgkmcnt(0)":::"memory");SBAR();
    #define PK(k) (bf16x8){lo[k][0],lo[k][1],lo[k][2],lo[k][3],hi[k][0],hi[k][1],hi[k][2],hi[k][3]}
    o[d0]=__builtin_amdgcn_mfma_f32_32x32x16_bf16(pa0,PK(0),o[d0],0,0,0);
    o[d0]=__builtin_amdgcn_mfma_f32_32x32x16_bf16(pa1,PK(1),o[d0],0,0,0);
    o[d0]=__builtin_amdgcn_mfma_f32_32x32x16_bf16(pa2,PK(2),o[d0],0,0,0);
    o[d0]=__builtin_amdgcn_mfma_f32_32x32x16_bf16(pa3,PK(3),o[d0],0,0,0);
    #undef PK
  }
}

#ifndef ATTN_STORE16
#define ATTN_STORE16(p,v) (*(u32x4*)(p)=(v))
#endif

using f32x4=__attribute__((ext_vector_type(4)))float;
struct PChunk { f32x4 a, b; };
__device__ __forceinline__ void pchunk_geom(int id, int tk, int tv, int NT, bool& isk, bool& valid, int& kr, int& col, int& ldsoff) {
  isk = id < 512; const int v = id - 512;
  const int g = id & 7, rest = id >> 3, kc = (rest & 1) * 4 + (g & 3), krow = (rest >> 1) * 2 + (g >> 2);
  const int pc = v >> 6, ln = v & 63, vrow = 16 * (pc & 3) + (ln >> 2), vcol = (pc >> 2) * 32 + (ln & 3) * 8;
  const int tile = isk ? tk : tv, row = isk ? krow : vrow; col = isk ? kc * 8 : vcol;
  valid = (tile >= 0) && (tile < NT) && (id < 1536);
  kr = tile * 64 + row;
  const int slot = (tile + 3) % 3;
  ldsoff = isk ? LDS_K + slot * SLOTB + kc * 1024 + krow * 16 : LDS_V + slot * 2 * SLOTB + v * 16;
}
__device__ __forceinline__ PChunk pchunk_load(int id, int tk, int tv, int NT, const float* Kc, const float* Vc, const bf16* Kn, const bf16* Vn) {
  bool isk, valid; int kr, col, ldsoff; pchunk_geom(id, tk, tv, NT, isk, valid, kr, col, ldsoff);
  const char* pf = (const char*)((isk ? Kc : Vc) + (long)kr * 1024 + col);
  const char* pb = (const char*)((isk ? Kn : Vn) + (long)kr * 1024 + col);
  const char* p = (!valid || kr >= 4096 + 32) ? (const char*)Kc : (kr < 4096 ? pf : pb);
  PChunk c; c.a = *(const f32x4*)p; c.b = *(const f32x4*)(p + 16); return c;
}
__device__ __forceinline__ void pchunk_store(const PChunk& c, int id, int tk, int tv, int NT, char* shm) {
  bool isk, valid; int kr, col, ldsoff; pchunk_geom(id, tk, tv, NT, isk, valid, kr, col, ldsoff);
  u32x4 w; w.x = cvtpk_s(c.a[0], c.a[1]); w.y = cvtpk_s(c.a[2], c.a[3]); w.z = cvtpk_s(c.b[0], c.b[1]); w.w = cvtpk_s(c.b[2], c.b[3]);
  const u32x4 raw = __builtin_bit_cast(u32x4, c.a);
  const bool isnew = kr >= 4096 && kr < 4096 + 32, zero = kr >= 4096 + 32;
  w.x = zero ? 0u : isnew ? raw.x : w.x; w.y = zero ? 0u : isnew ? raw.y : w.y; w.z = zero ? 0u : isnew ? raw.z : w.z; w.w = zero ? 0u : isnew ? raw.w : w.w;
  if (valid) *(__attribute__((address_space(3))) u32x4*)((lds_cptr)shm + ldsoff) = w;
}
#define PBAR() asm volatile("s_waitcnt lgkmcnt(0)\n\ts_barrier":::"memory")
__device__ __forceinline__ void sample_producer(const int NT, const float* Kc, const float* Vc, const bf16* Kn, const bf16* Vn, char* shm, int wid, int lane) {
  const int p = (wid - 1) * 64 + lane;
  PChunk a0, a1, a2, a3, b0, b1, b2, b3, c0, c1, c2, c3;
  #define PLOAD(X,tk,tv) do{ X##0=pchunk_load(p,tk,tv,NT,Kc,Vc,Kn,Vn); X##1=pchunk_load(p+448,tk,tv,NT,Kc,Vc,Kn,Vn); X##2=pchunk_load(p+896,tk,tv,NT,Kc,Vc,Kn,Vn); X##3=pchunk_load(p+1344,tk,tv,NT,Kc,Vc,Kn,Vn); }while(0)
  #define PSTORE(X,tk,tv) do{ pchunk_store(X##0,p,tk,tv,NT,shm); pchunk_store(X##1,p+448,tk,tv,NT,shm); pchunk_store(X##2,p+896,tk,tv,NT,shm); pchunk_store(X##3,p+1344,tk,tv,NT,shm); }while(0)
  #define PSTEP(X,s) do{ PSTORE(X,(s)+3,(s)+1); PLOAD(X,(s)+6,(s)+4); PBAR(); }while(0)
  PLOAD(a,0,-1); PLOAD(b,1,0); PLOAD(c,2,-1);
  PSTORE(a,0,-1); PBAR();
  PLOAD(a,3,1);
  PSTORE(b,1,0); PSTORE(c,2,-1); PBAR();
  PLOAD(b,4,2); PLOAD(c,5,3);
  PSTORE(a,3,1); PLOAD(a,6,4); PBAR();
  int s = 1;
  for (; s + 2 <= NT - 2; s += 3) { PSTEP(b, s); PSTEP(c, s + 1); PSTEP(a, s + 2); }
  if (s <= NT - 2) { PSTEP(b, s); ++s; }
  if (s <= NT - 2) { PSTEP(c, s); ++s; }
  PBAR();
  #undef PLOAD
  #undef PSTORE
  #undef PSTEP
}
#undef PBAR
template<int THRL> __device__ __forceinline__ void attn_unit(const int mode,const int NT,const bf16*Qw0,const bf16*__restrict__ Kh,const bf16*__restrict__ Vh,bf16*Ow0,char*shm,const float*Kc,const float*Vc,const int tid_in,const bool pre,const bool pfN,const bf16*KhN,const bf16*VhN){
  int tid0_=tid_in; asm volatile("":"+v"(tid0_));
  const int tid=tid0_,lane=tid&63,r32=lane&31,hi=lane>>5; const int wid=__builtin_amdgcn_readfirstlane(tid>>6);
  const bf16*Qw=Qw0+(long)wid*QBLK*DM; const bool qvalid=(mode==0)||(wid==0); const bool dma=(mode==0);
  if(mode==1&&wid!=0){ sample_producer(NT,Kc,Vc,Kh,Vh,shm,wid,lane); return; }
  const unsigned lds0=(unsigned)(uintptr_t)shm;
  float*wsf=(float*)(shm+LDS_WS)+wid*64;
  const bf16*ksrc=Kh+wid*512+lane*8;
  const bf16*vsrc=Vh+(wid>>2)*2048+(wid&3)*512+lane*8;
  const unsigned kdst=lds0+LDS_K+wid*1024, vdst=lds0+LDS_V+wid*1024;
  #define DMA_K(t,slot) if(dma)glds16(ksrc+(long)(t)*4096,(unsigned)__builtin_amdgcn_readfirstlane(kdst+(slot)))
  #define DMA_V(t,slot) if(dma)do{ glds16(vsrc+(long)(t)*8192,(unsigned)__builtin_amdgcn_readfirstlane(vdst+2*(slot))); glds16(vsrc+(long)(t)*8192+4096,(unsigned)__builtin_amdgcn_readfirstlane(vdst+2*(slot)+8192)); }while(0)
  const int vb0=(int)(lds0+LDS_V)+((lane>>4)&1)*32+(lane&3)*8+(4*hi+((lane&15)>>2))*64;
  const char*Kbase=shm+LDS_K; bf16x8 kf[8];
  const lds_cptr shm3=(lds_cptr)shm; const lds_cptr kp0=shm3+LDS_K+hi*1024+r32*16; const lds_cptr vp0=shm3+LDS_V+((lane>>4)&1)*32+(lane&3)*8+(4*hi+((lane&15)>>2))*64;
  if(!pre){DMA_K(0,0);DMA_V(0,0);DMA_K(1,SLOTB);}
  bf16x8 qr[4];
  #pragma unroll
  for(int d0=0;d0<4;++d0){ if(qvalid)qr[d0]=*reinterpret_cast<const bf16x8*>(&Qw[(long)r32*DM+d0*16+hi*8]); else qr[d0]=bf16x8{}; }
  const lds_cptr qls=(lds_cptr)shm+LDS_OST+wid*4096+lane*16;
  #pragma unroll
  for(int d0=0;d0<4;++d0)*(__attribute__((address_space(3))) bf16x8*)((lds_cptr)qls+d0*1024)=qr[d0];
  #define QLD(d) (*(const __attribute__((address_space(3))) bf16x8*)(qls+(d)*1024))
  bf16x8 qa=qr[0],qb;
  float mhat=0.f,l_reg=0.f;f32x16 o[4];o[0]=f32x16{};o[1]=f32x16{};o[2]=f32x16{};o[3]=f32x16{};f32x16 negm=f32x16{};asm volatile("":"+v"(negm));
  #define CMASK(P0,P1,t) do{int jb_=(t)-(NT-4); if(jb_>=0)bmask(P0,P1,jb_,wid,mode);}while(0)
  bool resc=false;
  #define START(P0,P1) do{ const float rm=rowmax(P0,P1); resc=false; \
    { const float dl=rm; mhat=fadd_s(mhat,dl); \
      _Pragma("unroll") for(int r=0;r<16;++r){P0[r]=fsub_s(P0[r],dl);P1[r]=fsub_s(P1[r],dl);} \
      _Pragma("unroll") for(int r=0;r<16;++r)negm[r]=-mhat; asm volatile("":"+v"(negm)); } \
    _Pragma("unroll") for(int r=0;r<16;++r)P0[r]=__builtin_amdgcn_exp2f(P0[r]); }while(0)
  #define RESC() do{ if(resc){ asm volatile("s_waitcnt lgkmcnt(0)":::"memory"); \
      _Pragma("unroll") for(int d_=0;d_<4;++d_) _Pragma("unroll") for(int r=0;r<16;++r)o[d_][r]*=wsf[crow(r,hi)]; } }while(0)
  f32x16 pA0,pA1,pB0,pB1;
  int sl_prev=0,sl_cur=0,sl_next=SLOTB;
  #define ROT() do{sl_prev=sl_cur;sl_cur=sl_next;sl_next=(sl_next==(NSLOT-1)*SLOTB)?0:sl_next+SLOTB;}while(0)
  DMA_K(2,2*SLOTB);
  WAIT_BAR(4);
  qkt(pA0,pA1,Kbase,qr,negm,r32,hi);asm volatile("s_nop 15\n\ts_nop 7":"+v"(pA0),"+v"(pA1));CMASK(pA0,pA1,0);
  START(pA0,pA1);
  _Pragma("unroll") for(int r=0;r<16;++r)pA1[r]=__builtin_amdgcn_exp2f(pA1[r]);
  WAIT_BAR(0);
  DMA_K(3,0);DMA_V(1,SLOTB);
  ROT();
  kload8(kf,kp0+sl_cur);
  WAIT_BAR(3);
  s16x4 vlo[8],vhi[8]; u32x4 pw0,pw1,pw2,pw3;
  #define PKW(P,B) cvtpk_s(P[B],P[B+1])
  #define PAF(k) __builtin_bit_cast(bf16x8,pw##k)
  #define VFR(i) (bf16x8){vlo[i][0],vlo[i][1],vlo[i][2],vlo[i][3],vhi[i][0],vhi[i][1],vhi[i][2],vhi[i][3]}
  #define PIN(x) asm volatile("":"+v"(x))
  #define MX3(a,b,c) __builtin_fmaxf(__builtin_fmaxf((a),(b)),(c))
  #define GAPA(MF,A0,A1,A2,A3,W0,W1,PW) do{ MF; sacc+=A0; sacc+=A1; sacc+=A2; sacc+=A3; PIN(sacc); W0; W1; PIN(PW); SBAR(); }while(0)
  #define EX(v) __builtin_amdgcn_exp2f(v)
  #define GAPB(MF,X,B) do{ MF; X[B]=EX(X[B]); X[B+1]=EX(X[B+1]); X[B+2]=EX(X[B+2]); X[B+3]=EX(X[B+3]); PIN(X); SBAR(); }while(0)
  #define VRD(i) do{ vlo[i]=vtr(vp_+(((i)>>2)*4096+((i)&3)*1024)); vhi[i]=vtr(vp_+(((i)>>2)*4096+((i)&3)*1024+512)); }while(0)
  #define VRD2(s,i) do{ vlo[s]=vtr(vp_+(((i)>>2)*4096+((i)&3)*1024)); vhi[s]=vtr(vp_+(((i)>>2)*4096+((i)&3)*1024+512)); }while(0)
  #define GAPB2(MF,RD,X,B) do{ MF; RD; X[B]=EX(X[B]); X[B+1]=EX(X[B+1]); PIN(X); SBAR(); }while(0)
  #define KRD(G,j) do{ if(G){ kload2(kf,kp0+sl_next,j); SBAR(); } }while(0)
  #define STEP(C0,C1,P0,P1,t,GK,GV,GL) do{ SBAR(); \
    const lds_cptr vp_=vp0+2*sl_prev; \
    qb=QLD(1); VRD(0); SBAR(); float sacc=(P0[0]+P0[1]); \
    GAPA(C0=__builtin_amdgcn_mfma_f32_32x32x16_bf16(kf[0],qa,negm,0,0,0), P0[2],P0[3],P0[4],P0[5],     pw0[0]=PKW(P0,0), pw0[1]=PKW(P0,2), pw0); \
    VRD(4); SBAR(); GAPA(C1=__builtin_amdgcn_mfma_f32_32x32x16_bf16(kf[1],qa,negm,0,0,0), P0[6],P0[7],P0[8],P0[9],     pw0[2]=PKW(P0,4), pw0[3]=PKW(P0,6), pw0); \
    qa=QLD(2); VRD(1); SBAR(); GAPA(C0=__builtin_amdgcn_mfma_f32_32x32x16_bf16(kf[2],qb,C0,0,0,0),   P0[10],P0[11],P0[12],P0[13], pw1[0]=PKW(P0,8), pw1[1]=PKW(P0,10), pw1); \
    VRD(5); SBAR(); GAPA(C1=__builtin_amdgcn_mfma_f32_32x32x16_bf16(kf[3],qb,C1,0,0,0),   P0[14],P0[15],P1[0],P1[1],   pw1[2]=PKW(P0,12),pw1[3]=PKW(P0,14), pw1); \
    qb=QLD(3); VRD(2); SBAR(); GAPA(C0=__builtin_amdgcn_mfma_f32_32x32x16_bf16(kf[4],qa,C0,0,0,0),   P1[2],P1[3],P1[4],P1[5],     pw2[0]=PKW(P1,0), pw2[1]=PKW(P1,2), pw2); \
    VRD(6); SBAR(); GAPA(C1=__builtin_amdgcn_mfma_f32_32x32x16_bf16(kf[5],qa,C1,0,0,0),   P1[6],P1[7],P1[8],P1[9],     pw2[2]=PKW(P1,4), pw2[3]=PKW(P1,6), pw2); \
    VRD(3); SBAR(); GAPA(C0=__builtin_amdgcn_mfma_f32_32x32x16_bf16(kf[6],qb,C0,0,0,0),   P1[10],P1[11],P1[12],P1[13], pw3[0]=PKW(P1,8), pw3[1]=PKW(P1,10), pw3); \
    VRD(7); SBAR(); GAPA(C1=__builtin_amdgcn_mfma_f32_32x32x16_bf16(kf[7],qb,C1,0,0,0),   P1[14],P1[15],0.f,0.f,       pw3[2]=PKW(P1,12),pw3[3]=PKW(P1,14), pw3); \
    l_reg+=sacc; \
    if(GK){DMA_K((t)+3,sl_cur);} if(GV){DMA_V((t)+1,sl_next);} \
    CMASK(C0,C1,t); \
    SBAR(); float mxa_,mxb_,rm_; \
    do{ o[0]=__builtin_amdgcn_mfma_f32_32x32x16_bf16(PAF(0),VFR(0),o[0],0,0,0); VRD2(0,8); mxa_=MX3(C0[0],C0[1],C1[0]); mxb_=MX3(C0[2],C0[3],C1[1]); mxa_=MX3(mxa_,C1[2],C1[3]); mxa_=MX3(mxa_,C0[4],C0[5]); mxb_=MX3(mxb_,C0[6],C0[7]); PIN(mxa_); PIN(mxb_); SBAR(); }while(0); \
    do{ o[1]=__builtin_amdgcn_mfma_f32_32x32x16_bf16(PAF(0),VFR(4),o[1],0,0,0); VRD2(4,12); mxa_=MX3(mxa_,C1[4],C1[5]); mxb_=MX3(mxb_,C1[6],C1[7]); mxa_=MX3(mxa_,C0[8],C0[9]); mxb_=MX3(mxb_,C0[10],C0[11]); PIN(mxa_); PIN(mxb_); SBAR(); }while(0); \
    do{ o[0]=__builtin_amdgcn_mfma_f32_32x32x16_bf16(PAF(1),VFR(1),o[0],0,0,0); VRD2(1,9); mxa_=MX3(mxa_,C1[8],C1[9]); mxb_=MX3(mxb_,C1[10],C1[11]); mxa_=MX3(mxa_,C0[12],C0[13]); mxb_=MX3(mxb_,C0[14],C0[15]); PIN(mxa_); PIN(mxb_); SBAR(); }while(0); \
    do{ o[1]=__builtin_amdgcn_mfma_f32_32x32x16_bf16(PAF(1),VFR(5),o[1],0,0,0); VRD2(5,13); mxa_=MX3(mxa_,C1[12],C1[13]); mxb_=MX3(mxb_,C1[14],C1[15]); rm_=__builtin_fmaxf(mxa_,mxb_); { auto rr=__builtin_amdgcn_permlane32_swap(__float_as_uint(rm_),__float_as_uint(rm_),false,false); rm_=__builtin_fmaxf(__uint_as_float(rr[0]),__uint_as_float(rr[1])); } PIN(mxa_); PIN(mxb_); SBAR(); }while(0); \
    resc=false; \
    if(__builtin_expect(__any(rm_>(float)THRL),0)){ const float dl=__builtin_fmaxf(rm_,0.f); mhat+=dl; \
      _Pragma("unroll") for(int r=0;r<16;++r){C0[r]-=dl;C1[r]-=dl;} \
      _Pragma("unroll") for(int r=0;r<16;++r)negm[r]=-mhat; asm volatile("":"+v"(negm)); \
      const float f=__builtin_amdgcn_exp2f(-dl); l_reg*=f; if(hi==0)wsf[r32]=f; resc=true; } \
    SBAR(); \
    do{ o[0]=__builtin_amdgcn_mfma_f32_32x32x16_bf16(PAF(2),VFR(2),o[0],0,0,0); VRD2(2,10); C0[0]=EX(C0[0]); C0[1]=EX(C0[1]); PIN(C0); SBAR(); }while(0); \
    do{ o[1]=__builtin_amdgcn_mfma_f32_32x32x16_bf16(PAF(2),VFR(6),o[1],0,0,0); VRD2(6,14); C0[2]=EX(C0[2]); C0[3]=EX(C0[3]); PIN(C0); SBAR(); }while(0); \
    do{ o[0]=__builtin_amdgcn_mfma_f32_32x32x16_bf16(PAF(3),VFR(3),o[0],0,0,0); VRD2(3,11); C0[4]=EX(C0[4]); C0[5]=EX(C0[5]); PIN(C0); SBAR(); }while(0); \
    do{ o[1]=__builtin_amdgcn_mfma_f32_32x32x16_bf16(PAF(3),VFR(7),o[1],0,0,0); VRD2(7,15); C0[6]=EX(C0[6]); C0[7]=EX(C0[7]); PIN(C0); SBAR(); }while(0); \
    do{ o[2]=__builtin_amdgcn_mfma_f32_32x32x16_bf16(PAF(0),VFR(0),o[2],0,0,0); (void)0; C0[8]=EX(C0[8]); C0[9]=EX(C0[9]); C0[10]=EX(C0[10]); C0[11]=EX(C0[11]); PIN(C0); SBAR(); }while(0); \
    KRD(GL,0); do{ o[3]=__builtin_amdgcn_mfma_f32_32x32x16_bf16(PAF(0),VFR(4),o[3],0,0,0); (void)0; C0[12]=EX(C0[12]); C0[13]=EX(C0[13]); PIN(C0); SBAR(); }while(0); \
    KRD(GL,1); do{ o[2]=__builtin_amdgcn_mfma_f32_32x32x16_bf16(PAF(1),VFR(1),o[2],0,0,0); (void)0; C0[14]=EX(C0[14]); C0[15]=EX(C0[15]); PIN(C0); SBAR(); }while(0); \
    KRD(GL,2); do{ o[3]=__builtin_amdgcn_mfma_f32_32x32x16_bf16(PAF(1),VFR(5),o[3],0,0,0); (void)0; C1[0]=EX(C1[0]); C1[1]=EX(C1[1]); PIN(C1); SBAR(); }while(0); \
    KRD(GL,3); do{ o[2]=__builtin_amdgcn_mfma_f32_32x32x16_bf16(PAF(2),VFR(2),o[2],0,0,0); (void)0; C1[2]=EX(C1[2]); C1[3]=EX(C1[3]); PIN(C1); SBAR(); }while(0); \
    do{ o[3]=__builtin_amdgcn_mfma_f32_32x32x16_bf16(PAF(2),VFR(6),o[3],0,0,0); (void)0; C1[4]=EX(C1[4]); C1[5]=EX(C1[5]); C1[6]=EX(C1[6]); C1[7]=EX(C1[7]); PIN(C1); SBAR(); }while(0); \
    do{ o[2]=__builtin_amdgcn_mfma_f32_32x32x16_bf16(PAF(3),VFR(3),o[2],0,0,0); (void)0; C1[8]=EX(C1[8]); C1[9]=EX(C1[9]); C1[10]=EX(C1[10]); C1[11]=EX(C1[11]); PIN(C1); SBAR(); }while(0); \
    do{ o[3]=__builtin_amdgcn_mfma_f32_32x32x16_bf16(PAF(3),VFR(7),o[3],0,0,0); qa=QLD(0); C1[12]=EX(C1[12]); C1[13]=EX(C1[13]); C1[14]=EX(C1[14]); C1[15]=EX(C1[15]); PIN(C1); SBAR(); }while(0); \
    }while(0)
  int t=1;
  #undef CMASK
  #define CMASK(P0,P1,t) do{}while(0)
  for(;t+5<NT;t+=2){
    STEP(pB0,pB1,pA0,pA1,t,true,true,true);     WAIT_BAR(3); RESC(); ROT();
    STEP(pA0,pA1,pB0,pB1,t+1,true,true,true);   WAIT_BAR(3); RESC(); ROT();
  }
  #undef CMASK
  #define CMASK(P0,P1,t) do{int jb_=(t)-(NT-4); if(jb_>=0)bmask(P0,P1,jb_,wid,mode);}while(0)
  #define ENDW(tt) do{ if((tt)+3<NT){WAIT_BAR(3);} else if((tt)+2<NT){WAIT_BAR(2);} else {WAIT_BAR(0);} }while(0)
  for(;t+1<NT;t+=2){
    STEP(pB0,pB1,pA0,pA1,t,(t+3<NT),(t+1<NT),(t+1<NT));       ENDW(t);   RESC(); ROT();
    STEP(pA0,pA1,pB0,pB1,t+1,(t+4<NT),(t+2<NT),(t+2<NT));     ENDW(t+1); RESC(); ROT();
  }
  STEP(pB0,pB1,pA0,pA1,NT-1,false,false,false); RESC();
  { float sacc=pB0[0]+pB0[1]; _Pragma("unroll") for(int r=2;r<16;++r)sacc+=pB0[r]; _Pragma("unroll") for(int r=0;r<16;++r)sacc+=pB1[r]; l_reg+=sacc;
    pw0=(u32x4){PKW(pB0,0),PKW(pB0,2),PKW(pB0,4),PKW(pB0,6)};pw1=(u32x4){PKW(pB0,8),PKW(pB0,10),PKW(pB0,12),PKW(pB0,14)};pw2=(u32x4){PKW(pB1,0),PKW(pB1,2),PKW(pB1,4),PKW(pB1,6)};pw3=(u32x4){PKW(pB1,8),PKW(pB1,10),PKW(pB1,12),PKW(pB1,14)};
    SBAR(); pv(o,vb0+2*sl_cur,PAF(0),PAF(1),PAF(2),PAF(3)); }
  asm volatile("s_waitcnt lgkmcnt(0)\n\ts_barrier":::"memory");
  if(pfN){ const bf16*kn=KhN+wid*512+lane*8; const bf16*vn=VhN+(wid>>2)*2048+(wid&3)*512+lane*8;
    glds16(kn,(unsigned)__builtin_amdgcn_readfirstlane(kdst)); glds16(vn,(unsigned)__builtin_amdgcn_readfirstlane(vdst)); glds16(vn+4096,(unsigned)__builtin_amdgcn_readfirstlane(vdst+8192)); glds16(kn+4096,(unsigned)__builtin_amdgcn_readfirstlane(kdst+SLOTB)); }
  #undef PKW
  #undef PAF
  #undef VFR
  #undef PIN
  #undef MX3
  #undef GAPA
  #undef GAPB
  #undef EX
  #undef VRD
  #undef VRD2
  #undef QLD
  #undef GAPB2
  #undef KRD
  #undef STEP
  #undef ENDW
  {auto rr=__builtin_amdgcn_permlane32_swap(__float_as_uint(l_reg),__float_as_uint(l_reg),false,false);l_reg=__uint_as_float(rr[0])+__uint_as_float(rr[1]);}
  if(hi==0)wsf[32+r32]=l_reg;asm volatile("s_waitcnt lgkmcnt(0)":::"memory");
  float rli[16];
  #pragma unroll
  for(int r=0;r<16;++r)rli[r]=__builtin_amdgcn_rcpf(wsf[32+crow(r,hi)]);
  bf16*Ow=Ow0+(long)wid*QBLK*OPITCH;
  { bf16*stg=(bf16*)(shm+LDS_OST)+wid*2048;
    #pragma unroll
    for(int hp=0;hp<2;++hp){
      #pragma unroll
      for(int r=0;r<16;++r){const int orow=crow(r,hi);
        #pragma unroll
        for(int d0=0;d0<2;++d0)stg[orow*64+d0*32+r32]=__float2bfloat16(o[2*hp+d0][r]*rli[r]);}
      asm volatile("s_waitcnt lgkmcnt(0)":::"memory");
      #pragma unroll
      for(int i=0;i<4;++i){const int row=i*8+(lane>>3),ch=lane&7; const u32x4 v=*(const u32x4*)(stg+row*64+ch*8); if(qvalid)ATTN_STORE16(Ow+(long)row*OPITCH+hp*64+ch*8,v);}
      asm volatile("s_waitcnt lgkmcnt(0)":::"memory"); } }
  asm volatile("s_waitcnt lgkmcnt(0)":::"memory");
  #undef DMA_K
  #undef DMA_V
  #undef CMASK
  #undef START
  #undef RESC
  #undef ROT
}
constexpr int ATTN_LDS_BYTES=LDS_BYTES;
#undef SBAR
#undef WAIT_BAR
}

constexpr int NWAVES = 8;
constexpr int PH_PER_LAYER = 11, NPH = 1 + DEPTH * PH_PER_LAYER;
enum { P_WIN = 0, P_MIXA, P_ATTN, P_MIXC, P_PG, P_MERGE, P_OUT, P_LN1, P_UP, P_DOWN, P_LN2 };

constexpr int CW_TMO = 0, CW_CODE = 1, CW_BAR = 4096;

constexpr int RING_OFF = 0, RING_BYTES = 131072;
constexpr int LDSCTL_OFF = RING_BYTES, MISC_OFF = LDSCTL_OFF + 320;
constexpr int LDS_BYTES = 147456;
static_assert(MISC_OFF + 128 <= LDS_BYTES, "LDS map");

#define GAS __attribute__((address_space(1)))
#define LAS __attribute__((address_space(3)))
typedef unsigned short bf16;
typedef unsigned v4u __attribute__((ext_vector_type(4)));
typedef float f32x4 __attribute__((ext_vector_type(4)));
typedef float f32x16 __attribute__((ext_vector_type(16)));
typedef short bf16x8 __attribute__((ext_vector_type(8)));
typedef GAS unsigned gu32;
#define RLX_AGENT __ATOMIC_RELAXED, __HIP_MEMORY_SCOPE_AGENT
#define LDS_WAIT() asm volatile("s_waitcnt lgkmcnt(0)" ::: "memory")
#define VM_WAIT() asm volatile("s_waitcnt vmcnt(0)" ::: "memory")
__device__ __forceinline__ unsigned f2bf(float f) { unsigned u = __builtin_bit_cast(unsigned, f); return (u + 0x7fffu + ((u >> 16) & 1u)) >> 16; }
__device__ __forceinline__ unsigned pk2(float lo, float hi) { return f2bf(lo) | (f2bf(hi) << 16); }
typedef float pk_f2_t __attribute__((ext_vector_type(2))); typedef __bf16 pk_b2_t __attribute__((ext_vector_type(2)));
__device__ __forceinline__ unsigned pk2hw(float lo, float hi) { const pk_f2_t v = {lo, hi}; const pk_b2_t b = __builtin_convertvector(v, pk_b2_t); return __builtin_bit_cast(unsigned, b); }
__device__ __forceinline__ float bfl(unsigned w) { return __uint_as_float(w << 16); }
__device__ __forceinline__ float bfh(unsigned w) { return __uint_as_float(w & 0xffff0000u); }

#define XB_TMO      128
#define XB_XCNT(j)  (256  + 64 * (j))
#define XB_XSUB(j)  (1280 + 64 * (j))
#define XB_XGEN(j)  (2304 + 64 * (j))
#define XB_TOP      3328
#define XB_TOPGEN   3392
#define XCD_BAR_WORDS 3456
#define XB_SPIN_CAP (1u << 18)

__device__ __forceinline__ unsigned xb_ld(unsigned* p)              { return __hip_atomic_load(p, __ATOMIC_RELAXED, __HIP_MEMORY_SCOPE_AGENT); }
__device__ __forceinline__ unsigned xb_add(unsigned* p, unsigned v) { return __hip_atomic_fetch_add(p, v, __ATOMIC_RELAXED, __HIP_MEMORY_SCOPE_AGENT); }
__device__ __forceinline__ unsigned xb_xcc_id() { return (unsigned)__builtin_amdgcn_s_getreg((3 << 11) | 20) & 0xFu; }
#define XB_SPIN(cond, bar) do { unsigned _sp = 0; while (cond) { __builtin_amdgcn_s_sleep(1); \
    if ((++_sp & 255u) == 0u) { if (xb_ld(&(bar)[XB_TMO])) break; if (_sp > XB_SPIN_CAP) { atomicAdd(&(bar)[XB_TMO], 1u); break; } } } } while (0)

struct XcdBarrier {
    unsigned* bar; unsigned x; int tid;
    volatile LAS unsigned* st;
};

__device__ __forceinline__ XcdBarrier xcd_barrier_post(unsigned* bar, volatile LAS unsigned* st) {
    XcdBarrier b; b.bar = bar; b.x = xb_xcc_id(); b.st = st; b.tid = 0;
    if (threadIdx.x == 0) (void)xb_add(&bar[XB_XCNT(b.x)], 1u);
    return b;
}
__device__ __forceinline__ void xcd_barrier_complete(unsigned* bar, unsigned x, unsigned& nloc, unsigned& nx) {
    const unsigned G = gridDim.x * gridDim.y * gridDim.z;
    unsigned sum, cnt, mine, sp = 0u;
    for (;;) {
        sum = 0u; cnt = 0u; mine = 0u;
#pragma unroll
        for (unsigned j = 0; j < 16; ++j) { const unsigned c = xb_ld(&bar[XB_XCNT(j)]); sum += c; cnt += (c > 0u) ? 1u : 0u; mine = (j == x) ? c : mine; }
        if (sum == G) break;
        __builtin_amdgcn_s_sleep(1);
        if ((++sp & 255u) == 0u) { if (xb_ld(&bar[XB_TMO])) break; if (sp > XB_SPIN_CAP) { atomicAdd(&bar[XB_TMO], 1u); break; } }
    }
    nloc = mine > 0u ? mine : 1u; nx = cnt > 0u ? cnt : 1u;
}

__device__ __forceinline__ void xcd_barrier(const XcdBarrier& b) {
    asm volatile("s_waitcnt vmcnt(0)" ::: "memory");
    __syncthreads();
    if (b.tid == 0) {
        unsigned* bar = b.bar;
        __builtin_amdgcn_s_waitcnt(0);
        unsigned nloc = b.st[0], nx = b.st[1];
        if (nloc == 0u) { xcd_barrier_complete(bar, b.x, nloc, nx); b.st[0] = nloc; b.st[1] = nx; }
        const unsigned old = xb_add(&bar[XB_XSUB(b.x)], 1u);
        const unsigned gen = old / nloc;
        if (old + 1u == (gen + 1u) * nloc) {
            __builtin_amdgcn_fence(__ATOMIC_RELEASE, "agent");
            asm volatile("s_waitcnt vmcnt(0)" ::: "memory");
            const unsigned og = xb_add(&bar[XB_TOP], 1u);
            const unsigned tg = og / nx;
            if (og + 1u == (tg + 1u) * nx) xb_add(&bar[XB_TOPGEN], 1u);
            else XB_SPIN(xb_ld(&bar[XB_TOPGEN]) == tg, bar);
            __builtin_amdgcn_fence(__ATOMIC_ACQUIRE, "agent");
            xb_add(&bar[XB_XGEN(b.x)], 1u);
            asm volatile("s_waitcnt vmcnt(0)" ::: "memory");
        } else {
            XB_SPIN(xb_ld(&bar[XB_XGEN(b.x)]) == gen, bar);
            __builtin_amdgcn_fence(__ATOMIC_ACQUIRE, "agent");
            asm volatile("s_waitcnt vmcnt(0)" ::: "memory");
        }
    }
    __syncthreads();
}

struct Args { const float* in[35]; float* out; unsigned char* ws; int ph_lo, ph_hi, li, pad; };
struct Frame {
    LAS unsigned char* lds;
    volatile LAS unsigned* MISC;
    gu32* ctl;
    int tid, lane, wave;
    int vcu, G;
    float* out;
    unsigned char* ws;
};
__device__ __forceinline__ float wave_sum(float v) {
    v += swz_xor<1>(v); v += swz_xor<2>(v); v += swz_xor<4>(v); v += swz_xor<8>(v); v += swz_xor<16>(v);
    { auto rr = __builtin_amdgcn_permlane32_swap(__float_as_uint(v), __float_as_uint(v), false, false); v = __uint_as_float(rr[0]) + __uint_as_float(rr[1]); }
    return v;
}
__device__ __forceinline__ void p0_transpose_item(const float* W, int K, int N, bf16* WT, int row_off, LAS float* scr, int item, int lane) {
    const int nblk = N / 32, kb = item / nblk, nb = item % nblk, k0 = 64 * kb, n0 = 32 * nb;
#pragma unroll 8
    for (int i = 0; i < 32; ++i) { const int kk = 2 * i + (lane >> 5); scr[kk * 33 + (lane & 31)] = W[(size_t)(k0 + kk) * N + n0 + (lane & 31)]; }
    LDS_WAIT(); asm volatile("" ::: "memory");
    const int c = lane & 7;
#pragma unroll
    for (int j = 0; j < 4; ++j) { const int n = (lane >> 3) + 8 * j; const LAS float* s = scr + (8 * c) * 33 + n;
        v4u o; o.x = pk2(s[0 * 33], s[1 * 33]); o.y = pk2(s[2 * 33], s[3 * 33]); o.z = pk2(s[4 * 33], s[5 * 33]); o.w = pk2(s[6 * 33], s[7 * 33]);
        *(GAS v4u*)(WT + (size_t)(row_off + n0 + n) * K + k0 + 8 * c) = o; }
    LDS_WAIT(); asm volatile("" ::: "memory");
}

__device__ __forceinline__ void p0_transpose64(const float* W, int N, int nblk, bf16* WT, int ldo, int item, int lane) {
    const int kb = item / nblk, nb = item % nblk, k0 = 64 * kb, n0 = 64 * nb, n4 = lane & 15, kq = lane >> 4;
    f32x4 v[16];
#pragma unroll
    for (int j = 0; j < 16; ++j) v[j] = *(const GAS f32x4*)(W + (size_t)(k0 + kq * 16 + j) * N + n0 + 4 * n4);
#pragma unroll
    for (int e = 0; e < 4; ++e) { v4u c0, c1;
        c0.x = pk2hw(v[0][e], v[1][e]); c0.y = pk2hw(v[2][e], v[3][e]); c0.z = pk2hw(v[4][e], v[5][e]); c0.w = pk2hw(v[6][e], v[7][e]);
        c1.x = pk2hw(v[8][e], v[9][e]); c1.y = pk2hw(v[10][e], v[11][e]); c1.z = pk2hw(v[12][e], v[13][e]); c1.w = pk2hw(v[14][e], v[15][e]);
        bf16* o = WT + (size_t)(n0 + 4 * n4 + e) * ldo + k0 + kq * 16; *(GAS v4u*)o = c0; *(GAS v4u*)(o + 8) = c1; }
}

__device__ __forceinline__ void dsincos(double x, double& s, double& c) {
    const double TWO_PI = 6.283185307179586476925287, HALF_PI = 1.570796326794896619231322;
    x -= TWO_PI * __builtin_rint(x * (1.0 / TWO_PI));
    const double kq = __builtin_rint(x * (1.0 / HALF_PI)); const double r = x - kq * HALF_PI; const int k = ((int)kq) & 3; const double r2 = r * r;
    double sp = -1.0 / 1307674368000.0; sp = sp * r2 + 1.0 / 6227020800.0; sp = sp * r2 - 1.0 / 39916800.0; sp = sp * r2 + 1.0 / 362880.0; sp = sp * r2 - 1.0 / 5040.0; sp = sp * r2 + 1.0 / 120.0; sp = sp * r2 - 1.0 / 6.0; sp = sp * r2 * r + r;
    double cp = 1.0 / 20922789888000.0; cp = cp * r2 - 1.0 / 87178291200.0; cp = cp * r2 + 1.0 / 479001600.0; cp = cp * r2 - 1.0 / 3628800.0; cp = cp * r2 + 1.0 / 40320.0; cp = cp * r2 - 1.0 / 720.0; cp = cp * r2 + 1.0 / 24.0; cp = cp * r2 - 0.5; cp = cp * r2 + 1.0;
    s = (k == 0) ? sp : (k == 1) ? cp : (k == 2) ? -sp : -cp;
    c = (k == 0) ? cp : (k == 1) ? -sp : (k == 2) ? -cp : sp;
}
__device__ __forceinline__ double dexp(double x) {
    const double LN2 = 0.693147180559945309417232; const double n = __builtin_rint(x * (1.0 / LN2)); const double r = x - n * LN2;
    double p = 1.0 / 6227020800.0; p = p * r + 1.0 / 479001600.0; p = p * r + 1.0 / 39916800.0; p = p * r + 1.0 / 3628800.0; p = p * r + 1.0 / 362880.0; p = p * r + 1.0 / 40320.0; p = p * r + 1.0 / 5040.0;
    p = p * r + 1.0 / 720.0; p = p * r + 1.0 / 120.0; p = p * r + 1.0 / 24.0; p = p * r + 1.0 / 6.0; p = p * r + 0.5; p = p * r + 1.0; p = p * r + 1.0;
    return __builtin_ldexp(p, (int)n);
}

enum { I_XP = 0, I_XS, I_CK, I_CV, I_SRE, I_SIM, I_SCONV, I_SPOOL, I_WIN, I_POOLW, I_PSCALE, I_ARE, I_AIM, I_LOGDT, I_BRE, I_BIM, I_CRE, I_CIM, I_SD, I_WGLU, I_CONVW, I_CONVB,
       I_LQ1, I_LK1, I_LQ2, I_LK2, I_SUBLN, I_WBR, I_WOUT, I_LN1G, I_LN1B, I_WUP, I_WDN, I_LN2G, I_LN2B };

constexpr int I_IN0 = (DM / 64) * (N_IN / 64);
__device__ __forceinline__ void p0_weights(Frame& F, const Args& A, int first, int last, int wv, int nw) {
    unsigned char* ws = F.ws;
    constexpr int I_IN = (DM / 64) * (N_IN / 64), I_BR = (BR_W / 64) * (DM / 64), I_OUT = (DM / 64) * (DM / 64), I_UP = (DM / 64) * (D_FF / 64), I_DN = (D_FF / 64) * (DM / 64), I_GLU = (512 / 64) * (512 / 64), I_PF = (512 / 8) * (DM / 64);
    constexpr int PER_L = I_IN + I_BR + I_OUT + I_UP + I_DN + I_GLU + I_PF;
    if (last > DEPTH * PER_L) last = DEPTH * PER_L;
    for (int it = first + wv; it < last; it += nw) {
        const int l = it / PER_L; int r = it % PER_L; unsigned char* wl = ws + WS_W + (size_t)l * W_LSTRIDE;
        if (r < I_IN) { p0_transpose64(A.in[I_WIN] + (size_t)l * DM * N_IN, N_IN, N_IN / 64, (bf16*)(wl + W_IN), DM, r, F.lane); continue; } r -= I_IN;
        if (r < I_BR) { if (r >= 8 * (DM / 64)) p0_transpose64(A.in[I_WBR] + (size_t)l * BR_W * DM, DM, DM / 64, (bf16*)(wl + W_BR), BR_W, r, F.lane); continue; } r -= I_BR;
        if (r < I_OUT) { p0_transpose64(A.in[I_WOUT] + (size_t)l * DM * DM, DM, DM / 64, (bf16*)(wl + W_OUT), DM, r, F.lane); continue; } r -= I_OUT;
        if (r < I_UP) { p0_transpose64(A.in[I_WUP] + (size_t)l * DM * D_FF, D_FF, D_FF / 64, (bf16*)(wl + W_UP), DM, r, F.lane); continue; } r -= I_UP;
        if (r < I_DN) { p0_transpose64(A.in[I_WDN] + (size_t)l * D_FF * DM, DM, DM / 64, (bf16*)(wl + W_DN), D_FF, r, F.lane); continue; } r -= I_DN;
        if (r < I_GLU) { p0_transpose64(A.in[I_WGLU] + (size_t)l * 512 * 512, 512, 512 / 64, (bf16*)(wl + W_GLU), 512, r, F.lane); continue; } r -= I_GLU;
        {
            const int k0 = (r >> 4) * 8, d = (r & 15) * 64 + F.lane, g = k0 >> 7;
            const float* pw = A.in[I_POOLW] + (((size_t)l * 4 + g) * 128 + (k0 & 127)) * 128; const float* sc = A.in[I_PSCALE] + (size_t)l * 512 + g * 128; const float* wb = A.in[I_WBR] + ((size_t)l * BR_W + g * 128) * DM + d;
            float acc8[8];
#pragma unroll
            for (int e = 0; e < 8; ++e) acc8[e] = 0.f;
#pragma unroll 1
            for (int jb = 0; jb < 128; jb += 8) {
                float w8[8]; f32x4 s4[2], p4[8][2];
#pragma unroll
                for (int jj = 0; jj < 8; ++jj) w8[jj] = *(const GAS float*)(wb + (size_t)(jb + jj) * DM);
                s4[0] = *(const GAS f32x4*)(sc + jb); s4[1] = *(const GAS f32x4*)(sc + jb + 4);
#pragma unroll
                for (int e = 0; e < 8; ++e) { p4[e][0] = *(const GAS f32x4*)(pw + e * 128 + jb); p4[e][1] = *(const GAS f32x4*)(pw + e * 128 + jb + 4); }
                __builtin_amdgcn_sched_barrier(0);
#pragma unroll
                for (int jj = 0; jj < 8; ++jj) { const float wv = s4[jj >> 2][jj & 3] * w8[jj];
#pragma unroll
                    for (int e = 0; e < 8; ++e) acc8[e] += p4[e][jj >> 2][jj & 3] * wv; }
                __builtin_amdgcn_sched_barrier(0);
            }
            v4u o; o.x = pk2(acc8[0], acc8[1]); o.y = pk2(acc8[2], acc8[3]); o.z = pk2(acc8[4], acc8[5]); o.w = pk2(acc8[6], acc8[7]);
            *(GAS v4u*)((bf16*)(wl + W_BR) + (size_t)d * BR_W + k0) = o; }
    }
}
__device__ __forceinline__ void p0_prologue(Frame& F, const Args& A) {
    LAS float* scr = (LAS float*)(F.lds + RING_OFF + F.wave * 16384);
    const int gw = F.vcu * NWAVES + F.wave, NGW = F.G * NWAVES;
    const int gt = gw * 64 + F.lane, NGT = NGW * 64;
    unsigned char* ws = F.ws;
    p0_weights(F, A, 0, I_IN0, gw, NGW);
    for (int m = gw; m < M_T; m += NGW) {
        const float* xr = m < M_P ? A.in[I_XP] + (size_t)m * DM : A.in[I_XS] + (size_t)(m - M_P) * DM;
        const GAS f32x4* x4 = (const GAS f32x4*)xr + F.lane; GAS unsigned long long* o8 = (GAS unsigned long long*)((bf16*)(ws + WS_XB) + (size_t)m * DM) + F.lane;
        f32x4 v[4];
#pragma unroll
        for (int j = 0; j < 4; ++j) v[j] = x4[64 * j];
#pragma unroll
        for (int j = 0; j < 4; ++j) o8[64 * j] = (unsigned long long)pk2(v[j].x, v[j].y) | ((unsigned long long)pk2(v[j].z, v[j].w) << 32);
    }
    for (int i = gt; i < SEQ * 8; i += NGT) { const int pos = i >> 3, k = i & 7;
        const double inv = dexp(-(double)k * (13.122363377404328 / 8.0)); double s, c; dsincos((double)pos * inv, s, c);
        float* rp = (float*)(ws + WS_ROPE) + (size_t)pos * 16; rp[k] = (float)c; rp[8 + k] = (float)s; }
    for (int i = gt; i < DEPTH * 2048; i += NGT) { const int l = i >> 11, gp = i & 2047, g = gp >> 6, p = gp & 63;
        unsigned char* sc = ws + WS_SSMC + (size_t)l * SSMC_LSTRIDE;
        const double dt = dexp((double)A.in[I_LOGDT][l * 32 + g]), are = (double)A.in[I_ARE][i], aim = (double)A.in[I_AIM][i];
        const double mag = dexp(are * dt); double sn, cs; dsincos(aim * dt, sn, cs);
        const double abr = mag * cs, abi = mag * sn, den = are * are + aim * aim;
        const double cr = ((abr - 1.0) * are + abi * aim) / den, ci = (abi * are - (abr - 1.0) * aim) / den;
        ((float2*)(sc + SC_AB))[gp] = make_float2((float)abr, (float)abi);
        const double m64 = dexp(are * dt * 64.0); double s64, c64; dsincos(aim * dt * 64.0, s64, c64);
        ((float2*)(sc + SC_A64))[gp] = make_float2((float)(m64 * c64), (float)(m64 * s64));
        bf16* BB = (bf16*)(sc + SC_BB) + (size_t)g * 128 * 16;
#pragma unroll 4
        for (int n = 0; n < 16; ++n) { const double bre = (double)A.in[I_BRE][(size_t)i * 16 + n], bim = (double)A.in[I_BIM][(size_t)i * 16 + n];
            BB[p * 16 + n] = (bf16)f2bf((float)(cr * bre - ci * bim)); BB[(64 + p) * 16 + n] = (bf16)f2bf((float)(cr * bim + ci * bre)); }
    }
    for (int i = gt; i < DEPTH * 32 * 16 * 64; i += NGT) { const int l = i >> 15, r = i & 32767, gn = r >> 6, p = r & 63;
        bf16* CM = (bf16*)(ws + WS_SSMC + (size_t)l * SSMC_LSTRIDE + SC_CM) + (size_t)gn * 128;
        CM[2 * p] = (bf16)f2bf(A.in[I_CRE][i]); CM[2 * p + 1] = (bf16)f2bf(-A.in[I_CIM][i]); }
}

__device__ __forceinline__ float gelu_tanh(float y) {
    const float z = 0.7978845608028654f * (y + 0.044715f * y * y * y);
    const float e = __builtin_amdgcn_exp2f(2.885390081777927f * z);
    const float th = 1.0f - 2.0f * __builtin_amdgcn_rcpf(1.0f + e);
    return 0.5f * y * (1.0f + th);
}
struct SsmGrp { float2 ab; bf16x8 bfr[4]; bf16x8 afr0, afr1; float sre, sim; bf16x8 cfr[4]; float dsk; };
template <bool PASSB> __device__ __forceinline__ SsmGrp ssm_load_group(Frame& F, const Args& A, int l, int ch, int g, bool smp, int row0) {
    const int lane = F.lane, r32 = lane & 31, hi = lane >> 5, fr = lane & 15, fq = lane >> 4;
    const unsigned char* sc = F.ws + WS_SSMC + (size_t)l * SSMC_LSTRIDE;
    const bf16* BB = (const bf16*)(sc + SC_BB); const bf16* CM = (const bf16*)(sc + SC_CM); const bf16* US = (const bf16*)(F.ws + WS_US);
    SsmGrp d;
    d.ab = ((const float2*)(sc + SC_AB))[g * 64 + lane];
#pragma unroll
    for (int cb = 0; cb < 4; ++cb) d.bfr[cb] = *(const bf16x8*)(BB + ((size_t)g * 128 + cb * 32 + r32) * 16 + 8 * hi);
    d.afr0 = *(const bf16x8*)(US + (size_t)(row0 + r32) * 512 + g * 16 + 8 * hi);
    d.afr1 = smp ? d.afr0 : *(const bf16x8*)(US + (size_t)(row0 + 32 + r32) * 512 + g * 16 + 8 * hi);
    d.sre = 0.f; d.sim = 0.f; d.dsk = 0.f;
#pragma unroll
    for (int kb = 0; kb < 4; ++kb) d.cfr[kb] = bf16x8{};
    if (PASSB) {
        if (smp) { const size_t si = ((size_t)(l * NB_S + (ch - NCH_P)) * 32 + g) * 64 + lane; d.sre = A.in[I_SRE][si]; d.sim = A.in[I_SIM][si]; }
        else { const float2 h = ((const float2*)(F.ws + WS_H))[((size_t)ch * 32 + g) * 64 + lane]; d.sre = h.x; d.sim = h.y; }
#pragma unroll
        for (int kb = 0; kb < 4; ++kb) d.cfr[kb] = *(const bf16x8*)(CM + ((size_t)g * 16 + fr) * 128 + kb * 32 + 8 * fq);
        d.dsk = A.in[I_SD][l * 512 + g * 16 + fr];
    }
    return d;
}
template <bool PASSB> __device__ __forceinline__ void ssm_pass(Frame& F, const Args& A, int l) {
    LAS unsigned char* wl = F.lds + RING_OFF + F.wave * 9728;
    LAS unsigned* ST32 = (LAS unsigned*)wl; LAS unsigned short* ST = (LAS unsigned short*)wl; LAS unsigned short* UT = (LAS unsigned short*)(wl + 8704);
    const int lane = F.lane, r32 = lane & 31, hi = lane >> 5, fr = lane & 15, fq = lane >> 4;
    unsigned char* ws = F.ws;
    bf16* VS_ = (bf16*)(ws + WS_VSSM); float2* Eb = (float2*)(ws + WS_E);
    const int nprompt = (NCH_P - F.vcu + F.G - 1) / F.G; const int nsmp = PASSB ? (NB_S * 32 - (F.vcu * NWAVES + F.wave) + F.G * NWAVES - 1) / (F.G * NWAVES) : 0;
#pragma unroll 1
    for (int it = 0; it < nprompt + nsmp; ++it) {
        const bool smp = it >= nprompt; const int sidx = F.vcu * NWAVES + F.wave + (it - nprompt) * F.G * NWAVES;
        const int ch = smp ? NCH_P + (sidx >> 5) : F.vcu + it * F.G; const int row0 = smp ? M_P + (ch - NCH_P) * 32 : ch * 64; const int nhalf = smp ? 1 : 2;
        const int g0 = smp ? (sidx & 31) : F.wave * 4, ng = smp ? 1 : 4;
        SsmGrp cur = ssm_load_group<PASSB>(F, A, l, ch, g0, smp, row0);
#pragma unroll 1
        for (int gi = 0; gi < ng; ++gi) {
            const int g = g0 + gi;
            const SsmGrp nxt = ssm_load_group<PASSB>(F, A, l, ch, g0 + (gi < ng - 1 ? gi + 1 : ng - 1), smp, row0);
            const float2 ab = cur.ab; float sre = cur.sre, sim = cur.sim;
#pragma unroll 1
            for (int hf = 0; hf < nhalf; ++hf) {
                const int rbase = row0 + hf * 32;
                const bf16x8 afr = hf ? cur.afr1 : cur.afr0;
                if (PASSB) *(LAS bf16x8*)(UT + r32 * 16 + 8 * hi) = afr;
                f32x16 c[4];
#pragma unroll
                for (int cb = 0; cb < 4; ++cb) c[cb] = __builtin_amdgcn_mfma_f32_32x32x16_bf16(afr, cur.bfr[cb], (f32x16){}, 0, 0, 0);
#pragma unroll
                for (int i = 0; i < 16; ++i) {
                    { auto rr = __builtin_amdgcn_permlane32_swap(__float_as_uint(c[0][i]), __float_as_uint(c[1][i]), false, false); c[0][i] = __uint_as_float(rr[0]); c[1][i] = __uint_as_float(rr[1]); }
                    { auto rr = __builtin_amdgcn_permlane32_swap(__float_as_uint(c[2][i]), __float_as_uint(c[3][i]), false, false); c[2][i] = __uint_as_float(rr[0]); c[3][i] = __uint_as_float(rr[1]); } }
#pragma unroll
                for (int t = 0; t < 32; ++t) {
                    const int i = (t & 3) + 4 * (t >> 3), h = (t >> 2) & 1;
                    const float bre = c[h][i], bim = c[2 + h][i];
                    float nre = __builtin_fmaf(ab.x, sre, __builtin_fmaf(-ab.y, sim, bre)); asm volatile("" : "+v"(nre));
                    const float nim = __builtin_fmaf(ab.x, sim, __builtin_fmaf(ab.y, sre, bim)); sre = nre; sim = nim;
                    if (PASSB) ST32[t * 68 + lane] = pk2hw(sre, sim);
                }
                if (PASSB) {
#pragma unroll
                    for (int q = 0; q < 2; ++q) {
                        pg8::f32x4 y = {0.f, 0.f, 0.f, 0.f};
#pragma unroll
                        for (int kb = 0; kb < 4; ++kb) { const bf16x8 a = *(const LAS bf16x8*)(ST + (16 * q + fr) * 136 + kb * 32 + 8 * fq); y = __builtin_amdgcn_mfma_f32_16x16x32_bf16(a, cur.cfr[kb], y, 0, 0, 0); }
#pragma unroll
                        for (int j = 0; j < 4; ++j) { const int tok = 16 * q + fq * 4 + j;
                            const float u = __uint_as_float((unsigned)UT[tok * 16 + fr] << 16); UT[tok * 16 + fr] = (unsigned short)f2bf(gelu_tanh(y[j] + cur.dsk * u)); }
                    }
                    { const v4u w = *(const LAS v4u*)(UT + (lane >> 1) * 16 + (lane & 1) * 8); *(GAS v4u*)(VS_ + (size_t)(rbase + (lane >> 1)) * 512 + g * 16 + (lane & 1) * 8) = w; }
                }
            }
            if (!PASSB) Eb[((size_t)ch * 32 + g) * 64 + lane] = make_float2(sre, sim);
            else if (smp) { const size_t oi = ((size_t)(l * NB_S + (ch - NCH_P)) * 32 + g) * 64 + lane; F.out[O_SRS + oi] = sre; F.out[O_SIS + oi] = sim; }
            else if ((ch & 255) == 255) { const size_t oi = ((size_t)(l * NB_P + (ch >> 8)) * 32 + g) * 64 + lane; F.out[O_SRP + oi] = sre; F.out[O_SIP + oi] = sim; }
            cur = nxt;
        }
    }
}
__device__ __forceinline__ void ssm_carry(Frame& F, int l) {
    const int gw = F.vcu * NWAVES + F.wave; if (gw >= NB_P * 32) return;
    const int b = gw >> 5, g = gw & 31;
    const float2 a = ((const float2*)(F.ws + WS_SSMC + (size_t)l * SSMC_LSTRIDE + SC_A64))[g * 64 + F.lane];
    const float2* Eb = (const float2*)(F.ws + WS_E) + ((size_t)b * 256 * 32 + g) * 64 + F.lane; float2* Hb = (float2*)(F.ws + WS_H) + ((size_t)b * 256 * 32 + g) * 64 + F.lane;
    float hr = 0.f, hi_ = 0.f;
    float2 cur[32], nxt[32];
#pragma unroll
    for (int j = 0; j < 32; ++j) cur[j] = Eb[(size_t)j * 2048];
#pragma unroll 1
    for (int c0 = 0; c0 < 256; c0 += 32) {
        if (c0 + 32 < 256) {
#pragma unroll
            for (int j = 0; j < 32; ++j) nxt[j] = Eb[(size_t)(c0 + 32 + j) * 2048]; }
#pragma unroll
        for (int j = 0; j < 32; ++j) { Hb[(size_t)(c0 + j) * 2048] = make_float2(hr, hi_);
            const float nr = a.x * hr - a.y * hi_ + cur[j].x, ni = a.x * hi_ + a.y * hr + cur[j].y; hr = nr; hi_ = ni; }
#pragma unroll
        for (int j = 0; j < 32; ++j) cur[j] = nxt[j];
    }
}

__device__ __forceinline__ void ld8b(const bf16* p, float (&v)[8]) { const v4u w = *(const GAS v4u*)p; v[0] = bfl(w.x); v[1] = bfh(w.x); v[2] = bfl(w.y); v[3] = bfh(w.y); v[4] = bfl(w.z); v[5] = bfh(w.z); v[6] = bfl(w.w); v[7] = bfh(w.w); }
__device__ __forceinline__ void ld8f(const float* p, float (&v)[8]) { const f32x4 a = *(const GAS f32x4*)p, b = *(const GAS f32x4*)(p + 4); v[0] = a.x; v[1] = a.y; v[2] = a.z; v[3] = a.w; v[4] = b.x; v[5] = b.y; v[6] = b.z; v[7] = b.w; }
__device__ __forceinline__ void st8b(bf16* p, const float (&v)[8]) { v4u w; w.x = pk2(v[0], v[1]); w.y = pk2(v[2], v[3]); w.z = pk2(v[4], v[5]); w.w = pk2(v[6], v[7]); *(GAS v4u*)p = w; }
__device__ __forceinline__ void st8f(float* p, const float (&v)[8]) { *(GAS f32x4*)p = (f32x4){v[0], v[1], v[2], v[3]}; *(GAS f32x4*)(p + 4) = (f32x4){v[4], v[5], v[6], v[7]}; }
__device__ __forceinline__ void up8(const v4u w, float (&v)[8]) { v[0] = bfl(w.x); v[1] = bfh(w.x); v[2] = bfl(w.y); v[3] = bfh(w.y); v[4] = bfl(w.z); v[5] = bfh(w.z); v[6] = bfl(w.w); v[7] = bfh(w.w); }
__device__ __forceinline__ v4u ldrow_or_hist(const bf16* cur, const float* hist, bool use_cur, bool use_hist) {
    if (use_cur) return *(const GAS v4u*)cur;
    if (use_hist) { float h[8]; ld8f(hist, h); v4u w; w.x = pk2(h[0], h[1]); w.y = pk2(h[2], h[3]); w.z = pk2(h[4], h[5]); w.w = pk2(h[6], h[7]); return w; }
    return (v4u){0u, 0u, 0u, 0u};
}
template <int W> __device__ __forceinline__ void pool8(const bf16* ZP, const float* hist  , bf16* UP, float* st_out  , int st_t0  ,
                                                       int row0, int t0, bool smp, int c0) {
    v4u zr[W + 7];
#pragma unroll
    for (int k = 0; k < W + 7; ++k) { const int tk = t0 - (W - 1) + k;
        zr[k] = ldrow_or_hist(ZP + (size_t)(row0 - (W - 1) + k) * 512 + c0, hist + (size_t)(15 + tk) * 512 + c0, tk >= 0, smp && tk < 0); }
    float S[8];
#pragma unroll
    for (int e = 0; e < 8; ++e) S[e] = 0.f;
#pragma unroll
    for (int k = 0; k < W - 1; ++k) { float z[8]; up8(zr[k], z);
#pragma unroll
        for (int e = 0; e < 8; ++e) S[e] += z[e]; }
#pragma unroll
    for (int i = 0; i < 8; ++i) { float z[8]; up8(zr[i + W - 1], z);
#pragma unroll
        for (int e = 0; e < 8; ++e) S[e] += z[e];
        const int t = t0 + i; const int cnt = smp ? W : (t + 1 < W ? t + 1 : W); const float inv = 1.0f / (float)cnt;
        float uo[8];
#pragma unroll
        for (int e = 0; e < 8; ++e) uo[e] = S[e] * inv - z[e];
        st8b(UP + (size_t)(row0 + i) * BR_W + c0, uo);
        if (st_out && t >= st_t0) st8f(st_out + (size_t)(t - st_t0) * 512 + c0, z);
        float zo[8]; up8(zr[i], zo);
#pragma unroll
        for (int e = 0; e < 8; ++e) S[e] -= zo[e]; }
}
template <int W> __device__ __forceinline__ void pool8_fast(const bf16* ZP, bf16* UP, float* st_out, int st_t0, int row0, int t0, bool smp, int c0) {
    v4u zr[W + 7];
#pragma unroll
    for (int k = 0; k < W + 7; ++k) { const int rk = row0 - (W - 1) + k; zr[k] = *(const GAS v4u*)(ZP + (size_t)(rk < 0 ? 0 : rk) * 512 + c0); }
#pragma unroll
    for (int k = 0; k < W - 1; ++k) { const bool neg = t0 - (W - 1) + k < 0; zr[k].x = neg ? 0u : zr[k].x; zr[k].y = neg ? 0u : zr[k].y; zr[k].z = neg ? 0u : zr[k].z; zr[k].w = neg ? 0u : zr[k].w; }
    float S[8];
#pragma unroll
    for (int e = 0; e < 8; ++e) S[e] = 0.f;
#pragma unroll
    for (int k = 0; k < W - 1; ++k) { float z[8]; up8(zr[k], z);
#pragma unroll
        for (int e = 0; e < 8; ++e) S[e] += z[e]; }
#pragma unroll
    for (int i = 0; i < 8; ++i) { float z[8]; up8(zr[i + W - 1], z);
#pragma unroll
        for (int e = 0; e < 8; ++e) S[e] += z[e];
        const int t = t0 + i; const int cnt = smp ? W : (t + 1 < W ? t + 1 : W); const float inv = 1.0f / (float)cnt;
        float uo[8];
#pragma unroll
        for (int e = 0; e < 8; ++e) uo[e] = S[e] * inv - z[e];
        st8b(UP + (size_t)(row0 + i) * BR_W + c0, uo);
        if (st_out && t >= st_t0) st8f(st_out + (size_t)(t - st_t0) * 512 + c0, z);
        float zo[8]; up8(zr[i], zo);
#pragma unroll
        for (int e = 0; e < 8; ++e) S[e] -= zo[e]; }
}
__device__ __forceinline__ void mixa_elem(Frame& F, const Args& A, int l) {
    unsigned char* ws = F.ws;
    const bf16* ZP = (const bf16*)(ws + WS_ZP); const bf16* HC = (const bf16*)(ws + WS_HC); const bf16* BC = (const bf16*)(ws + WS_BC); const bf16* CC = (const bf16*)(ws + WS_CC);
    bf16* OALL = (bf16*)(ws + WS_OALL); bf16* UP = OALL;
    const int gi = F.wave & 3, c0 = (gi * 16 + (F.lane & 15)) * 8, rsub = (F.wave >> 2) * 4 + (F.lane >> 4);
    float cw0[8], cw1[8], cw2[8], cbias[8];
    ld8f(A.in[I_CONVW] + (size_t)(l * 3 + 0) * 512 + c0, cw0); ld8f(A.in[I_CONVW] + (size_t)(l * 3 + 1) * 512 + c0, cw1); ld8f(A.in[I_CONVW] + (size_t)(l * 3 + 2) * 512 + c0, cw2); ld8f(A.in[I_CONVB] + (size_t)l * 512 + c0, cbias);
    const int nptile = (M_P / 64 - F.vcu + F.G - 1) / F.G; const int nstile = (64 - F.vcu + F.G - 1) / F.G;
#pragma unroll 1
    for (int it = 0; it < nptile + nstile; ++it) {
        const bool stile = it >= nptile; const int sidx = F.vcu + (it - nptile) * F.G;
        if (stile && F.wave != (sidx & 7)) continue;
        const int tile = stile ? M_P / 64 + (sidx >> 3) : F.vcu + it * F.G;
        const int row0 = tile * 64 + rsub * 8; const bool smp = row0 >= M_P; const int loc = row0 - M_P;
        const int t0 = smp ? (loc & 31) : (row0 & (SEQ - 1)), b = smp ? (loc >> 5) : (row0 >> 14);
        const float* hist = smp ? A.in[I_SPOOL] + (size_t)(l * NB_S + b) * 15 * 512 : nullptr;
        float* st_out = smp ? F.out + O_PS + (size_t)(l * NB_S + b) * 15 * 512 : F.out + O_PP + (size_t)(l * NB_P + b) * 15 * 512;
        const int L = smp ? SEQ_S : SEQ;
        if (t0 + 8 <= L - 15) st_out = nullptr;
        if (smp && t0 < 15) {
            if (gi == 0) pool8<2>(ZP, hist, UP, st_out, L - 15, row0, t0, smp, c0);
            else if (gi == 1) pool8<4>(ZP, hist, UP, st_out, L - 15, row0, t0, smp, c0);
            else if (gi == 2) pool8<8>(ZP, hist, UP, st_out, L - 15, row0, t0, smp, c0);
            else pool8<16>(ZP, hist, UP, st_out, L - 15, row0, t0, smp, c0);
            const float* chist = smp ? A.in[I_SCONV] + (size_t)(l * NB_S + b) * 2 * 512 : nullptr;
            float* cst = smp ? F.out + O_CS + (size_t)(l * NB_S + b) * 2 * 512 : F.out + O_CP + (size_t)(l * NB_P + b) * 2 * 512;
            v4u hr[10], cr[10], br[8];
    #pragma unroll
            for (int k = 0; k < 10; ++k) { const int tk = t0 - 2 + k;
                if (tk >= 0) { hr[k] = *(const GAS v4u*)(HC + (size_t)(row0 - 2 + k) * 512 + c0); cr[k] = *(const GAS v4u*)(CC + (size_t)(row0 - 2 + k) * 512 + c0); }
                else { hr[k] = (v4u){0u, 0u, 0u, 0u}; cr[k] = hr[k]; } }
    #pragma unroll
            for (int k = 0; k < 8; ++k) br[k] = *(const GAS v4u*)(BC + (size_t)(row0 + k) * 512 + c0);
            float z2[8], z1[8];
            {   float h_[8], c_[8];
                if (t0 >= 2 || !smp) { up8(hr[0], h_); up8(cr[0], c_);
    #pragma unroll
                    for (int e = 0; e < 8; ++e) z2[e] = h_[e] * c_[e]; } else ld8f(chist + (size_t)(t0) * 512 + c0, z2);
                if (t0 >= 1 || !smp) { up8(hr[1], h_); up8(cr[1], c_);
    #pragma unroll
                    for (int e = 0; e < 8; ++e) z1[e] = h_[e] * c_[e]; } else ld8f(chist + (size_t)(t0 + 1) * 512 + c0, z1); }
    #pragma unroll
            for (int i = 0; i < 8; ++i) { float h_[8], c_[8], z0[8], bb[8], y[8]; up8(hr[i + 2], h_); up8(cr[i + 2], c_); up8(br[i], bb);
    #pragma unroll
                for (int e = 0; e < 8; ++e) { z0[e] = h_[e] * c_[e]; y[e] = (cbias[e] + z2[e] * cw0[e] + z1[e] * cw1[e] + z0[e] * cw2[e]) * bb[e]; }
                st8b(OALL + (size_t)(row0 + i) * BR_W + 1024 + c0, y);
                const int t = t0 + i; if (t >= L - 2) st8f(cst + (size_t)(t - (L - 2)) * 512 + c0, z0);
    #pragma unroll
                for (int e = 0; e < 8; ++e) { z2[e] = z1[e]; z1[e] = z0[e]; } }
        } else {
            if (gi == 0) pool8_fast<2>(ZP, UP, st_out, L - 15, row0, t0, smp, c0);
            else if (gi == 1) pool8_fast<4>(ZP, UP, st_out, L - 15, row0, t0, smp, c0);
            else if (gi == 2) pool8_fast<8>(ZP, UP, st_out, L - 15, row0, t0, smp, c0);
            else pool8_fast<16>(ZP, UP, st_out, L - 15, row0, t0, smp, c0);
            float* cst = smp ? F.out + O_CS + (size_t)(l * NB_S + b) * 2 * 512 : F.out + O_CP + (size_t)(l * NB_P + b) * 2 * 512;
            v4u hr[10], cr[10], br[8];
#pragma unroll
            for (int k = 0; k < 10; ++k) { const int rk = row0 - 2 + k; const size_t ro = (size_t)(rk < 0 ? 0 : rk) * 512 + c0; hr[k] = *(const GAS v4u*)(HC + ro); cr[k] = *(const GAS v4u*)(CC + ro); }
#pragma unroll
            for (int k = 0; k < 8; ++k) br[k] = *(const GAS v4u*)(BC + (size_t)(row0 + k) * 512 + c0);
#pragma unroll
            for (int k = 0; k < 2; ++k) { const bool neg = t0 - 2 + k < 0; hr[k].x = neg ? 0u : hr[k].x; hr[k].y = neg ? 0u : hr[k].y; hr[k].z = neg ? 0u : hr[k].z; hr[k].w = neg ? 0u : hr[k].w; }
            float z2[8], z1[8];
            {   float h_[8], c_[8]; up8(hr[0], h_); up8(cr[0], c_);
#pragma unroll
                for (int e = 0; e < 8; ++e) z2[e] = h_[e] * c_[e];
                up8(hr[1], h_); up8(cr[1], c_);
#pragma unroll
                for (int e = 0; e < 8; ++e) z1[e] = h_[e] * c_[e]; }
#pragma unroll
            for (int i = 0; i < 8; ++i) { float h_[8], c_[8], z0[8], bb[8], y[8]; up8(hr[i + 2], h_); up8(cr[i + 2], c_); up8(br[i], bb);
#pragma unroll
                for (int e = 0; e < 8; ++e) { z0[e] = h_[e] * c_[e]; y[e] = (cbias[e] + z2[e] * cw0[e] + z1[e] * cw1[e] + z0[e] * cw2[e]) * bb[e]; }
                st8b(OALL + (size_t)(row0 + i) * BR_W + 1024 + c0, y);
                const int t = t0 + i; if (t >= L - 2) st8f(cst + (size_t)(t - (L - 2)) * 512 + c0, z0);
#pragma unroll
                for (int e = 0; e < 8; ++e) { z2[e] = z1[e]; z1[e] = z0[e]; } }
        }
    }
}

__device__ __forceinline__ void diff_subln(Frame& F, const Args& A, int l) {
    const int lane = F.lane; const int gw = F.vcu * NWAVES + F.wave, NGW = F.G * NWAVES;
    const float s1 = wave_sum(A.in[I_LQ1][l * 64 + lane] * A.in[I_LK1][l * 64 + lane]), s2 = wave_sum(A.in[I_LQ2][l * 64 + lane] * A.in[I_LK2][l * 64 + lane]);
    const float lam_init = 0.8f - 0.6f * expf(-0.3f * (float)l);
    const float lam = expf(s1) - expf(s2) + lam_init, coef = 1.0f - lam_init;
    const int h = lane >> 3, e0 = (lane & 7) * 16;
    float sw0[8], sw1[8]; ld8f(A.in[I_SUBLN] + (size_t)l * 128 + e0, sw0); ld8f(A.in[I_SUBLN] + (size_t)l * 128 + e0 + 8, sw1);
    const bf16* OA = (const bf16*)(F.ws + WS_OATT); bf16* OALL = (bf16*)(F.ws + WS_OALL);
    for (int m0 = gw; m0 < M_T; m0 += 4 * NGW) {
        v4u ra[4][4];
#pragma unroll
        for (int r = 0; r < 4; ++r) { int m = m0 + r * NGW; m = m < M_T ? m : m0; const bf16* p1 = OA + (size_t)m * 2048 + (2 * h) * 128 + e0;
            ra[r][0] = *(const GAS v4u*)p1; ra[r][1] = *(const GAS v4u*)(p1 + 8); ra[r][2] = *(const GAS v4u*)(p1 + 128); ra[r][3] = *(const GAS v4u*)(p1 + 136); }
        __builtin_amdgcn_sched_barrier(0);
#pragma unroll
        for (int r = 0; r < 4; ++r) { int m = m0 + r * NGW; m = m < M_T ? m : m0;
            float a0[8], a1[8], b0[8], b1[8]; up8(ra[r][0], a0); up8(ra[r][1], a1); up8(ra[r][2], b0); up8(ra[r][3], b1);
            float ss = 0.f;
#pragma unroll
            for (int e = 0; e < 8; ++e) { a0[e] = a0[e] - lam * b0[e]; a1[e] = a1[e] - lam * b1[e]; ss += a0[e] * a0[e] + a1[e] * a1[e]; }
            ss += swz_xor<1>(ss); ss += swz_xor<2>(ss); ss += swz_xor<4>(ss);
            const float rs = coef / sqrtf(ss * (1.0f / 128.0f) + LN_EPS);
#pragma unroll
            for (int e = 0; e < 8; ++e) { a0[e] = a0[e] * rs * sw0[e]; a1[e] = a1[e] * rs * sw1[e]; }
            bf16* o = OALL + (size_t)m * BR_W + 1536 + h * 128 + e0;
            { v4u w; w.x = pk2hw(a0[0], a0[1]); w.y = pk2hw(a0[2], a0[3]); w.z = pk2hw(a0[4], a0[5]); w.w = pk2hw(a0[6], a0[7]); *(GAS v4u*)o = w; }
            { v4u w; w.x = pk2hw(a1[0], a1[1]); w.y = pk2hw(a1[2], a1[3]); w.z = pk2hw(a1[4], a1[5]); w.w = pk2hw(a1[6], a1[7]); *(GAS v4u*)(o + 8) = w; } }
    }
}

__device__ __forceinline__ void ln_load_row(const void* Yv, bool ybf, int m, int lane, f32x4 (&v)[4]) {
    if (ybf) { const GAS v4u* xr = (const GAS v4u*)((const bf16*)Yv + (size_t)m * DM) + lane;
#pragma unroll
        for (int jj = 0; jj < 2; ++jj) { const v4u w = xr[64 * jj]; v[2 * jj] = (f32x4){bfl(w.x), bfh(w.x), bfl(w.y), bfh(w.y)}; v[2 * jj + 1] = (f32x4){bfl(w.z), bfh(w.z), bfl(w.w), bfh(w.w)}; } }
    else { const GAS f32x4* xr = (const GAS f32x4*)((const float*)Yv + (size_t)m * DM) + 2 * lane;
#pragma unroll
        for (int j = 0; j < 4; ++j) v[j] = xr[128 * (j >> 1) + (j & 1)]; }
}
__device__ __forceinline__ void ln_finish_row(f32x4 (&v)[4], const f32x4 (&g4)[4], const f32x4 (&b4)[4], int m, int lane, float* outf, bf16* outb) {
    float s = 0.f;
#pragma unroll
    for (int j = 0; j < 4; ++j) s += (v[j].x + v[j].y) + (v[j].z + v[j].w);
    const float mean = wave_sum(s) * (1.f / DM); float s2 = 0.f;
#pragma unroll
    for (int j = 0; j < 4; ++j) { v[j] = v[j] - mean; s2 += (v[j].x * v[j].x + v[j].y * v[j].y) + (v[j].z * v[j].z + v[j].w * v[j].w); }
    const float rstd = 1.f / sqrtf(wave_sum(s2) * (1.f / DM) + LN_EPS);
#pragma unroll
    for (int j = 0; j < 4; ++j) { v[j] = v[j] * rstd * g4[j] + b4[j];
        if (outf) ((GAS f32x4*)(outf + (size_t)m * DM))[2 * lane + 128 * (j >> 1) + (j & 1)] = v[j]; }
    if (outb) {
#pragma unroll
        for (int jj = 0; jj < 2; ++jj) { v4u w; w.x = pk2hw(v[2 * jj].x, v[2 * jj].y); w.y = pk2hw(v[2 * jj].z, v[2 * jj].w); w.z = pk2hw(v[2 * jj + 1].x, v[2 * jj + 1].y); w.w = pk2hw(v[2 * jj + 1].z, v[2 * jj + 1].w);
            ((GAS v4u*)(outb + (size_t)m * DM))[lane + 64 * jj] = w; } }
}
__device__ __forceinline__ void ln_rows(Frame& F, const void* Yv, bool ybf, const float* gam, const float* bet, float* outf, bf16* outb) {
    const int gw = F.vcu * NWAVES + F.wave, NGW = F.G * NWAVES;
    f32x4 g4[4], b4[4];
#pragma unroll
    for (int j = 0; j < 4; ++j) { g4[j] = ((const GAS f32x4*)gam)[2 * F.lane + 128 * (j >> 1) + (j & 1)]; b4[j] = ((const GAS f32x4*)bet)[2 * F.lane + 128 * (j >> 1) + (j & 1)]; }
    for (int m = gw; m < M_T; m += 2 * NGW) {
        const int m2 = m + NGW < M_T ? m + NGW : m;
        f32x4 va[4], vb[4];
        ln_load_row(Yv, ybf, m, F.lane, va);
        ln_load_row(Yv, ybf, m2, F.lane, vb);
        ln_finish_row(va, g4, b4, m, F.lane, outf, outb);
        ln_finish_row(vb, g4, b4, m2, F.lane, outf, outb);
    }
}

template <int MODE, int N = DM> __device__ __forceinline__ void skinny_gemm(Frame& F, const bf16* A  , const bf16* Bt, int K, const void* resid  , bool rbf = false, bool ybf = false) {
    const int lane = F.lane, r32 = lane & 31, hi = lane >> 5, w = F.wave;
    LAS float* part = (LAS float*)(F.lds + RING_OFF);
    for (int tile = F.vcu; tile < (M_S / 64) * (N / 32); tile += F.G) {
        const int rb = tile & 7, cb = tile >> 3, row0 = rb * 64, col0 = cb * 32;
        int ks0, nks;
        if (MODE == 1) { ks0 = w < 6 ? w * 16 : 96 + (w - 6) * 32; nks = w < 6 ? 16 : 32; }
        else { nks = K / 128; ks0 = w * nks; }
        const bf16* a0 = A + (size_t)(row0 + r32) * K + ks0 * 16 + 8 * hi; const bf16* a1 = a0 + (size_t)32 * K; const bf16* bp = Bt + (size_t)(col0 + r32) * K + ks0 * 16 + 8 * hi;
        f32x16 acc0 = {}, acc1 = {};
        bf16x8 pa0[4], pa1[4], pb[4], qa0[4], qa1[4], qb_[4];
#define SK_LOAD(X0, X1, XB, kk) do { _Pragma("unroll") for (int u = 0; u < 4; ++u) { X0[u] = *(const bf16x8*)(a0 + ((kk) + u) * 16); X1[u] = *(const bf16x8*)(a1 + ((kk) + u) * 16); XB[u] = *(const bf16x8*)(bp + ((kk) + u) * 16); } } while (0)
#define SK_MMA(X0, X1, XB) do { _Pragma("unroll") for (int u = 0; u < 4; ++u) { acc0 = __builtin_amdgcn_mfma_f32_32x32x16_bf16(X0[u], XB[u], acc0, 0, 0, 0); acc1 = __builtin_amdgcn_mfma_f32_32x32x16_bf16(X1[u], XB[u], acc1, 0, 0, 0); } } while (0)
        SK_LOAD(pa0, pa1, pb, 0);
#pragma unroll 1
        for (int k = 0; k < nks; k += 8) {
            const bool two = k + 4 < nks;
            if (two) SK_LOAD(qa0, qa1, qb_, k + 4);
            SK_MMA(pa0, pa1, pb);
            if (k + 8 < nks) SK_LOAD(pa0, pa1, pb, k + 8);
            if (two) SK_MMA(qa0, qa1, qb_);
        }
#undef SK_LOAD
#undef SK_MMA
        LAS float* mine = part + w * 2048;
#pragma unroll
        for (int r = 0; r < 16; ++r) { const int row = (r & 3) + 8 * (r >> 2) + 4 * hi; mine[row * 32 + r32] = acc0[r]; mine[(32 + row) * 32 + r32] = acc1[r]; }
        __syncthreads();
        {
            const int row = 8 * w + (lane >> 3), c4 = (lane & 7) * 4; const int grow = row0 + row, gcol = col0 + c4;
            f32x4 sum = {0.f, 0.f, 0.f, 0.f};
            if (MODE == 1) {
                const bf16* gp = (const bf16*)(F.ws + WS_G) + (size_t)(M_P + grow) * 4096 + gcol;
#pragma unroll
                for (int b = 0; b < 4; ++b) { const unsigned long long gw = *(const GAS unsigned long long*)(gp + b * 1024);
                    const f32x4 gv = {bfl((unsigned)gw), bfh((unsigned)gw), bfl((unsigned)(gw >> 32)), bfh((unsigned)(gw >> 32))};
                    const f32x4 pb = *(const LAS f32x4*)(part + (2 * b) * 2048 + row * 32 + c4) + *(const LAS f32x4*)(part + (2 * b + 1) * 2048 + row * 32 + c4);
                    sum += gv * pb; }
                *(GAS unsigned long long*)((bf16*)(F.ws + WS_MG) + (size_t)(M_P + grow) * 1024 + gcol) = (unsigned long long)pk2(sum.x, sum.y) | ((unsigned long long)pk2(sum.z, sum.w) << 32);
            } else if (MODE == 3) {
#pragma unroll
                for (int ww = 0; ww < 8; ++ww) sum += *(const LAS f32x4*)(part + ww * 2048 + row * 32 + c4);
                const unsigned long long vw = *(const GAS unsigned long long*)((const bf16*)(F.ws + WS_VSSM) + (size_t)(M_P + grow) * 512 + gcol);
                const f32x4 vv = {bfl((unsigned)vw), bfh((unsigned)vw), bfl((unsigned)(vw >> 32)), bfh((unsigned)(vw >> 32))};
#pragma unroll
                for (int e = 0; e < 4; ++e) sum[e] = vv[e] * pg8::fast_sigmoid(sum[e]);
                *(GAS unsigned long long*)((bf16*)(F.ws + WS_OALL) + (size_t)(M_P + grow) * BR_W + 512 + gcol) = (unsigned long long)pk2(sum.x, sum.y) | ((unsigned long long)pk2(sum.z, sum.w) << 32);
            } else if (MODE == 2) {
#pragma unroll
                for (int ww = 0; ww < 8; ++ww) sum += *(const LAS f32x4*)(part + ww * 2048 + row * 32 + c4);
#pragma unroll
                for (int e = 0; e < 4; ++e) { const float a = fmaxf(sum[e], 0.f); sum[e] = a * a; }
                *(GAS unsigned long long*)((bf16*)(F.ws + WS_G) + (size_t)(M_P + grow) * N + gcol) = (unsigned long long)pk2(sum.x, sum.y) | ((unsigned long long)pk2(sum.z, sum.w) << 32);
            } else {
#pragma unroll
                for (int ww = 0; ww < 8; ++ww) sum += *(const LAS f32x4*)(part + ww * 2048 + row * 32 + c4);
                f32x4 rv; if (rbf) { const unsigned long long w = *(const GAS unsigned long long*)((const bf16*)resid + (size_t)grow * 1024 + gcol); rv = (f32x4){bfl((unsigned)w), bfh((unsigned)w), bfl((unsigned)(w >> 32)), bfh((unsigned)(w >> 32))}; }
                else rv = *(const GAS f32x4*)((const float*)resid + (size_t)grow * 1024 + gcol);
                const f32x4 y = rv * DN_ALPHA + sum;
                if (ybf) *(GAS unsigned long long*)((bf16*)(F.ws + WS_YF) + (size_t)(M_P + grow) * 1024 + gcol) = (unsigned long long)pk2(y.x, y.y) | ((unsigned long long)pk2(y.z, y.w) << 32);
                else *(GAS f32x4*)((float*)(F.ws + WS_YF) + (size_t)(M_P + grow) * 1024 + gcol) = y;
            }
        }
        __syncthreads();
    }
}

__device__ __forceinline__ void attn_all(Frame& F, const Args& A, int l, char* lds_generic) {
    using abf = attn_body::bf16;
    const abf* Q = (const abf*)(F.ws + WS_Q); const abf* K = (const abf*)(F.ws + WS_K); const abf* V = (const abf*)(F.ws + WS_V);
    const abf* KS = (const abf*)(F.ws + WS_KS); const abf* VS = (const abf*)(F.ws + WS_VS); abf* OA = (abf*)(F.ws + WS_OATT);
#if ATTN_DV128
    constexpr int NU_P = NB_P * 16 * 64, NU_S = NB_S * 16;
    const bool bal = (F.G == 256);
    const int nmine = bal ? 8 + REP_SAMPLE : (NU_P + NU_S - F.vcu + F.G - 1) / F.G;
    struct AU { int mode, NT; const abf* Q; const abf* Kh; const abf* Vh; abf* O; const float* Kc; const float* Vc; };
    auto mk = [&](int i) -> AU {
        int mode, b, ph, qb = 0;
        if (bal) {
            const int spos = F.vcu % 9, ip = i < spos ? i : i - REP_SAMPLE;
            if (i < spos || i >= spos + REP_SAMPLE) { mode = 0; const int bp = F.vcu >> 3, s = F.vcu & 7, j = ip >> 1; b = bp >> 4; ph = bp & 15; qb = (ip & 1) ? s + 8 * j : 63 - s - 8 * j; }
            else { mode = 1; b = F.vcu >> 4; ph = F.vcu & 15; }
        } else {
            const int u = F.vcu + i * F.G;
            if (u < NU_P) { mode = 0; const int bp = u >> 6; qb = 63 - (u & 63); b = bp >> 4; ph = bp & 15; }
            else { mode = 1; const int su = u - NU_P; b = su >> 4; ph = su & 15; }
        }
        const size_t qrow = mode == 0 ? (size_t)b * SEQ + (size_t)qb * 256 : (size_t)M_P + (size_t)b * SEQ_S;
        AU u_;
        u_.mode = mode; u_.NT = mode == 0 ? 4 * (qb + 1) : KS_ROWS / 64;
        u_.Kh = (mode == 0 && KT_K) ? K + ((size_t)(b * 16 + ph) * 256) * 4096 : (mode == 0 ? K + (size_t)b * SEQ * 1024 : KS + (size_t)b * KS_ROWS * 1024) + ph * 64;
        u_.Vh = (mode == 0 && KT_V) ? V + ((size_t)(b * 8 + (ph >> 1)) * 256) * 8192 : (mode == 0 ? V + (size_t)b * SEQ * 1024 : VS + (size_t)b * KS_ROWS * 1024) + (ph >> 1) * 128;
        u_.Kc = mode == 0 ? nullptr : A.in[I_CK] + ((size_t)(l * NB_S + b) * PAST) * 1024 + ph * 64;
        u_.Vc = mode == 0 ? nullptr : A.in[I_CV] + ((size_t)(l * NB_S + b) * PAST) * 1024 + (ph >> 1) * 128;
        u_.Q = Q + qrow * 1024 + ph * 64; u_.O = OA + qrow * 2048 + ph * 128;
        return u_;
    };
    AU cur = mk(0); bool pre = false;
#pragma unroll 1
    for (int i = 0; i < nmine; ++i) {
        const bool hasn = i + 1 < nmine; const AU nx = mk(hasn ? i + 1 : i);
        const bool pfN = hasn && cur.mode == 0 && nx.mode == 0 && KT_K && KT_V;
        attn_body::attn_unit<8>(cur.mode, cur.NT, cur.Q, cur.Kh, cur.Vh, cur.O, lds_generic, cur.Kc, cur.Vc, F.tid, pre, pfN, nx.Kh, nx.Vh);
        pre = pfN; cur = nx;
    }
}
#else
    constexpr int NU_P = NB_P * 32 * 64, NU_S = NB_S * 32;
    const bool bal = (F.G == 256);
    const int nmine = bal ? 18 : (NU_P + NU_S - F.vcu + F.G - 1) / F.G;
    for (int i = 0; i < nmine; ++i) {
        int mode, b, vhd, qb = 0;
        if (bal) {
            if (i < 16) { mode = 0; const int bv = F.vcu >> 2, s = F.vcu & 3, j = i >> 1; b = bv >> 5; vhd = bv & 31; qb = (i & 1) ? s + 4 * j : 63 - s - 4 * j; }
            else { mode = 1; const int su = F.vcu + 256 * (i - 16); b = su >> 5; vhd = su & 31; }
        } else {
            const int u = F.vcu + i * F.G;
            if (u < NU_P) { mode = 0; const int bv = u >> 6; qb = 63 - (u & 63); b = bv >> 5; vhd = bv & 31; }
            else { mode = 1; const int su = u - NU_P; b = su >> 5; vhd = su & 31; }
        }
        const int ph = vhd >> 1, vh = vhd & 1;
        const size_t qrow = mode == 0 ? (size_t)b * SEQ + (size_t)qb * 256 : (size_t)M_P + (size_t)b * SEQ_S;
        const abf* Kh = (mode == 0 ? K + (size_t)b * SEQ * 1024 : KS + (size_t)b * KS_ROWS * 1024) + ph * 64;
        const abf* Vh = (mode == 0 ? V + (size_t)b * SEQ * 1024 : VS + (size_t)b * KS_ROWS * 1024) + (ph >> 1) * 128 + vh * 64;
        const int NT = mode == 0 ? 4 * (qb + 1) : KS_ROWS / 64;
        attn_body::attn_unit<8>(mode, NT, Q + qrow * 1024 + ph * 64, Kh, Vh, OA + qrow * 2048 + ph * 128 + vh * 64, lds_generic);
    }
}
#endif

__device__ __forceinline__ int grid_bar(const XcdBarrier& bar, int wave) { XcdBarrier b = bar; b.tid = wave * 64 + lane_id(); xcd_barrier(b); return 1; }
#ifndef REP_SK
#define REP_SK 1
#endif
#if REP_SK > 1
#define REP_SKLOOP _Pragma("unroll 1") for (int rs_ = 0; rs_ < REP_SK; ++rs_)
#else
#define REP_SKLOOP
#endif
__global__ void __launch_bounds__(NWAVES * 64, 2) hse_fwd(Args args) {
    extern __shared__ __attribute__((aligned(16))) unsigned char lds[];
    Frame F;
    F.lds = (LAS unsigned char*)lds;
    F.MISC = (volatile LAS unsigned*)(F.lds + MISC_OFF);
    F.tid = threadIdx.x; F.lane = F.tid & 63; F.wave = __builtin_amdgcn_readfirstlane(F.tid >> 6);
    F.G = gridDim.x; { const int bx = blockIdx.x; F.vcu = (F.G % 8 == 0) ? (bx % 8) * (F.G / 8) + bx / 8 : bx; }
    F.out = args.out; F.ws = args.ws; F.ctl = (gu32*)(args.ws + WS_CTL);
    for (int u = F.tid; u < (LDS_BYTES - LDSCTL_OFF) / 4; u += NWAVES * 64) ((LAS unsigned*)(F.lds + LDSCTL_OFF))[u] = 0u;
    __syncthreads();
    XcdBarrier bar; bar.bar = (unsigned*)(F.ctl + CW_BAR); bar.x = 0; bar.st = nullptr; bar.tid = 0;
#if MK_ONE_LAUNCH
    bar = xcd_barrier_post((unsigned*)(F.ctl + CW_BAR), F.MISC + 8);
#define GRID_BAR() grid_bar(bar, F.wave)
#else
#define GRID_BAR() do { if (F.tid == 0) __hip_atomic_store(F.ctl + CW_TMO, 0xBADBA0u, RLX_AGENT); } while (0)
#endif
    const int lo = args.ph_lo, hi = args.ph_hi;
#define IN(k) (lo <= (k) && (k) < hi)
#define SEAM(k) do { if (IN(k) && IN((k) + 1)) GRID_BAR(); } while (0)
#if MK_ONE_LAUNCH
#define REPEAT(N) _Pragma("unroll 1") for (int rp_ = 0; rp_ < (N); ++rp_) for (int once_ = (rp_ > 0 ? grid_bar(bar, F.wave) : 1); once_; once_ = 0)
#else
#define REPEAT(N)
#endif
#define PHASE_ENTER() Frame P = F; unsigned char* ws; { int t_ = F.wave * 64 + lane_id(); asm volatile("" : "+v"(t_)); P.tid = t_; P.lane = t_ & 63; P.wave = F.wave; \
        GAS unsigned char* w_ = (GAS unsigned char*)args.ws; asm volatile("" : "+s"(w_)); ws = (unsigned char*)w_; P.ws = ws; GAS float* o_ = (GAS float*)args.out; asm volatile("" : "+s"(o_)); P.out = (float*)o_; } \
        unsigned char* wl = ws + WS_W + (size_t)l * W_LSTRIDE; (void)wl

    { const int l = 0; if (IN(0)) { PHASE_ENTER(); p0_prologue(P, args); } } SEAM(0);

    for (int l = 0; l < DEPTH; ++l) {
        const int pb = 1 + l * PH_PER_LAYER;
        if (IN(pb + P_WIN)) { PHASE_ENTER();
            pg8::Gemm g{(const bf16*)(ws + WS_XB), (const bf16*)(wl + W_IN), M_T, N_IN, DM}; typedef pg8::StaticOrderT<M_T / 256, N_IN / 256> SO; SO S; S.init(M_T, N_IN, P.G, (int)blockIdx.x); S.tid = P.tid;
            pg8::EpiWin E{ws, P.out, l, attn_body::C2};
            pg8::gemm_phase<pg8::EpiWin, SO, true, true>(P.lds + RING_OFF, g, S, E);
            if (l == 0) {
                constexpr int NU = (M_T / 256) * (N_IN / 256); const int rounds = (NU + P.G - 1) / P.G, nlast = NU - (rounds - 1) * P.G;
                const int bx = (int)blockIdx.x;
                if (nlast >= P.G) p0_weights(P, args, I_IN0, 1 << 30, bx * NWAVES + P.wave, P.G * NWAVES);
                else if (bx >= nlast) p0_weights(P, args, I_IN0, 1 << 30, (bx - nlast) * NWAVES + P.wave, (P.G - nlast) * NWAVES);
            }
        }
        SEAM(pb + P_WIN);
        if (IN(pb + P_MIXA)) { PHASE_ENTER(); mixa_elem(P, args, l); ssm_pass<false>(P, args, l); }
        SEAM(pb + P_MIXA);
        if (IN(pb + P_ATTN)) { PHASE_ENTER(); ssm_carry(P, l); attn_all(P, args, l, (char*)lds + RING_OFF); }
#if REP_ATTN > 1
        GRID_BAR(); if (IN(pb + P_ATTN)) { PHASE_ENTER(); attn_all(P, args, l, (char*)lds + RING_OFF); }
#endif
        SEAM(pb + P_ATTN);
        if (IN(pb + P_MIXC)) { PHASE_ENTER(); ssm_pass<true>(P, args, l); diff_subln(P, args, l); }
        SEAM(pb + P_MIXC);
        if (IN(pb + P_PG)) { PHASE_ENTER();
            pg8::Gemm g{(const bf16*)(ws + WS_VSSM), (const bf16*)(wl + W_GLU), M_P, 512, 512}; typedef pg8::StaticOrderT<M_P / 256, 2> SO; SO S; S.init(M_P, 512, P.G, (int)blockIdx.x); S.tid = P.tid;
            pg8::EpiGlu E{ws};
            pg8::gemm_phase<pg8::EpiGlu, SO, true, true>(P.lds + RING_OFF, g, S, E);
            REP_SKLOOP skinny_gemm<3, 512>(P, (const bf16*)(ws + WS_VSSM) + (size_t)M_P * 512, (const bf16*)(wl + W_GLU), 512, nullptr);
        }
        SEAM(pb + P_PG);
        if (IN(pb + P_MERGE)) { PHASE_ENTER();
            pg8::Gemm g{(const bf16*)(ws + WS_OALL), (const bf16*)(wl + W_BR), M_P, DM, BR_W}; typedef pg8::StaticOrderT<M_P / 256, DM / 256> SO; SO S; S.init(M_P, DM, P.G, (int)blockIdx.x); S.tid = P.tid;
            pg8::EpiMerge E{ws, P.tid};
            pg8::gemm_phase<pg8::EpiMerge, SO, true, true>(P.lds + RING_OFF, g, S, E);
            REP_SKLOOP skinny_gemm<1>(P, (const bf16*)(ws + WS_OALL) + (size_t)M_P * BR_W, (const bf16*)(wl + W_BR), BR_W, nullptr);
        }
        SEAM(pb + P_MERGE);
        if (IN(pb + P_OUT)) { PHASE_ENTER();
            pg8::Gemm g{(const bf16*)(ws + WS_MG), (const bf16*)(wl + W_OUT), M_P, DM, DM}; typedef pg8::StaticOrderT<M_P / 256, DM / 256> SO; SO S; S.init(M_P, DM, P.G, (int)blockIdx.x); S.tid = P.tid;
            const void* rs = l == 0 ? (const void*)args.in[I_XS] : (const void*)((const bf16*)(ws + WS_XB) + (size_t)M_P * DM);
            pg8::EpiResid E{(const pg8::bf16_t*)(ws + WS_XB), ws, 1};
            pg8::gemm_phase<pg8::EpiResid, SO, true, true>(P.lds + RING_OFF, g, S, E);
            REP_SKLOOP skinny_gemm<0>(P, (const bf16*)(ws + WS_MG) + (size_t)M_P * DM, (const bf16*)(wl + W_OUT), DM, rs, l != 0, true);
        }
        SEAM(pb + P_OUT);
        if (IN(pb + P_LN1)) { PHASE_ENTER(); ln_rows(P, (const void*)(ws + WS_YF), true, args.in[I_LN1G] + (size_t)l * DM, args.in[I_LN1B] + (size_t)l * DM, nullptr, (bf16*)(ws + WS_XMB)); }
        SEAM(pb + P_LN1);
        if (IN(pb + P_UP)) { PHASE_ENTER();
            pg8::Gemm g{(const bf16*)(ws + WS_XMB), (const bf16*)(wl + W_UP), M_T, D_FF, DM}; typedef pg8::StaticOrderT<M_T / 256, D_FF / 256> SO; SO S; S.init(M_T, D_FF, P.G, (int)blockIdx.x); S.tid = P.tid;
            pg8::EpiUp E{ws};
            pg8::gemm_phase<pg8::EpiUp, SO, true, true>(P.lds + RING_OFF, g, S, E);
        }
        SEAM(pb + P_UP);
        if (IN(pb + P_DOWN)) { PHASE_ENTER();
            pg8::Gemm g{(const bf16*)(ws + WS_G), (const bf16*)(wl + W_DN), M_P, DM, D_FF}; typedef pg8::StaticOrderT<M_P / 256, DM / 256> SO; SO S; S.init(M_P, DM, P.G, (int)blockIdx.x); S.tid = P.tid;
            pg8::EpiResid E{(const pg8::bf16_t*)(ws + WS_XMB), ws, l + 1 < DEPTH ? 1 : 0};
            pg8::gemm_phase<pg8::EpiResid, SO, true, true>(P.lds + RING_OFF, g, S, E);
            REP_SKLOOP skinny_gemm<0>(P, (const bf16*)(ws + WS_G) + (size_t)M_P * D_FF, (const bf16*)(wl + W_DN), D_FF, (const bf16*)(ws + WS_XMB) + (size_t)M_P * DM, true, l + 1 < DEPTH);
        }
        SEAM(pb + P_DOWN);
        if (IN(pb + P_LN2)) { PHASE_ENTER();
            if (l + 1 < DEPTH) ln_rows(P, (const void*)(ws + WS_YF), true, args.in[I_LN2G] + (size_t)l * DM, args.in[I_LN2B] + (size_t)l * DM, nullptr, (bf16*)(ws + WS_XB));
            else ln_rows(P, (const void*)(ws + WS_YF), false, args.in[I_LN2G] + (size_t)l * DM, args.in[I_LN2B] + (size_t)l * DM, P.out + O_YP, nullptr);
        }
        SEAM(pb + P_LN2);
    }
#undef IN
#undef SEAM
}

extern "C" void kernel_launch(void* const* d_in, const int* in_sizes, int n_in, void* d_out, int out_size, void* d_ws, size_t ws_size, hipStream_t stream) {
    static int grid = 0;
    if (grid == 0) {
        if (n_in != 35 || (size_t)out_size != O_END || ws_size < WS_END) { fprintf(stderr, "kernel_launch: unexpected shapes: n_in %d out %d (want %zu) ws %zu (want %zu)\n", n_in, out_size, (size_t)O_END, ws_size, (size_t)WS_END); grid = -1; return; }
        int dev = 0, cus = 0, per_cu = 0;
        if (hipGetDevice(&dev) != hipSuccess || hipDeviceGetAttribute(&cus, hipDeviceAttributeMultiprocessorCount, dev) != hipSuccess) { grid = -1; return; }
        if (hipFuncSetAttribute((const void*)hse_fwd, hipFuncAttributeMaxDynamicSharedMemorySize, LDS_BYTES) != hipSuccess) { fprintf(stderr, "kernel_launch: hipFuncSetAttribute failed\n"); grid = -1; return; }
        if (hipOccupancyMaxActiveBlocksPerMultiprocessor(&per_cu, (const void*)hse_fwd, NWAVES * 64, LDS_BYTES) != hipSuccess || per_cu < 1) fprintf(stderr, "kernel_launch: occupancy query reports %d\n", per_cu);
        (void)hipGetLastError();
        grid = cus;
    }
    if (grid < 0) return;
    (void)hipMemsetAsync((char*)d_ws + WS_CTL, 0, CTL_ZERO_BYTES, stream);
    Args a{};
    for (int i = 0; i < 35; ++i) a.in[i] = (const float*)d_in[i];
    a.out = (float*)d_out; a.ws = (unsigned char*)d_ws; a.pad = 0;
#if MK_ONE_LAUNCH
    a.ph_lo = 0; a.ph_hi = NPH; a.li = 0;
    hipLaunchKernelGGL(hse_fwd, dim3(grid), dim3(NWAVES * 64), LDS_BYTES, stream, a);
#else
    for (int p = 0; p < NPH; ++p) { a.ph_lo = p; a.ph_hi = p + 1; a.li = p; hipLaunchKernelGGL(hse_fwd, dim3(grid), dim3(NWAVES * 64), LDS_BYTES, stream, a); }
#endif
}
```

```cpp
#include <hip/hip_runtime.h>
#include <hip/hip_bf16.h>
#include <cstdio>
#include <cstdint>
#include <cmath>

#define ATTN_DV128 1
#define KT_K 1
#define KT_V 1
#define REP_EPI 1
#define REP_GEMM 1
#define REP_THIN 1
#define REP_ATTN 1
#define REP_MIXA 1
#define REP_MIXC 1
#define REP_PRO 1
#define REP_WIN 1
#define REP_PG 1
#define REP_MERGE 1
#define REP_OUT 1
#define REP_UP 1
#define REP_DOWN 1
#define REP_SAMPLE 1

#ifndef MK_ONE_LAUNCH
#define MK_ONE_LAUNCH 1
#endif

constexpr int DM = 1024, NB_P = 2, SEQ = 16384, DEPTH = 2, NB_S = 16, SEQ_S = 32, PAST = 4096;
constexpr int M_P = NB_P * SEQ, M_S = NB_S * SEQ_S, M_T = M_P + M_S;
constexpr int N_IN = 9728, D_FF = 4096, BR_W = 2560;
constexpr int KS_ROWS = 4224;
constexpr int NCH_P = M_P / 64;
constexpr float LN_EPS = 1e-5f;
constexpr float DN_ALPHA = 1.41421356237309515f;

constexpr size_t O_YP = 0;
constexpr size_t O_YS = O_YP + (size_t)M_P * DM;
constexpr size_t O_KP = O_YS + (size_t)M_S * DM;
constexpr size_t O_VP = O_KP + (size_t)DEPTH * M_P * 1024;
constexpr size_t O_SRP = O_VP + (size_t)DEPTH * M_P * 1024;
constexpr size_t O_SIP = O_SRP + (size_t)DEPTH * NB_P * 2048;
constexpr size_t O_CP = O_SIP + (size_t)DEPTH * NB_P * 2048;
constexpr size_t O_PP = O_CP + (size_t)DEPTH * NB_P * 2 * 512;
constexpr size_t O_KS = O_PP + (size_t)DEPTH * NB_P * 15 * 512;
constexpr size_t O_VS = O_KS + (size_t)DEPTH * M_S * 1024;
constexpr size_t O_SRS = O_VS + (size_t)DEPTH * M_S * 1024;
constexpr size_t O_SIS = O_SRS + (size_t)DEPTH * NB_S * 2048;
constexpr size_t O_CS = O_SIS + (size_t)DEPTH * NB_S * 2048;
constexpr size_t O_PS = O_CS + (size_t)DEPTH * NB_S * 2 * 512;
constexpr size_t O_END = O_PS + (size_t)DEPTH * NB_S * 15 * 512;

constexpr size_t KiB = 1u << 10, MiB = 1u << 20;
constexpr size_t WS_CTL = 0, CTL_ZERO_BYTES = 64 * KiB;
constexpr size_t WS_W = 2 * MiB, W_LSTRIDE = 44 * MiB;
constexpr size_t W_IN = 0, W_BR = 19 * MiB, W_OUT = 24 * MiB, W_UP = 26 * MiB, W_DN = 34 * MiB, W_GLU = 42 * MiB, W_POOL = 42 * MiB + 512 * KiB;
constexpr size_t WS_ROPE = 90 * MiB;
constexpr size_t WS_SSMC = 91 * MiB, SSMC_LSTRIDE = 512 * KiB;
constexpr size_t SC_AB = 0, SC_A64 = 16 * KiB, SC_BB = 32 * KiB, SC_CM = 160 * KiB;
constexpr size_t WS_E = 92 * MiB, WS_H = 100 * MiB;
constexpr size_t WS_XB = 108 * MiB;
constexpr size_t WS_XF1 = 173 * MiB;
constexpr size_t WS_XMF = 303 * MiB, WS_XMB = 433 * MiB;
constexpr size_t WS_YF = 498 * MiB;
constexpr size_t WS_ZP = 628 * MiB, SZ_512 = (size_t)M_T * 512 * 2;
constexpr size_t WS_US = WS_ZP + SZ_512, WS_HC = WS_US + SZ_512, WS_BC = WS_HC + SZ_512, WS_CC = WS_BC + SZ_512, WS_UPOOL = WS_CC + SZ_512, WS_VSSM = WS_UPOOL + SZ_512;
constexpr size_t WS_Q = 856 * MiB, WS_K = 922 * MiB, WS_V = 986 * MiB;
constexpr size_t WS_KS = 1050 * MiB, WS_VS = 1182 * MiB;
constexpr size_t WS_G = 1314 * MiB;
constexpr size_t WS_OATT = 1574 * MiB;
constexpr size_t WS_OALL = 1704 * MiB;
constexpr size_t WS_MG = 1867 * MiB;
constexpr size_t WS_END = 1932 * MiB;
static_assert(WS_VSSM + SZ_512 <= WS_Q && WS_Q + (size_t)(M_T + 256) * 2048 <= WS_K && WS_KS + (size_t)NB_S * KS_ROWS * 2048 <= WS_VS && WS_VS + (size_t)NB_S * KS_ROWS * 2048 <= WS_G, "ws map 1");
static_assert(WS_G + (size_t)M_T * 8192 <= WS_OATT && WS_OATT + (size_t)M_T * 4096 <= WS_OALL && WS_OALL + (size_t)M_T * 5120 <= WS_MG && WS_MG + (size_t)M_T * 2048 <= WS_END, "ws map 2");
static_assert(WS_XB + (size_t)M_T * 2048 <= WS_XF1 && WS_XF1 + (size_t)M_T * 4096 <= WS_XMF && WS_XMF + (size_t)M_T * 4096 <= WS_XMB && WS_XMB + (size_t)M_T * 2048 <= WS_YF && WS_YF + (size_t)M_T * 4096 <= WS_ZP, "ws map 3");

#ifndef REP_EPI
#define REP_EPI 1
#endif
constexpr int EPI_REP = REP_EPI;
__device__ __forceinline__ int lane_id() { int l; asm volatile("v_mbcnt_lo_u32_b32 %0, -1, 0\n\tv_mbcnt_hi_u32_b32 %0, -1, %0" : "=v"(l)); return l; }
template <int X> __device__ __forceinline__ float swz_xor(float v) { return __int_as_float(__builtin_amdgcn_ds_swizzle(__float_as_int(v), 0x1f | (X << 10))); }
namespace pg8 {
#define PG8_LAS __attribute__((address_space(3)))
typedef unsigned short bf16_t;
typedef short bf16x8 __attribute__((ext_vector_type(8)));
typedef float f32x4 __attribute__((ext_vector_type(4)));
typedef unsigned u32x4 __attribute__((ext_vector_type(4)));
typedef unsigned u32x2 __attribute__((ext_vector_type(2)));
constexpr int BM = 256, BK = 64, HALF = 128, HTB = HALF * BK * 2  , STAGE_BYTES = 8 * HTB, NXCD = 8, WGM = 8;

__host__ __device__ __forceinline__ int lds_byte(int r, int c) { const int st = (r >> 4) * 2 + (c >> 5), rr = r & 15, cc = c & 31, ob = rr * 64 + cc * 2; return st * 1024 + (ob ^ (((ob >> 9) & 1) << 5)); }
__host__ __device__ __forceinline__ void stage_rc(int b, int& R, int& C) { const int st = b / 1024, sb = b % 1024, swz = sb ^ (((sb >> 9) & 1) << 5); R = (st >> 1) * 16 + swz / 64; C = (st & 1) * 32 + (swz % 64) / 2; }
__host__ __device__ __forceinline__ int perm32(int rho) { const int n = rho >> 4, i = rho & 15; return 8 * (i >> 2) + 4 * n + (i & 3); }

struct Unit { int pm, pn; };
struct Gemm { const bf16_t* A; const bf16_t* Bt; int M, N, K; };

template <int NM, int NN> struct StaticOrderT {
    static constexpr int nwg = NM * NN, TAIL = NM % WGM;
    static_assert(TAIL == 0 || TAIL == 1 || TAIL == 2 || TAIL == 4, "last row-panel group must be a power of two");
    int G, c, tid;
    __host__ __device__ void init(int, int, int G_, int c_) { G = G_; c = c_; tid = 0; }
    __host__ __device__ bool next(int i, Unit& u) const {
        const int L = i * G + c; if (L >= nwg) return false;
        int wgid = L; { constexpr int q = nwg / NXCD, r = nwg % NXCD; const int xcd = wgid % NXCD, off = wgid / NXCD; wgid = (xcd < r ? xcd * (q + 1) : r * (q + 1) + (xcd - r) * q) + off; }
        constexpr int nig = WGM * NN; const int gid = wgid / nig, fm = gid * WGM, x = wgid - gid * nig; const bool tail = (NM - fm) < WGM;
        const int sh = tail ? (TAIL == 4 ? 2 : TAIL == 2 ? 1 : 0) : 3;
        u.pm = fm + (x & ((1 << sh) - 1)); u.pn = x >> sh; return true;
    }
    __device__ __forceinline__ const char* abase(const Gemm& g, const Unit& u) const { return (const char*)g.A + (size_t)u.pm * (size_t)(BM * 2) * g.K; }
    __device__ __forceinline__ const char* bbase(const Gemm& g, const Unit& u) const { return (const char*)g.Bt + (size_t)u.pn * (size_t)(BM * 2) * g.K; }
    __device__ __forceinline__ void a_ready(const Unit&) const {}
    __device__ __forceinline__ void done(const Unit&) const {}
};
typedef float pkh_f2_t __attribute__((ext_vector_type(2))); typedef __bf16 pkh_b2_t __attribute__((ext_vector_type(2)));
__device__ __forceinline__ unsigned cvt_pk_bf16_hw(float lo, float hi);
__device__ __forceinline__ unsigned cvt_pk_bf16(float lo, float hi) { return cvt_pk_bf16_hw(lo, hi); }
__device__ __forceinline__ unsigned cvt_pk_bf16_hw(float lo, float hi) { const pkh_f2_t v = {lo, hi}; const pkh_b2_t b = __builtin_convertvector(v, pkh_b2_t); return __builtin_bit_cast(unsigned, b); }
__device__ __forceinline__ float bf_lo(unsigned w) { return __uint_as_float(w << 16); }
__device__ __forceinline__ float bf_hi(unsigned w) { return __uint_as_float(w & 0xffff0000u); }
__device__ __forceinline__ float fast_sigmoid(float x) { return __builtin_amdgcn_rcpf(1.0f + __builtin_amdgcn_exp2f(-1.4426950408889634f * x)); }

#define EPI_LOOP_ROWS for (int ai = 0; ai < 2; ++ai) _Pragma("unroll") for (int m = 0; m < 4; ++m)

struct EpiWin {
    static constexpr bool PERM = true, AFTER_DRAIN = false, MIDK = false, PROBE_REP = true; static constexpr bool PERM2 = false;
    unsigned char* ws; float* out; int l; float qscale;
    static __device__ __forceinline__ u32x4 pack8(const f32x4 v0, const f32x4 v1) { u32x4 w; w.x = cvt_pk_bf16_hw(v0[0], v0[1]); w.y = cvt_pk_bf16_hw(v0[2], v0[3]); w.z = cvt_pk_bf16_hw(v1[0], v1[1]); w.w = cvt_pk_bf16_hw(v1[2], v1[3]); return w; }
    template <bool GATE> __device__ __forceinline__ void plain(const f32x4 (&acc)[2][2][4][2], bf16_t* base, int ld, int row0, int col) const {
#pragma unroll
        EPI_LOOP_ROWS { bf16_t* rowp = base + (size_t)(row0 + ai * HALF + m * 16) * ld + col;
#pragma unroll
            for (int bj = 0; bj < 2; ++bj) { f32x4 v0 = acc[ai][bj][m][0], v1 = acc[ai][bj][m][1];
                if (GATE) {
#pragma unroll
                    for (int e = 0; e < 4; ++e) { v0[e] = fast_sigmoid(v0[e]); v1[e] = fast_sigmoid(v1[e]); } }
                *(u32x4*)(rowp + bj * HALF) = pack8(v0, v1); } }
    }
    __device__ __forceinline__ void gates(const f32x4 (&acc)[2][2][4][2], const Unit& u, int wave, int lane, int row0, int c8) const {
        const bool smp = u.pm >= M_P / BM;
        bf16_t* base = smp ? (bf16_t*)(ws + WS_G) + (size_t)row0 * 4096 + (u.pn - 22) * BM + c8 : (bf16_t*)(ws + WS_G) + ((size_t)u.pm * 16 + (u.pn - 22)) * 65536 + (size_t)(wave * 1024 + lane) * 8;
        const int sA = smp ? HALF * 4096 : 4096, sM = smp ? 16 * 4096 : 1024, sB = smp ? HALF : 512;
#pragma unroll
        EPI_LOOP_ROWS {
#pragma unroll
            for (int bj = 0; bj < 2; ++bj) { f32x4 v0 = acc[ai][bj][m][0], v1 = acc[ai][bj][m][1];
#pragma unroll
                for (int e = 0; e < 4; ++e) { v0[e] = fast_sigmoid(v0[e]); v1[e] = fast_sigmoid(v1[e]); }
                *(u32x4*)(base + (size_t)(ai * sA + m * sM + bj * sB)) = pack8(v0, v1); } }
    }
    template <int KIND, bool ROT> __device__ __forceinline__ void qkv(const f32x4 (&acc)[2][2][4][2], const Unit& u, int row0, int colt, int c8, int fq) const {
        const bool smp = u.pm >= M_P / BM;
        const float sg = fq == 0 ? -1.f : 1.f; const bool act = fq < 2;
#pragma unroll
        for (int ai = 0; ai < 2; ++ai) {
        f32x4 rt[4][4];
        if (ROT) {
#pragma unroll
            for (int m = 0; m < 4; ++m) { const int row = row0 + ai * HALF + m * 16, loc = row - M_P; const int pos = smp ? PAST + (loc & 31) : (row & (SEQ - 1)); const f32x4* rp = (const f32x4*)(ws + WS_ROPE) + (size_t)pos * 4;
                rt[m][0] = rp[0]; rt[m][1] = rp[1]; rt[m][2] = rp[2]; rt[m][3] = rp[3]; }
            __builtin_amdgcn_sched_barrier(0); }
#pragma unroll
        for (int m = 0; m < 4; ++m) {
            const int row = row0 + ai * HALF + m * 16, loc = row - M_P;
            f32x4 cs0, cs1, sn0, sn1;
            if (ROT) { cs0 = rt[m][0]; cs1 = rt[m][1]; sn0 = rt[m][2]; sn1 = rt[m][3];
#pragma unroll
                for (int e = 0; e < 4; ++e) { cs0[e] = act ? cs0[e] : 1.f; cs1[e] = act ? cs1[e] : 1.f; sn0[e] = act ? sg * sn0[e] : 0.f; sn1[e] = act ? sg * sn1[e] : 0.f; } }
            float* of = nullptr; bf16_t* ob;
            if (KIND == 0) ob = (bf16_t*)(ws + WS_Q) + (size_t)row * 1024 + colt + c8;
            else { const size_t fo = smp ? (KIND == 1 ? O_KS : O_VS) + (size_t)l * M_S * 1024 + (size_t)loc * 1024 : (KIND == 1 ? O_KP : O_VP) + (size_t)l * M_P * 1024 + (size_t)row * 1024;
                of = out + fo + colt + c8;
                ob = smp ? (bf16_t*)(ws + (KIND == 1 ? WS_KS : WS_VS)) + ((size_t)(loc >> 5) * KS_ROWS + PAST + (loc & 31)) * 1024 + colt + c8 : (bf16_t*)(ws + (KIND == 1 ? WS_K : WS_V)) + (size_t)row * 1024 + colt + c8; }
#pragma unroll
            for (int bj = 0; bj < 2; ++bj) { f32x4 v0 = acc[ai][bj][m][0], v1 = acc[ai][bj][m][1];
                if (ROT) { f32x4 p0, p1;
#pragma unroll
                    for (int e = 0; e < 4; ++e) { p0[e] = swz_xor<16>(v0[e]); p1[e] = swz_xor<16>(v1[e]); }
                    v0 = v0 * cs0 + p0 * sn0; v1 = v1 * cs1 + p1 * sn1; }
                if (KIND == 0) { v0 = v0 * qscale; v1 = v1 * qscale; }
                else { *(f32x4*)(of + bj * HALF) = v0; *(f32x4*)(of + bj * HALF + 4) = v1; }
                bf16_t* o2 = ob + bj * HALF;
                if (((KIND == 1 && KT_K) || (KIND == 2 && KT_V)) && !smp) {
                    const int col = colt + bj * HALF + c8, bt = row >> 14, tile = (row & (SEQ - 1)) >> 6, r = row & 63;
                    o2 = KIND == 1 ? (bf16_t*)(ws + WS_K) + ((((size_t)(bt * 16 + (col >> 6)) * 256 + tile) * 8 + ((col >> 3) & 7)) * 64 + r) * 8
                                   : (bf16_t*)(ws + WS_V) + ((((size_t)(bt * 8 + (col >> 7)) * 256 + tile) * 4 + ((col >> 5) & 3)) * 64 + r) * 32 + (col & 31); }
                *(u32x4*)o2 = pack8(v0, v1); } }
        }
    }
    __device__ __forceinline__ void operator()(const f32x4 (&acc)[2][2][4][2], const Unit& u, int wr, int wc, int fr, int fq) const {
        { const int ln_ = lane_id(); fr = ln_ & 15; fq = ln_ >> 4; }
        const int pn = u.pn, row0 = u.pm * BM + wr * 64 + fr, c8 = wc * 32 + 8 * fq;
        if (pn < 10) plain<false>(acc, (bf16_t*)(ws + WS_ZP + (size_t)(pn >> 1) * SZ_512), 512, row0, (pn & 1) * BM + c8);
        else if (pn >= 22) gates(acc, u, wr * 4 + wc, fq * 16 + fr, row0, c8);
        else { const bool rot = (wc & 1) == 0;
            if (pn < 14) { if (rot) qkv<0, true>(acc, u, row0, (pn - 10) * BM, c8, fq); else qkv<0, false>(acc, u, row0, (pn - 10) * BM, c8, fq); }
            else if (pn < 18) { if (rot) qkv<1, true>(acc, u, row0, (pn - 14) * BM, c8, fq); else qkv<1, false>(acc, u, row0, (pn - 14) * BM, c8, fq); }
            else qkv<2, false>(acc, u, row0, (pn - 18) * BM, c8, fq); }
    }
};

struct EpiGlu {
    static constexpr bool PERM = true, AFTER_DRAIN = false, MIDK = false; static constexpr bool PROBE_REP = false; static constexpr bool PERM2 = false;
    unsigned char* ws;
    __device__ __forceinline__ void operator()(const f32x4 (&acc)[2][2][4][2], const Unit& u, int wr, int wc, int fr, int fq) const {
        { const int ln_ = lane_id(); fr = ln_ & 15; fq = ln_ >> 4; }
        const int row0 = u.pm * BM + wr * 64 + fr, c8 = wc * 32 + 8 * fq, colt = u.pn * BM;
        u32x4 vv[2][4][2];
#pragma unroll
        EPI_LOOP_ROWS {
#pragma unroll
            for (int bj = 0; bj < 2; ++bj) vv[ai][m][bj] = *(const u32x4*)((const bf16_t*)(ws + WS_VSSM) + (size_t)(row0 + ai * HALF + m * 16) * 512 + colt + bj * HALF + c8); }
        __builtin_amdgcn_sched_barrier(0);
#pragma unroll
        EPI_LOOP_ROWS { const int row = row0 + ai * HALF + m * 16;
#pragma unroll
            for (int bj = 0; bj < 2; ++bj) { f32x4 v0 = acc[ai][bj][m][0], v1 = acc[ai][bj][m][1]; const int col = colt + bj * HALF + c8; const u32x4 x = vv[ai][m][bj];
#pragma unroll
                for (int e = 0; e < 4; ++e) { v0[e] = fast_sigmoid(v0[e]); v1[e] = fast_sigmoid(v1[e]); }
                v0[0] *= bf_lo(x.x); v0[1] *= bf_hi(x.x); v0[2] *= bf_lo(x.y); v0[3] *= bf_hi(x.y); v1[0] *= bf_lo(x.z); v1[1] *= bf_hi(x.z); v1[2] *= bf_lo(x.w); v1[3] *= bf_hi(x.w);
                u32x4 w; w.x = cvt_pk_bf16(v0[0], v0[1]); w.y = cvt_pk_bf16(v0[2], v0[3]); w.z = cvt_pk_bf16(v1[0], v1[1]); w.w = cvt_pk_bf16(v1[2], v1[3]);
                *(u32x4*)((bf16_t*)(ws + WS_OALL) + (size_t)row * BR_W + 512 + col) = w; } }
    }
};

struct EpiMerge {
    static constexpr bool PERM = true, AFTER_DRAIN = false, MIDK = true; static constexpr bool PROBE_REP = false; static constexpr bool PERM2 = false;
    unsigned char* ws; int tid;
    template <bool DEN> __device__ __forceinline__ void scale(f32x4 (&acc)[2][2][4][2], const Unit& u, int wr, int wc, int fr, int fq, int bnum, int bden) const {
        int tid_ = tid; asm volatile("" : "+v"(tid_));
        { const int l_ = tid_ & 63, w_ = tid_ >> 6; fr = l_ & 15; fq = l_ >> 4; wr = w_ >> 2; wc = w_ & 3; }
        const int wave = wr * 4 + wc, lane = fq * 16 + fr;
        const bf16_t* gb = (const bf16_t*)(ws + WS_G) + ((size_t)u.pm * 16 + u.pn) * 65536 + (size_t)(wave * 1024 + lane) * 8;
#pragma unroll
        for (int ai = 0; ai < 2; ++ai) {
            u32x4 ga[4][2], gd[4][2];
#pragma unroll
            for (int m = 0; m < 4; ++m)
#pragma unroll
                for (int bj = 0; bj < 2; ++bj) { const bf16_t* gp = gb + (size_t)(ai * 4096 + m * 1024 + bj * 512);
                    ga[m][bj] = *(const u32x4*)(gp + (size_t)bnum * 262144); if (DEN) gd[m][bj] = *(const u32x4*)(gp + (size_t)bden * 262144); }
            __builtin_amdgcn_sched_barrier(0);
#pragma unroll
            for (int m = 0; m < 4; ++m)
#pragma unroll
                for (int bj = 0; bj < 2; ++bj) { const u32x4 a = ga[m][bj];
                    f32x4 r0 = {bf_lo(a.x), bf_hi(a.x), bf_lo(a.y), bf_hi(a.y)}, r1 = {bf_lo(a.z), bf_hi(a.z), bf_lo(a.w), bf_hi(a.w)};
                    if (DEN) { const u32x4 b = gd[m][bj];
                        r0[0] *= __builtin_amdgcn_rcpf(bf_lo(b.x)); r0[1] *= __builtin_amdgcn_rcpf(bf_hi(b.x)); r0[2] *= __builtin_amdgcn_rcpf(bf_lo(b.y)); r0[3] *= __builtin_amdgcn_rcpf(bf_hi(b.y));
                        r1[0] *= __builtin_amdgcn_rcpf(bf_lo(b.z)); r1[1] *= __builtin_amdgcn_rcpf(bf_hi(b.z)); r1[2] *= __builtin_amdgcn_rcpf(bf_lo(b.w)); r1[3] *= __builtin_amdgcn_rcpf(bf_hi(b.w)); }
                    acc[ai][bj][m][0] *= r0; acc[ai][bj][m][1] *= r1; }
            __builtin_amdgcn_sched_barrier(0);
        }
    }
    __device__ __forceinline__ void mid(f32x4 (&acc)[2][2][4][2], const Unit& u, int wr, int wc, int fr, int fq, int t) const {
        if (t == 8 || t == 16 || t == 24) scale<true>(acc, u, wr, wc, fr, fq, (t >> 3) - 1, t >> 3);
    }
    __device__ __forceinline__ void operator()(f32x4 (&acc)[2][2][4][2], const Unit& u, int wr, int wc, int fr, int fq) const {
        { const int ln_ = lane_id(); fr = ln_ & 15; fq = ln_ >> 4; }
        scale<false>(acc, u, wr, wc, fr, fq, 3, -1);
        int row0 = u.pm * BM + wr * 64 + fr; const int c8 = wc * 32 + 8 * fq;
        asm volatile("" : "+v"(row0));
#pragma unroll
        EPI_LOOP_ROWS { bf16_t* rowp = (bf16_t*)(ws + WS_MG) + (size_t)(row0 + ai * HALF + m * 16) * 1024 + u.pn * BM + c8;
#pragma unroll
            for (int bj = 0; bj < 2; ++bj) { const f32x4 v0 = acc[ai][bj][m][0], v1 = acc[ai][bj][m][1];
                u32x4 w; w.x = cvt_pk_bf16(v0[0], v0[1]); w.y = cvt_pk_bf16(v0[2], v0[3]); w.z = cvt_pk_bf16(v1[0], v1[1]); w.w = cvt_pk_bf16(v1[2], v1[3]);
                *(u32x4*)(rowp + bj * HALF) = w; } }
    }
};

struct EpiResid {
    static constexpr bool PERM = true, AFTER_DRAIN = false, MIDK = false; static constexpr bool PROBE_REP = false; static constexpr bool PERM2 = false;
    const bf16_t* resP; unsigned char* ws; int ybf;
    __device__ __forceinline__ void operator()(const f32x4 (&acc)[2][2][4][2], const Unit& u, int wr, int wc, int fr, int fq) const {
        { const int ln_ = lane_id(); fr = ln_ & 15; fq = ln_ >> 4; }
        const int row0 = u.pm * BM + wr * 64 + fr, col0 = u.pn * BM + wc * 32 + 8 * fq;
        u32x4 rr[2][4][2];
#pragma unroll
        EPI_LOOP_ROWS {
#pragma unroll
            for (int bj = 0; bj < 2; ++bj) rr[ai][m][bj] = *(const u32x4*)(resP + (size_t)(row0 + ai * HALF + m * 16) * 1024 + col0 + bj * HALF); }
        __builtin_amdgcn_sched_barrier(0);
#pragma unroll
        EPI_LOOP_ROWS { const size_t yo = (size_t)(row0 + ai * HALF + m * 16) * 1024 + col0;
#pragma unroll
            for (int bj = 0; bj < 2; ++bj) { const u32x4 w = rr[ai][m][bj];
                const f32x4 y0 = (f32x4){bf_lo(w.x), bf_hi(w.x), bf_lo(w.y), bf_hi(w.y)} * DN_ALPHA + acc[ai][bj][m][0], y1 = (f32x4){bf_lo(w.z), bf_hi(w.z), bf_lo(w.w), bf_hi(w.w)} * DN_ALPHA + acc[ai][bj][m][1];
                if (ybf) { u32x4 o; o.x = cvt_pk_bf16(y0[0], y0[1]); o.y = cvt_pk_bf16(y0[2], y0[3]); o.z = cvt_pk_bf16(y1[0], y1[1]); o.w = cvt_pk_bf16(y1[2], y1[3]); *(u32x4*)((bf16_t*)(ws + WS_YF) + yo + bj * HALF) = o; }
                else { *(f32x4*)((float*)(ws + WS_YF) + yo + bj * HALF) = y0; *(f32x4*)((float*)(ws + WS_YF) + yo + bj * HALF + 4) = y1; } } }
    }
};

struct EpiUp {
    static constexpr bool PERM = true, AFTER_DRAIN = false, MIDK = false; static constexpr bool PROBE_REP = false; static constexpr bool PERM2 = false;
    unsigned char* ws;
    __device__ __forceinline__ void operator()(const f32x4 (&acc)[2][2][4][2], const Unit& u, int wr, int wc, int fr, int fq) const {
        { const int ln_ = lane_id(); fr = ln_ & 15; fq = ln_ >> 4; }
        const int row0 = u.pm * BM + wr * 64 + fr, c8 = wc * 32 + 8 * fq;
#pragma unroll
        EPI_LOOP_ROWS { bf16_t* rowp = (bf16_t*)(ws + WS_G) + (size_t)(row0 + ai * HALF + m * 16) * D_FF + u.pn * BM + c8;
#pragma unroll
            for (int bj = 0; bj < 2; ++bj) { f32x4 v0 = acc[ai][bj][m][0], v1 = acc[ai][bj][m][1];
#pragma unroll
                for (int e = 0; e < 4; ++e) { const float a = fmaxf(v0[e], 0.f), b = fmaxf(v1[e], 0.f); v0[e] = a * a; v1[e] = b * b; }
                u32x4 w; w.x = cvt_pk_bf16(v0[0], v0[1]); w.y = cvt_pk_bf16(v0[2], v0[3]); w.z = cvt_pk_bf16(v1[0], v1[1]); w.w = cvt_pk_bf16(v1[2], v1[3]);
                *(u32x4*)(rowp + bj * HALF) = w; } }
    }
};

template <class Epi, class Sched, bool ALIGN_EPI = false, bool SP2 = false>
__device__ __forceinline__ void gemm_phase(PG8_LAS unsigned char* lds, const Gemm g, const Sched& S, const Epi& E) {
    int tid0_ = S.tid; asm volatile("" : "+v"(tid0_));
    const int tid = tid0_, wid = __builtin_amdgcn_readfirstlane(tid >> 6), lane = tid & 63, wr = wid >> 2, wc = wid & 3, fr = lane & 15, fq = lane >> 4;
    const int K = g.K, nt = K / BK;
    unsigned voffA[2], voffB[2];
#pragma unroll
    for (int i = 0; i < 2; ++i) { int R, C; stage_rc(tid * 16 + i * 8192, R, C); const int Rb = Epi::PERM2 ? ((R >> 5) * 64 + perm32(R & 31)) : Epi::PERM ? ((R & ~31) + perm32(R & 31)) : R;
        voffA[i] = (unsigned)(R * K + C) * 2u; voffB[i] = (unsigned)(Rb * K + C) * 2u; }
    const size_t kstep = (size_t)(BK * 2);
    const size_t hstepB = Epi::PERM2 ? (size_t)32 * K * 2 : (size_t)HALF * K * 2;
    const size_t hstep = (size_t)HALF * K * 2;
    const unsigned ldsw = (unsigned)wid * 1024u;
    const int aoff = lds_byte(wr * 64 + fr, fq * 8), boff = lds_byte(wc * 32 + fr, fq * 8);
#define PG8_SA(b, h) (((b) * 2 + (h)) * HTB)
#define PG8_SB(b, h) ((4 + (b) * 2 + (h)) * HTB)
#define PG8_STAGE(bufoff, gbase, voff) do { _Pragma("unroll") for (int _i = 0; _i < 2; ++_i) \
        __builtin_amdgcn_global_load_lds((const unsigned*)((const char*)(gbase) + (voff)[_i]), (PG8_LAS unsigned*)(lds + (bufoff) + ldsw + _i * 8192), 16, 0, 0); } while (0)
#define PG8_LDA(dst, b, h) do { _Pragma("unroll") for (int m = 0; m < 4; ++m) _Pragma("unroll") for (int k = 0; k < 2; ++k) dst[m][k] = *(const PG8_LAS bf16x8*)(lds + PG8_SA(b, h) + aoff + m * 2048 + k * 1024); } while (0)
#define PG8_LDB(dst, b, h) do { _Pragma("unroll") for (int n = 0; n < 2; ++n) _Pragma("unroll") for (int k = 0; k < 2; ++k) dst[n][k] = *(const PG8_LAS bf16x8*)(lds + PG8_SB(b, h) + boff + n * 2048 + k * 1024); } while (0)
#define PG8_MMA(ai, bj, At, Bt) do { __builtin_amdgcn_s_setprio(1); _Pragma("unroll") for (int m = 0; m < 4; ++m) _Pragma("unroll") for (int n = 0; n < 2; ++n) _Pragma("unroll") for (int k = 0; k < 2; ++k) \
        acc[ai][bj][m][n] = __builtin_amdgcn_mfma_f32_16x16x32_bf16(Bt[n][k], At[m][k], acc[ai][bj][m][n], 0, 0, 0); __builtin_amdgcn_s_setprio(0); } while (0)
#define PG8_WAIT_V(n) asm volatile("s_waitcnt vmcnt(" #n ")" ::: "memory")
#define PG8_WAIT_L(n) asm volatile("s_waitcnt lgkmcnt(" #n ")" ::: "memory")
#define PG8_BAR __builtin_amdgcn_s_barrier()
#define PG8_SCHED __builtin_amdgcn_sched_barrier(0)
    Unit cur, nxt; int ui = 0;
    if (!S.next(0, cur)) return;
    f32x4 acc[2][2][4][2];
#pragma unroll
    for (int a = 0; a < 2; ++a)
#pragma unroll
        for (int b = 0; b < 2; ++b)
#pragma unroll
            for (int m = 0; m < 4; ++m)
#pragma unroll
                for (int n = 0; n < 2; ++n) acc[a][b][m][n] = (f32x4){0.f, 0.f, 0.f, 0.f};
    bf16x8 At[4][2], B0[2][2], B1[2][2];
    const char* cA = S.abase(g, cur); const char* cB = S.bbase(g, cur);
    S.a_ready(cur);
    if constexpr (SP2) {
        PG8_STAGE(PG8_SB(0, 0), cB, voffB); PG8_STAGE(PG8_SB(0, 1), cB + hstepB, voffB); PG8_STAGE(PG8_SA(0, 0), cA, voffA); PG8_STAGE(PG8_SA(0, 1), cA + hstep, voffA);
        if (wr == 1) PG8_BAR;
        PG8_WAIT_V(2); PG8_BAR;
        PG8_STAGE(PG8_SB(1, 0), cB + kstep, voffB); PG8_STAGE(PG8_SA(1, 0), cA + kstep, voffA); PG8_STAGE(PG8_SB(1, 1), cB + hstepB + kstep, voffB);
        PG8_WAIT_V(6); PG8_BAR;
    } else {
        PG8_STAGE(PG8_SB(0, 0), cB, voffB); PG8_STAGE(PG8_SA(0, 0), cA, voffA); PG8_STAGE(PG8_SB(0, 1), cB + hstepB, voffB); PG8_STAGE(PG8_SA(0, 1), cA + hstep, voffA);
        if (wr == 1) PG8_BAR;
        PG8_WAIT_V(4); PG8_BAR;
        PG8_STAGE(PG8_SB(1, 0), cB + kstep, voffB); PG8_STAGE(PG8_SA(1, 0), cA + kstep, voffA); PG8_STAGE(PG8_SB(1, 1), cB + hstepB + kstep, voffB);
        PG8_WAIT_V(6); PG8_BAR;
    }
    for (;;) {
        const bool has_next = S.next(ui + 1, nxt);
        const char* nA = has_next ? S.abase(g, nxt) : cA; const char* nB = has_next ? S.bbase(g, nxt) : cB;
        for (int t = 0; t < nt; t += 2) {
            const bool last = (t == nt - 2);
            const char* a1 = cA + (size_t)(t + 1) * kstep;
            const char* a2 = last ? nA : cA + (size_t)(t + 2) * kstep; const char* b2 = last ? nB : cB + (size_t)(t + 2) * kstep;
            const char* a3 = a2 + kstep; const char* b3 = b2 + kstep;
            if (last && has_next) S.a_ready(nxt);
            if constexpr (Epi::MIDK) E.mid(acc, cur, wr, wc, fr, fq, t);
            if constexpr (SP2) {
            PG8_LDB(B0, 0, 0); PG8_LDB(B1, 0, 1); PG8_SCHED; PG8_LDA(At, 0, 0); PG8_STAGE(PG8_SA(1, 1), a1 + hstep, voffA);
            PG8_WAIT_V(8); PG8_WAIT_L(0); PG8_BAR; PG8_MMA(0, 0, At, B0); PG8_MMA(0, 1, At, B1); PG8_BAR; PG8_SCHED;
            PG8_LDA(At, 0, 1); PG8_STAGE(PG8_SB(0, 0), b2, voffB); PG8_STAGE(PG8_SB(0, 1), b2 + hstepB, voffB); PG8_STAGE(PG8_SA(0, 0), a2, voffA);
            PG8_WAIT_V(8); PG8_WAIT_L(0); PG8_BAR; PG8_MMA(1, 0, At, B0); PG8_MMA(1, 1, At, B1); PG8_BAR; PG8_SCHED;
            PG8_LDB(B0, 1, 0); PG8_LDB(B1, 1, 1); PG8_SCHED; PG8_LDA(At, 1, 0); PG8_STAGE(PG8_SA(0, 1), a2 + hstep, voffA);
            PG8_WAIT_V(8); PG8_WAIT_L(0); PG8_BAR; PG8_MMA(0, 0, At, B0); PG8_MMA(0, 1, At, B1); PG8_BAR; PG8_SCHED;
            PG8_LDA(At, 1, 1); PG8_STAGE(PG8_SB(1, 0), b3, voffB); PG8_STAGE(PG8_SB(1, 1), b3 + hstepB, voffB); PG8_STAGE(PG8_SA(1, 0), a3, voffA);
            PG8_WAIT_V(8); PG8_WAIT_L(0); PG8_BAR; PG8_MMA(1, 0, At, B0); PG8_MMA(1, 1, At, B1); PG8_BAR; PG8_SCHED;
            } else {
            PG8_LDB(B0, 0, 0); PG8_SCHED; PG8_LDA(At, 0, 0); PG8_STAGE(PG8_SA(1, 1), a1 + hstep, voffA);
            PG8_WAIT_L(8); PG8_BAR; PG8_WAIT_L(0); PG8_MMA(0, 0, At, B0); PG8_BAR; PG8_SCHED;
            PG8_LDB(B1, 0, 1); PG8_STAGE(PG8_SB(0, 0), b2, voffB);
            PG8_BAR; PG8_WAIT_L(0); PG8_MMA(0, 1, At, B1); PG8_BAR;
            PG8_LDA(At, 0, 1); PG8_STAGE(PG8_SA(0, 0), a2, voffA);
            PG8_BAR; PG8_WAIT_L(0); PG8_MMA(1, 0, At, B0); PG8_BAR; PG8_SCHED;
            PG8_STAGE(PG8_SB(0, 1), b2 + hstepB, voffB);
            PG8_WAIT_V(6); PG8_BAR; PG8_MMA(1, 1, At, B1); PG8_BAR;
            PG8_LDB(B0, 1, 0); PG8_SCHED; PG8_LDA(At, 1, 0); PG8_STAGE(PG8_SA(0, 1), a2 + hstep, voffA);
            PG8_WAIT_L(8); PG8_BAR; PG8_WAIT_L(0); PG8_MMA(0, 0, At, B0); PG8_BAR; PG8_SCHED;
            PG8_LDB(B1, 1, 1); PG8_STAGE(PG8_SB(1, 0), b3, voffB);
            PG8_BAR; PG8_WAIT_L(0); PG8_MMA(0, 1, At, B1); PG8_BAR;
            PG8_LDA(At, 1, 1); PG8_STAGE(PG8_SA(1, 0), a3, voffA);
            PG8_BAR; PG8_WAIT_L(0); PG8_MMA(1, 0, At, B0); PG8_BAR; PG8_SCHED;
            PG8_STAGE(PG8_SB(1, 1), b3 + hstepB, voffB);
            PG8_WAIT_V(6); PG8_BAR; PG8_MMA(1, 1, At, B1); PG8_BAR;
            }
        }
        if constexpr (ALIGN_EPI) { if (wr == 0) PG8_BAR; }
        if constexpr (!Epi::AFTER_DRAIN) { E(acc, cur, wr, wc, fr, fq); if constexpr (EPI_REP > 1 && Epi::PROBE_REP) { _Pragma("unroll 1") for (int e_ = 1; e_ < EPI_REP; ++e_) { asm volatile("" ::: "memory"); E(acc, cur, wr, wc, fr, fq); } } S.done(cur); }
        if (!has_next) break;
#pragma unroll
        for (int a = 0; a < 2; ++a)
#pragma unroll
            for (int b = 0; b < 2; ++b)
#pragma unroll
                for (int m = 0; m < 4; ++m)
#pragma unroll
                    for (int n = 0; n < 2; ++n) acc[a][b][m][n] = (f32x4){0.f, 0.f, 0.f, 0.f};
        cur = nxt; cA = nA; cB = nB; ++ui;
        if constexpr (ALIGN_EPI) { if (wr == 1) PG8_BAR; }
    }
    PG8_WAIT_V(0);
    if constexpr (!ALIGN_EPI) { if (wr == 0) PG8_BAR; }
    PG8_BAR;
    if constexpr (Epi::AFTER_DRAIN) { E.fused(acc, cur, wr, wc, fr, fq, lds, wid, lane); S.done(cur); }
#undef PG8_SA
#undef PG8_SB
#undef PG8_STAGE
#undef PG8_LDA
#undef PG8_LDB
#undef PG8_MMA
#undef PG8_WAIT_V
#undef PG8_WAIT_L
#undef PG8_BAR
#undef PG8_SCHED
}
}

#include <hip/hip_bf16.h>
#include <cmath>
namespace attn_body {
using bf16=__hip_bfloat16;
using bf16x8=__attribute__((ext_vector_type(8)))short;
using s16x4=__attribute__((ext_vector_type(4)))short;
using f32x16=__attribute__((ext_vector_type(16)))float;
using u32x4=__attribute__((ext_vector_type(4)))unsigned;
constexpr int D=64,DM=1024,OPITCH=2048;
constexpr int NW=8,QBLK=32,QB=QBLK*NW,KVBLK=64;
constexpr int ATTN_UNIT_ROWS=QB;
__device__ __forceinline__ int crow(int r,int hi){return (r&3)+8*(r>>2)+4*hi;}
#define SBAR() __builtin_amdgcn_sched_barrier(0)
__device__ __forceinline__ void bmask(f32x16&p0,f32x16&p1,int jb,int wid,int mode){
  const float NEG=-INFINITY; bool m0,m1;
  if(mode==0){ m0=jb>(wid>>1); m1=m0; } else { m0=(jb==3); m1=(jb>=2); }
  if(m0){
    #pragma unroll
    for(int r=0;r<16;++r)p0[r]=NEG; }
  if(m1){
    #pragma unroll
    for(int r=0;r<16;++r)p1[r]=NEG; }
}

constexpr int NSLOT=3, SLOTB=8192;
constexpr int LDS_K=0, LDS_V=NSLOT*SLOTB, LDS_WS=3*NSLOT*SLOTB, LDS_OST=LDS_WS+NW*64*4, LDS_BYTES=LDS_OST+NW*4096;
constexpr float C2=0.125f*1.4426950408889634f;
__device__ __forceinline__ void glds16(const void*gsrc,unsigned lds_dst){unsigned keep;
  asm volatile("s_mov_b32 %0, m0\n\ts_mov_b32 m0, %2\n\ts_nop 0\n\tglobal_load_lds_dwordx4 %1, off\n\ts_mov_b32 m0, %0":"=&s"(keep):"v"(gsrc),"s"(lds_dst):"memory");}
__device__ __forceinline__ float max3f(float a,float b,float c){float r;asm("v_max3_f32 %0, %1, %2, %3":"=v"(r):"v"(a),"v"(b),"v"(c));return r;}
__device__ __forceinline__ float max2f(float a,float b){float r;asm("v_max_f32_e32 %0, %1, %2":"=v"(r):"v"(a),"v"(b));return r;}
__device__ __forceinline__ float fadd_s(float a,float b){float r;asm("v_add_f32_e32 %0, %1, %2":"=v"(r):"v"(a),"v"(b));return r;}
__device__ __forceinline__ float fsub_s(float a,float b){float r;asm("v_sub_f32_e32 %0, %1, %2":"=v"(r):"v"(a),"v"(b));return r;}
typedef float f32x2_t __attribute__((ext_vector_type(2))); typedef __bf16 bf16x2_t __attribute__((ext_vector_type(2)));
__device__ __forceinline__ unsigned cvtpk_s(float lo,float hi){f32x2_t v={lo,hi};bf16x2_t b=__builtin_convertvector(v,bf16x2_t);return __builtin_bit_cast(unsigned,b);}
#define WAIT_BAR(N) asm volatile("s_waitcnt vmcnt(" #N ") lgkmcnt(0)\n\ts_barrier":::"memory")

__device__ __forceinline__ void qkt(f32x16&p0,f32x16&p1,const char*Kslot,const bf16x8*qr,const f32x16&negm,int r32,int hi){
  const char*kb=Kslot+hi*1024+r32*16;
  #pragma unroll
  for(int d0=0;d0<4;++d0){
    const bf16x8 b0=*reinterpret_cast<const bf16x8*>(kb+d0*2048);
    const bf16x8 b1=*reinterpret_cast<const bf16x8*>(kb+d0*2048+512);
    if(d0==0){p0=__builtin_amdgcn_mfma_f32_32x32x16_bf16(b0,qr[0],negm,0,0,0);p1=__builtin_amdgcn_mfma_f32_32x32x16_bf16(b1,qr[0],negm,0,0,0);}
    else{p0=__builtin_amdgcn_mfma_f32_32x32x16_bf16(b0,qr[d0],p0,0,0,0);p1=__builtin_amdgcn_mfma_f32_32x32x16_bf16(b1,qr[d0],p1,0,0,0);}}
}
typedef __attribute__((address_space(3))) const char* lds_cptr;
typedef short v4i16_t __attribute__((ext_vector_type(4)));
__device__ __forceinline__ void kload8(bf16x8*kf,lds_cptr kp){
  kf[0]=*(const __attribute__((address_space(3))) bf16x8*)(kp);      kf[1]=*(const __attribute__((address_space(3))) bf16x8*)(kp+512);
  kf[2]=*(const __attribute__((address_space(3))) bf16x8*)(kp+2048); kf[3]=*(const __attribute__((address_space(3))) bf16x8*)(kp+2560);
  kf[4]=*(const __attribute__((address_space(3))) bf16x8*)(kp+4096); kf[5]=*(const __attribute__((address_space(3))) bf16x8*)(kp+4608);
  kf[6]=*(const __attribute__((address_space(3))) bf16x8*)(kp+6144); kf[7]=*(const __attribute__((address_space(3))) bf16x8*)(kp+6656);
}
__device__ __forceinline__ void kload2(bf16x8*kf,lds_cptr kp,int j){ kf[2*j]=*(const __attribute__((address_space(3))) bf16x8*)(kp+j*2048); kf[2*j+1]=*(const __attribute__((address_space(3))) bf16x8*)(kp+j*2048+512); }
__device__ __forceinline__ s16x4 vtr(lds_cptr p){ return __builtin_bit_cast(s16x4,__builtin_amdgcn_ds_read_tr16_b64_v4i16((__attribute__((address_space(3))) v4i16_t*)p)); }
__device__ __forceinline__ float rowmax(const f32x16&p0,const f32x16&p1){
  float a=max3f(p0[0],p0[1],p1[0]),b=max3f(p0[2],p0[3],p1[1]);a=max3f(a,p1[2],p1[3]);
  #pragma unroll
  for(int r=4;r<16;r+=4){a=max3f(a,p0[r],p0[r+1]);b=max3f(b,p0[r+2],p0[r+3]);a=max3f(a,p1[r],p1[r+1]);b=max3f(b,p1[r+2],p1[r+3]);}
  const float m=max2f(a,b);
  auto rr=__builtin_amdgcn_permlane32_swap(__float_as_uint(m),__float_as_uint(m),false,false);
  return max2f(__uint_as_float(rr[0]),__uint_as_float(rr[1]));
}
__device__ __forceinline__ void pv(f32x16*o,int vb,bf16x8 pa0,bf16x8 pa1,bf16x8 pa2,bf16x8 pa3){
  #pragma unroll
  for(int d0=0;d0<4;++d0){s16x4 lo[4],hi[4];
    #pragma unroll
    for(int ks=0;ks<4;++ks){
      asm volatile("ds_read_b64_tr_b16 %0,%1 offset:%c2":"=&v"(lo[ks]):"v"(vb),"i"(d0*4096+ks*1024):"memory");
      asm volatile("ds_read_b64_tr_b16 %0,%1 offset:%c2":"=&v"(hi[ks]):"v"(vb),"i"(d0*4096+ks*1024+512):"memory");}
    asm volatile("s_waitcnt lgkmcnt(0)":::"memory");SBAR();
    #define PK(k) (bf16x8){lo[k][0],lo[k][1],lo[k][2],lo[k][3],hi[k][0],hi[k][1],hi[k][2],hi[k][3]}
    o[d0]=__builtin_amdgcn_mfma_f32_32x32x16_bf16(pa0,PK(0),o[d0],0,0,0);
    o[d0]=__builtin_amdgcn_mfma_f32_32x32x16_bf16(pa1,PK(1),o[d0],0,0,0);
    o[d0]=__builtin_amdgcn_mfma_f32_32x32x16_bf16(pa2,PK(2),o[d0],0,0,0);
    o[d0]=__builtin_amdgcn_mfma_f32_32x32x16_bf16(pa3,PK(3),o[d0],0,0,0);
    #undef PK
  }
}

#ifndef ATTN_STORE16
#define ATTN_STORE16(p,v) (*(u32x4*)(p)=(v))
#endif

using f32x4=__attribute__((ext_vector_type(4)))float;
struct PChunk { f32x4 a, b; };
__device__ __forceinline__ void pchunk_geom(int id, int tk, int tv, int NT, bool& isk, bool& valid, int& kr, int& col, int& ldsoff) {
  isk = id < 512; const int v = id - 512;
  const int g = id & 7, rest = id >> 3, kc = (rest & 1) * 4 + (g & 3), krow = (rest >> 1) * 2 + (g >> 2);
  const int pc = v >> 6, ln = v & 63, vrow = 16 * (pc & 3) + (ln >> 2), vcol = (pc >> 2) * 32 + (ln & 3) * 8;
  const int tile = isk ? tk : tv, row = isk ? krow : vrow; col = isk ? kc * 8 : vcol;
  valid = (tile >= 0) && (tile < NT) && (id < 1536);
  kr = tile * 64 + row;
  const int slot = (tile + 3) % 3;
  ldsoff = isk ? LDS_K + slot * SLOTB + kc * 1024 + krow * 16 : LDS_V + slot * 2 * SLOTB + v * 16;
}
__device__ __forceinline__ PChunk pchunk_load(int id, int tk, int tv, int NT, const float* Kc, const float* Vc, const bf16* Kn, const bf16* Vn) {
  bool isk, valid; int kr, col, ldsoff; pchunk_geom(id, tk, tv, NT, isk, valid, kr, col, ldsoff);
  const char* pf = (const char*)((isk ? Kc : Vc) + (long)kr * 1024 + col);
  const char* pb = (const char*)((isk ? Kn : Vn) + (long)kr * 1024 + col);
  const char* p = (!valid || kr >= 4096 + 32) ? (const char*)Kc : (kr < 4096 ? pf : pb);
  PChunk c; c.a = *(const f32x4*)p; c.b = *(const f32x4*)(p + 16); return c;
}
__device__ __forceinline__ void pchunk_store(const PChunk& c, int id, int tk, int tv, int NT, char* shm) {
  bool isk, valid; int kr, col, ldsoff; pchunk_geom(id, tk, tv, NT, isk, valid, kr, col, ldsoff);
  u32x4 w; w.x = cvtpk_s(c.a[0], c.a[1]); w.y = cvtpk_s(c.a[2], c.a[3]); w.z = cvtpk_s(c.b[0], c.b[1]); w.w = cvtpk_s(c.b[2], c.b[3]);
  const u32x4 raw = __builtin_bit_cast(u32x4, c.a);
  const bool isnew = kr >= 4096 && kr < 4096 + 32, zero = kr >= 4096 + 32;
  w.x = zero ? 0u : isnew ? raw.x : w.x; w.y = zero ? 0u : isnew ? raw.y : w.y; w.z = zero ? 0u : isnew ? raw.z : w.z; w.w = zero ? 0u : isnew ? raw.w : w.w;
  if (valid) *(__attribute__((address_space(3))) u32x4*)((lds_cptr)shm + ldsoff) = w;
}
#define PBAR() asm volatile("s_waitcnt lgkmcnt(0)\n\ts_barrier":::"memory")
__device__ __forceinline__ void sample_producer(const int NT, const float* Kc, const float* Vc, const bf16* Kn, const bf16* Vn, char* shm, int wid, int lane) {
  const int p = (wid - 1) * 64 + lane;
  PChunk a0, a1, a2, a3, b0, b1, b2, b3, c0, c1, c2, c3;
  #define PLOAD(X,tk,tv) do{ X##0=pchunk_load(p,tk,tv,NT,Kc,Vc,Kn,Vn); X##1=pchunk_load(p+448,tk,tv,NT,Kc,Vc,Kn,Vn); X##2=pchunk_load(p+896,tk,tv,NT,Kc,Vc,Kn,Vn); X##3=pchunk_load(p+1344,tk,tv,NT,Kc,Vc,Kn,Vn); }while(0)
  #define PSTORE(X,tk,tv) do{ pchunk_store(X##0,p,tk,tv,NT,shm); pchunk_store(X##1,p+448,tk,tv,NT,shm); pchunk_store(X##2,p+896,tk,tv,NT,shm); pchunk_store(X##3,p+1344,tk,tv,NT,shm); }while(0)
  #define PSTEP(X,s) do{ PSTORE(X,(s)+3,(s)+1); PLOAD(X,(s)+6,(s)+4); PBAR(); }while(0)
  PLOAD(a,0,-1); PLOAD(b,1,0); PLOAD(c,2,-1);
  PSTORE(a,0,-1); PBAR();
  PLOAD(a,3,1);
  PSTORE(b,1,0); PSTORE(c,2,-1); PBAR();
  PLOAD(b,4,2); PLOAD(c,5,3);
  PSTORE(a,3,1); PLOAD(a,6,4); PBAR();
  int s = 1;
  for (; s + 2 <= NT - 2; s += 3) { PSTEP(b, s); PSTEP(c, s + 1); PSTEP(a, s + 2); }
  if (s <= NT - 2) { PSTEP(b, s); ++s; }
  if (s <= NT - 2) { PSTEP(c, s); ++s; }
  PBAR();
  #undef PLOAD
  #undef PSTORE
  #undef PSTEP
}
#undef PBAR
template<int THRL> __device__ __forceinline__ void attn_unit(const int mode,const int NT,const bf16*Qw0,const bf16*__restrict__ Kh,const bf16*__restrict__ Vh,bf16*Ow0,char*shm,const float*Kc,const float*Vc,const int tid_in,const bool pre,const bool pfN,const bf16*KhN,const bf16*VhN){
  int tid0_=tid_in; asm volatile("":"+v"(tid0_));
  const int tid=tid0_,lane=tid&63,r32=lane&31,hi=lane>>5; const int wid=__builtin_amdgcn_readfirstlane(tid>>6);
  const bf16*Qw=Qw0+(long)wid*QBLK*DM; const bool qvalid=(mode==0)||(wid==0); const bool dma=(mode==0);
  if(mode==1&&wid!=0){ sample_producer(NT,Kc,Vc,Kh,Vh,shm,wid,lane); return; }
  const unsigned lds0=(unsigned)(uintptr_t)shm;
  float*wsf=(float*)(shm+LDS_WS)+wid*64;
  const bf16*ksrc=Kh+wid*512+lane*8;
  const bf16*vsrc=Vh+(wid>>2)*2048+(wid&3)*512+lane*8;
  const unsigned kdst=lds0+LDS_K+wid*1024, vdst=lds0+LDS_V+wid*1024;
  #define DMA_K(t,slot) if(dma)glds16(ksrc+(long)(t)*4096,(unsigned)__builtin_amdgcn_readfirstlane(kdst+(slot)))
  #define DMA_V(t,slot) if(dma)do{ glds16(vsrc+(long)(t)*8192,(unsigned)__builtin_amdgcn_readfirstlane(vdst+2*(slot))); glds16(vsrc+(long)(t)*8192+4096,(unsigned)__builtin_amdgcn_readfirstlane(vdst+2*(slot)+8192)); }while(0)
  const int vb0=(int)(lds0+LDS_V)+((lane>>4)&1)*32+(lane&3)*8+(4*hi+((lane&15)>>2))*64;
  const char*Kbase=shm+LDS_K; bf16x8 kf[8];
  const lds_cptr shm3=(lds_cptr)shm; const lds_cptr kp0=shm3+LDS_K+hi*1024+r32*16; const lds_cptr vp0=shm3+LDS_V+((lane>>4)&1)*32+(lane&3)*8+(4*hi+((lane&15)>>2))*64;
  if(!pre){DMA_K(0,0);DMA_V(0,0);DMA_K(1,SLOTB);}
  bf16x8 qr[4];
  #pragma unroll
  for(int d0=0;d0<4;++d0){ if(qvalid)qr[d0]=*reinterpret_cast<const bf16x8*>(&Qw[(long)r32*DM+d0*16+hi*8]); else qr[d0]=bf16x8{}; }
  const lds_cptr qls=(lds_cptr)shm+LDS_OST+wid*4096+lane*16;
  #pragma unroll
  for(int d0=0;d0<4;++d0)*(__attribute__((address_space(3))) bf16x8*)((lds_cptr)qls+d0*1024)=qr[d0];
  #define QLD(d) (*(const __attribute__((address_space(3))) bf16x8*)(qls+(d)*1024))
  bf16x8 qa=qr[0],qb;
  float mhat=0.f,l_reg=0.f;f32x16 o[4];o[0]=f32x16{};o[1]=f32x16{};o[2]=f32x16{};o[3]=f32x16{};f32x16 negm=f32x16{};asm volatile("":"+v"(negm));
  #define CMASK(P0,P1,t) do{int jb_=(t)-(NT-4); if(jb_>=0)bmask(P0,P1,jb_,wid,mode);}while(0)
  bool resc=false;
  #define START(P0,P1) do{ const float rm=rowmax(P0,P1); resc=false; \
    { const float dl=rm; mhat=fadd_s(mhat,dl); \
      _Pragma("unroll") for(int r=0;r<16;++r){P0[r]=fsub_s(P0[r],dl);P1[r]=fsub_s(P1[r],dl);} \
      _Pragma("unroll") for(int r=0;r<16;++r)negm[r]=-mhat; asm volatile("":"+v"(negm)); } \
    _Pragma("unroll") for(int r=0;r<16;++r)P0[r]=__builtin_amdgcn_exp2f(P0[r]); }while(0)
  #define RESC() do{ if(resc){ asm volatile("s_waitcnt lgkmcnt(0)":::"memory"); \
      _Pragma("unroll") for(int d_=0;d_<4;++d_) _Pragma("unroll") for(int r=0;r<16;++r)o[d_][r]*=wsf[crow(r,hi)]; } }while(0)
  f32x16 pA0,pA1,pB0,pB1;
  int sl_prev=0,sl_cur=0,sl_next=SLOTB;
  #define ROT() do{sl_prev=sl_cur;sl_cur=sl_next;sl_next=(sl_next==(NSLOT-1)*SLOTB)?0:sl_next+SLOTB;}while(0)
  DMA_K(2,2*SLOTB);
  WAIT_BAR(4);
  qkt(pA0,pA1,Kbase,qr,negm,r32,hi);asm volatile("s_nop 15\n\ts_nop 7":"+v"(pA0),"+v"(pA1));CMASK(pA0,pA1,0);
  START(pA0,pA1);
  _Pragma("unroll") for(int r=0;r<16;++r)pA1[r]=__builtin_amdgcn_exp2f(pA1[r]);
  WAIT_BAR(0);
  DMA_K(3,0);DMA_V(1,SLOTB);
  ROT();
  kload8(kf,kp0+sl_cur);
  WAIT_BAR(3);
  s16x4 vlo[8],vhi[8]; u32x4 pw0,pw1,pw2,pw3;
  #define PKW(P,B) cvtpk_s(P[B],P[B+1])
  #define PAF(k) __builtin_bit_cast(bf16x8,pw##k)
  #define VFR(i) (bf16x8){vlo[i][0],vlo[i][1],vlo[i][2],vlo[i][3],vhi[i][0],vhi[i][1],vhi[i][2],vhi[i][3]}
  #define PIN(x) asm volatile("":"+v"(x))
  #define MX3(a,b,c) __builtin_fmaxf(__builtin_fmaxf((a),(b)),(c))
  #define GAPA(MF,A0,A1,A2,A3,W0,W1,PW) do{ MF; sacc+=A0; sacc+=A1; sacc+=A2; sacc+=A3; PIN(sacc); W0; W1; PIN(PW); SBAR(); }while(0)
  #define EX(v) __builtin_amdgcn_exp2f(v)
  #define GAPB(MF,X,B) do{ MF; X[B]=EX(X[B]); X[B+1]=EX(X[B+1]); X[B+2]=EX(X[B+2]); X[B+3]=EX(X[B+3]); PIN(X); SBAR(); }while(0)
  #define VRD(i) do{ vlo[i]=vtr(vp_+(((i)>>2)*4096+((i)&3)*1024)); vhi[i]=vtr(vp_+(((i)>>2)*4096+((i)&3)*1024+512)); }while(0)
  #define VRD2(s,i) do{ vlo[s]=vtr(vp_+(((i)>>2)*4096+((i)&3)*1024)); vhi[s]=vtr(vp_+(((i)>>2)*4096+((i)&3)*1024+512)); }while(0)
  #define GAPB2(MF,RD,X,B) do{ MF; RD; X[B]=EX(X[B]); X[B+1]=EX(X[B+1]); PIN(X); SBAR(); }while(0)
  #define KRD(G,j) do{ if(G){ kload2(kf,kp0+sl_next,j); SBAR(); } }while(0)
  #define STEP(C0,C1,P0,P1,t,GK,GV,GL) do{ SBAR(); \
    const lds_cptr vp_=vp0+2*sl_prev; \
    qb=QLD(1); VRD(0); SBAR(); float sacc=(P0[0]+P0[1]); \
    GAPA(C0=__builtin_amdgcn_mfma_f32_32x32x16_bf16(kf[0],qa,negm,0,0,0), P0[2],P0[3],P0[4],P0[5],     pw0[0]=PKW(P0,0), pw0[1]=PKW(P0,2), pw0); \
    VRD(4); SBAR(); GAPA(C1=__builtin_amdgcn_mfma_f32_32x32x16_bf16(kf[1],qa,negm,0,0,0), P0[6],P0[7],P0[8],P0[9],     pw0[2]=PKW(P0,4), pw0[3]=PKW(P0,6), pw0); \
    qa=QLD(2); VRD(1); SBAR(); GAPA(C0=__builtin_amdgcn_mfma_f32_32x32x16_bf16(kf[2],qb,C0,0,0,0),   P0[10],P0[11],P0[12],P0[13], pw1[0]=PKW(P0,8), pw1[1]=PKW(P0,10), pw1); \
    VRD(5); SBAR(); GAPA(C1=__builtin_amdgcn_mfma_f32_32x32x16_bf16(kf[3],qb,C1,0,0,0),   P0[14],P0[15],P1[0],P1[1],   pw1[2]=PKW(P0,12),pw1[3]=PKW(P0,14), pw1); \
    qb=QLD(3); VRD(2); SBAR(); GAPA(C0=__builtin_amdgcn_mfma_f32_32x32x16_bf16(kf[4],qa,C0,0,0,0),   P1[2],P1[3],P1[4],P1[5],     pw2[0]=PKW(P1,0), pw2[1]=PKW(P1,2), pw2); \
    VRD(6); SBAR(); GAPA(C1=__builtin_amdgcn_mfma_f32_32x32x16_bf16(kf[5],qa,C1,0,0,0),   P1[6],P1[7],P1[8],P1[9],     pw2[2]=PKW(P1,4), pw2[3]=PKW(P1,6), pw2); \
    VRD(3); SBAR(); GAPA(C0=__builtin_amdgcn_mfma_f32_32x32x16_bf16(kf[6],qb,C0,0,0,0),   P1[10],P1[11],P1[12],P1[13], pw3[0]=PKW(P1,8), pw3[1]=PKW(P1,10), pw3); \
    VRD(7); SBAR(); GAPA(C1=__builtin_amdgcn_mfma_f32_32x32x16_bf16(kf[7],qb,C1,0,0,0),   P1[14],P1[15],0.f,0.f,       pw3[2]=PKW(P1,12),pw3[3]=PKW(P1,14), pw3); \
    l_reg+=sacc; \
    if(GK){DMA_K((t)+3,sl_cur);} if(GV){DMA_V((t)+1,sl_next);} \
    CMASK(C0,C1,t); \
    SBAR(); float mxa_,mxb_,rm_; \
    do{ o[0]=__builtin_amdgcn_mfma_f32_32x32x16_bf16(PAF(0),VFR(0),o[0],0,0,0); VRD2(0,8); mxa_=MX3(C0[0],C0[1],C1[0]); mxb_=MX3(C0[2],C0[3],C1[1]); mxa_=MX3(mxa_,C1[2],C1[3]); mxa_=MX3(mxa_,C0[4],C0[5]); mxb_=MX3(mxb_,C0[6],C0[7]); PIN(mxa_); PIN(mxb_); SBAR(); }while(0); \
    do{ o[1]=__builtin_amdgcn_mfma_f32_32x32x16_bf16(PAF(0),VFR(4),o[1],0,0,0); VRD2(4,12); mxa_=MX3(mxa_,C1[4],C1[5]); mxb_=MX3(mxb_,C1[6],C1[7]); mxa_=MX3(mxa_,C0[8],C0[9]); mxb_=MX3(mxb_,C0[10],C0[11]); PIN(mxa_); PIN(mxb_); SBAR(); }while(0); \
    do{ o[0]=__builtin_amdgcn_mfma_f32_32x32x16_bf16(PAF(1),VFR(1),o[0],0,0,0); VRD2(1,9); mxa_=MX3(mxa_,C1[8],C1[9]); mxb_=MX3(mxb_,C1[10],C1[11]); mxa_=MX3(mxa_,C0[12],C0[13]); mxb_=MX3(mxb_,C0[14],C0[15]); PIN(mxa_); PIN(mxb_); SBAR(); }while(0); \
    do{ o[1]=__builtin_amdgcn_mfma_f32_32x32x16_bf16(PAF(1),VFR(5),o[1],0,0,0); VRD2(5,13); mxa_=MX3(mxa_,C1[12],C1[13]); mxb_=MX3(mxb_,C1[14],C1[15]); rm_=__builtin_fmaxf(mxa_,mxb_); { auto rr=__builtin_amdgcn_permlane32_swap(__float_as_uint(rm_),__float_as_uint(rm_),false,false); rm_=__builtin_fmaxf(__uint_as_float(rr[0]),__uint_as_float(rr[1])); } PIN(mxa_); PIN(mxb_); SBAR(); }while(0); \
    resc=false; \
    if(__builtin_expect(__any(rm_>(float)THRL),0)){ const float dl=__builtin_fmaxf(rm_,0.f); mhat+=dl; \
      _Pragma("unroll") for(int r=0;r<16;++r){C0[r]-=dl;C1[r]-=dl;} \
      _Pragma("unroll") for(int r=0;r<16;++r)negm[r]=-mhat; asm volatile("":"+v"(negm)); \
      const float f=__builtin_amdgcn_exp2f(-dl); l_reg*=f; if(hi==0)wsf[r32]=f; resc=true; } \
    SBAR(); \
    do{ o[0]=__builtin_amdgcn_mfma_f32_32x32x16_bf16(PAF(2),VFR(2),o[0],0,0,0); VRD2(2,10); C0[0]=EX(C0[0]); C0[1]=EX(C0[1]); PIN(C0); SBAR(); }while(0); \
    do{ o[1]=__builtin_amdgcn_mfma_f32_32x32x16_bf16(PAF(2),VFR(6),o[1],0,0,0); VRD2(6,14); C0[2]=EX(C0[2]); C0[3]=EX(C0[3]); PIN(C0); SBAR(); }while(0); \
    do{ o[0]=__builtin_amdgcn_mfma_f32_32x32x16_bf16(PAF(3),VFR(3),o[0],0,0,0); VRD2(3,11); C0[4]=EX(C0[4]); C0[5]=EX(C0[5]); PIN(C0); SBAR(); }while(0); \
    do{ o[1]=__builtin_amdgcn_mfma_f32_32x32x16_bf16(PAF(3),VFR(7),o[1],0,0,0); VRD2(7,15); C0[6]=EX(C0[6]); C0[7]=EX(C0[7]); PIN(C0); SBAR(); }while(0); \
    do{ o[2]=__builtin_amdgcn_mfma_f32_32x32x16_bf16(PAF(0),VFR(0),o[2],0,0,0); (void)0; C0[8]=EX(C0[8]); C0[9]=EX(C0[9]); C0[10]=EX(C0[10]); C0[11]=EX(C0[11]); PIN(C0); SBAR(); }while(0); \
    KRD(GL,0); do{ o[3]=__builtin_amdgcn_mfma_f32_32x32x16_bf16(PAF(0),VFR(4),o[3],0,0,0); (void)0; C0[12]=EX(C0[12]); C0[13]=EX(C0[13]); PIN(C0); SBAR(); }while(0); \
    KRD(GL,1); do{ o[2]=__builtin_amdgcn_mfma_f32_32x32x16_bf16(PAF(1),VFR(1),o[2],0,0,0); (void)0; C0[14]=EX(C0[14]); C0[15]=EX(C0[15]); PIN(C0); SBAR(); }while(0); \
    KRD(GL,2); do{ o[3]=__builtin_amdgcn_mfma_f32_32x32x16_bf16(PAF(1),VFR(5),o[3],0,0,0); (void)0; C1[0]=EX(C1[0]); C1[1]=EX(C1[1]); PIN(C1); SBAR(); }while(0); \
    KRD(GL,3); do{ o[2]=__builtin_amdgcn_mfma_f32_32x32x16_bf16(PAF(2),VFR(2),o[2],0,0,0); (void)0; C1[2]=EX(C1[2]); C1[3]=EX(C1[3]); PIN(C1); SBAR(); }while(0); \
    do{ o[3]=__builtin_amdgcn_mfma_f32_32x32x16_bf16(PAF(2),VFR(6),o[3],0,0,0); (void)0; C1[4]=EX(C1[4]); C1[5]=EX(C1[5]); C1[6]=EX(C1[6]); C1[7]=EX(C1[7]); PIN(C1); SBAR(); }while(0); \
    do{ o[2]=__builtin_amdgcn_mfma_f32_32x32x16_bf16(PAF(3),VFR(3),o[2],0,0,0); (void)0; C1[8]=EX(C1[8]); C1[9]=EX(C1[9]); C1[10]=EX(C1[10]); C1[11]=EX(C1[11]); PIN(C1); SBAR(); }while(0); \
    do{ o[3]=__builtin_amdgcn_mfma_f32_32x32x16_bf16(PAF(3),VFR(7),o[3],0,0,0); qa=QLD(0); C1[12]=EX(C1[12]); C1[13]=EX(C1[13]); C1[14]=EX(C1[14]); C1[15]=EX(C1[15]); PIN(C1); SBAR(); }while(0); \
    }while(0)
  int t=1;
  #undef CMASK
  #define CMASK(P0,P1,t) do{}while(0)
  for(;t+5<NT;t+=2){
    STEP(pB0,pB1,pA0,pA1,t,true,true,true);     WAIT_BAR(3); RESC(); ROT();
    STEP(pA0,pA1,pB0,pB1,t+1,true,true,true);   WAIT_BAR(3); RESC(); ROT();
  }
  #undef CMASK
  #define CMASK(P0,P1,t) do{int jb_=(t)-(NT-4); if(jb_>=0)bmask(P0,P1,jb_,wid,mode);}while(0)
  #define ENDW(tt) do{ if((tt)+3<NT){WAIT_BAR(3);} else if((tt)+2<NT){WAIT_BAR(2);} else {WAIT_BAR(0);} }while(0)
  for(;t+1<NT;t+=2){
    STEP(pB0,pB1,pA0,pA1,t,(t+3<NT),(t+1<NT),(t+1<NT));       ENDW(t);   RESC(); ROT();
    STEP(pA0,pA1,pB0,pB1,t+1,(t+4<NT),(t+2<NT),(t+2<NT));     ENDW(t+1); RESC(); ROT();
  }
  STEP(pB0,pB1,pA0,pA1,NT-1,false,false,false); RESC();
  { float sacc=pB0[0]+pB0[1]; _Pragma("unroll") for(int r=2;r<16;++r)sacc+=pB0[r]; _Pragma("unroll") for(int r=0;r<16;++r)sacc+=pB1[r]; l_reg+=sacc;
    pw0=(u32x4){PKW(pB0,0),PKW(pB0,2),PKW(pB0,4),PKW(pB0,6)};pw1=(u32x4){PKW(pB0,8),PKW(pB0,10),PKW(pB0,12),PKW(pB0,14)};pw2=(u32x4){PKW(pB1,0),PKW(pB1,2),PKW(pB1,4),PKW(pB1,6)};pw3=(u32x4){PKW(pB1,8),PKW(pB1,10),PKW(pB1,12),PKW(pB1,14)};
    SBAR(); pv(o,vb0+2*sl_cur,PAF(0),PAF(1),PAF(2),PAF(3)); }
  asm volatile("s_waitcnt lgkmcnt(0)\n\ts_barrier":::"memory");
  if(pfN){ const bf16*kn=KhN+wid*512+lane*8; const bf16*vn=VhN+(wid>>2)*2048+(wid&3)*512+lane*8;
    glds16(kn,(unsigned)__builtin_amdgcn_readfirstlane(kdst)); glds16(vn,(unsigned)__builtin_amdgcn_readfirstlane(vdst)); glds16(vn+4096,(unsigned)__builtin_amdgcn_readfirstlane(vdst+8192)); glds16(kn+4096,(unsigned)__builtin_amdgcn_readfirstlane(kdst+SLOTB)); }
  #undef PKW
  #undef PAF
  #undef VFR
  #undef PIN
  #undef MX3
  #undef GAPA
  #undef GAPB
  #undef EX
  #undef VRD
  #undef VRD2
  #undef QLD
  #undef GAPB2
  #undef KRD
  #undef STEP
  #undef ENDW
  {auto rr=__builtin_amdgcn_permlane32_swap(__float_as_uint(l_reg),__float_as_uint(l_reg),false,false);l_reg=__uint_as_float(rr[0])+__uint_as_float(rr[1]);}
  if(hi==0)wsf[32+r32]=l_reg;asm volatile("s_waitcnt lgkmcnt(0)":::"memory");
  float rli[16];
  #pragma unroll
  for(int r=0;r<16;++r)rli[r]=__builtin_amdgcn_rcpf(wsf[32+crow(r,hi)]);
  bf16*Ow=Ow0+(long)wid*QBLK*OPITCH;
  { bf16*stg=(bf16*)(shm+LDS_OST)+wid*2048;
    #pragma unroll
    for(int hp=0;hp<2;++hp){
      #pragma unroll
      for(int r=0;r<16;++r){const int orow=crow(r,hi);
        #pragma unroll
        for(int d0=0;d0<2;++d0)stg[orow*64+d0*32+r32]=__float2bfloat16(o[2*hp+d0][r]*rli[r]);}
      asm volatile("s_waitcnt lgkmcnt(0)":::"memory");
      #pragma unroll
      for(int i=0;i<4;++i){const int row=i*8+(lane>>3),ch=lane&7; const u32x4 v=*(const u32x4*)(stg+row*64+ch*8); if(qvalid)ATTN_STORE16(Ow+(long)row*OPITCH+hp*64+ch*8,v);}
      asm volatile("s_waitcnt lgkmcnt(0)":::"memory"); } }
  asm volatile("s_waitcnt lgkmcnt(0)":::"memory");
  #undef DMA_K
  #undef DMA_V
  #undef CMASK
  #undef START
  #undef RESC
  #undef ROT
}
constexpr int ATTN_LDS_BYTES=LDS_BYTES;
#undef SBAR
#undef WAIT_BAR
}

constexpr int NWAVES = 8;
constexpr int PH_PER_LAYER = 11, NPH = 1 + DEPTH * PH_PER_LAYER;
enum { P_WIN = 0, P_MIXA, P_ATTN, P_MIXC, P_PG, P_MERGE, P_OUT, P_LN1, P_UP, P_DOWN, P_LN2 };

constexpr int CW_TMO = 0, CW_CODE = 1, CW_BAR = 4096;

constexpr int RING_OFF = 0, RING_BYTES = 131072;
constexpr int LDSCTL_OFF = RING_BYTES, MISC_OFF = LDSCTL_OFF + 320;
constexpr int LDS_BYTES = 147456;
static_assert(MISC_OFF + 128 <= LDS_BYTES, "LDS map");

#define GAS __attribute__((address_space(1)))
#define LAS __attribute__((address_space(3)))
typedef unsigned short bf16;
typedef unsigned v4u __attribute__((ext_vector_type(4)));
typedef float f32x4 __attribute__((ext_vector_type(4)));
typedef float f32x16 __attribute__((ext_vector_type(16)));
typedef short bf16x8 __attribute__((ext_vector_type(8)));
typedef GAS unsigned gu32;
#define RLX_AGENT __ATOMIC_RELAXED, __HIP_MEMORY_SCOPE_AGENT
#define LDS_WAIT() asm volatile("s_waitcnt lgkmcnt(0)" ::: "memory")
#define VM_WAIT() asm volatile("s_waitcnt vmcnt(0)" ::: "memory")
__device__ __forceinline__ unsigned f2bf(float f) { unsigned u = __builtin_bit_cast(unsigned, f); return (u + 0x7fffu + ((u >> 16) & 1u)) >> 16; }
__device__ __forceinline__ unsigned pk2(float lo, float hi) { return f2bf(lo) | (f2bf(hi) << 16); }
typedef float pk_f2_t __attribute__((ext_vector_type(2))); typedef __bf16 pk_b2_t __attribute__((ext_vector_type(2)));
__device__ __forceinline__ unsigned pk2hw(float lo, float hi) { const pk_f2_t v = {lo, hi}; const pk_b2_t b = __builtin_convertvector(v, pk_b2_t); return __builtin_bit_cast(unsigned, b); }
__device__ __forceinline__ float bfl(unsigned w) { return __uint_as_float(w << 16); }
__device__ __forceinline__ float bfh(unsigned w) { return __uint_as_float(w & 0xffff0000u); }

#define XB_TMO      128
#define XB_XCNT(j)  (256  + 64 * (j))
#define XB_XSUB(j)  (1280 + 64 * (j))
#define XB_XGEN(j)  (2304 + 64 * (j))
#define XB_TOP      3328
#define XB_TOPGEN   3392
#define XCD_BAR_WORDS 3456
#define XB_SPIN_CAP (1u << 18)

__device__ __forceinline__ unsigned xb_ld(unsigned* p)              { return __hip_atomic_load(p, __ATOMIC_RELAXED, __HIP_MEMORY_SCOPE_AGENT); }
__device__ __forceinline__ unsigned xb_add(unsigned* p, unsigned v) { return __hip_atomic_fetch_add(p, v, __ATOMIC_RELAXED, __HIP_MEMORY_SCOPE_AGENT); }
__device__ __forceinline__ unsigned xb_xcc_id() { return (unsigned)__builtin_amdgcn_s_getreg((3 << 11) | 20) & 0xFu; }
#define XB_SPIN(cond, bar) do { unsigned _sp = 0; while (cond) { __builtin_amdgcn_s_sleep(1); \
    if ((++_sp & 255u) == 0u) { if (xb_ld(&(bar)[XB_TMO])) break; if (_sp > XB_SPIN_CAP) { atomicAdd(&(bar)[XB_TMO], 1u); break; } } } } while (0)

struct XcdBarrier {
    unsigned* bar; unsigned x; int tid;
    volatile LAS unsigned* st;
};

__device__ __forceinline__ XcdBarrier xcd_barrier_post(unsigned* bar, volatile LAS unsigned* st) {
    XcdBarrier b; b.bar = bar; b.x = xb_xcc_id(); b.st = st; b.tid = 0;
    if (threadIdx.x == 0) (void)xb_add(&bar[XB_XCNT(b.x)], 1u);
    return b;
}
__device__ __forceinline__ void xcd_barrier_complete(unsigned* bar, unsigned x, unsigned& nloc, unsigned& nx) {
    const unsigned G = gridDim.x * gridDim.y * gridDim.z;
    unsigned sum, cnt, mine, sp = 0u;
    for (;;) {
        sum = 0u; cnt = 0u; mine = 0u;
#pragma unroll
        for (unsigned j = 0; j < 16; ++j) { const unsigned c = xb_ld(&bar[XB_XCNT(j)]); sum += c; cnt += (c > 0u) ? 1u : 0u; mine = (j == x) ? c : mine; }
        if (sum == G) break;
        __builtin_amdgcn_s_sleep(1);
        if ((++sp & 255u) == 0u) { if (xb_ld(&bar[XB_TMO])) break; if (sp > XB_SPIN_CAP) { atomicAdd(&bar[XB_TMO], 1u); break; } }
    }
    nloc = mine > 0u ? mine : 1u; nx = cnt > 0u ? cnt : 1u;
}

__device__ __forceinline__ void xcd_barrier(const XcdBarrier& b) {
    asm volatile("s_waitcnt vmcnt(0)" ::: "memory");
    __syncthreads();
    if (b.tid == 0) {
        unsigned* bar = b.bar;
        __builtin_amdgcn_s_waitcnt(0);
        unsigned nloc = b.st[0], nx = b.st[1];
        if (nloc == 0u) { xcd_barrier_complete(bar, b.x, nloc, nx); b.st[0] = nloc; b.st[1] = nx; }
        const unsigned old = xb_add(&bar[XB_XSUB(b.x)], 1u);
        const unsigned gen = old / nloc;
        if (old + 1u == (gen + 1u) * nloc) {
            __builtin_amdgcn_fence(__ATOMIC_RELEASE, "agent");
            asm volatile("s_waitcnt vmcnt(0)" ::: "memory");
            const unsigned og = xb_add(&bar[XB_TOP], 1u);
            const unsigned tg = og / nx;
            if (og + 1u == (tg + 1u) * nx) xb_add(&bar[XB_TOPGEN], 1u);
            else XB_SPIN(xb_ld(&bar[XB_TOPGEN]) == tg, bar);
            __builtin_amdgcn_fence(__ATOMIC_ACQUIRE, "agent");
            xb_add(&bar[XB_XGEN(b.x)], 1u);
            asm volatile("s_waitcnt vmcnt(0)" ::: "memory");
        } else {
            XB_SPIN(xb_ld(&bar[XB_XGEN(b.x)]) == gen, bar);
            __builtin_amdgcn_fence(__ATOMIC_ACQUIRE, "agent");
            asm volatile("s_waitcnt vmcnt(0)" ::: "memory");
        }
    }
    __syncthreads();
}

struct Args { const float* in[35]; float* out; unsigned char* ws; int ph_lo, ph_hi, li, pad; };
struct Frame {
    LAS unsigned char* lds;
    volatile LAS unsigned* MISC;
    gu32* ctl;
    int tid, lane, wave;
    int vcu, G;
    float* out;
    unsigned char* ws;
};
__device__ __forceinline__ float wave_sum(float v) {
    v += swz_xor<1>(v); v += swz_xor<2>(v); v += swz_xor<4>(v); v += swz_xor<8>(v); v += swz_xor<16>(v);
    { auto rr = __builtin_amdgcn_permlane32_swap(__float_as_uint(v), __float_as_uint(v), false, false); v = __uint_as_float(rr[0]) + __uint_as_float(rr[1]); }
    return v;
}
__device__ __forceinline__ void p0_transpose_item(const float* W, int K, int N, bf16* WT, int row_off, LAS float* scr, int item, int lane) {
    const int nblk = N / 32, kb = item / nblk, nb = item % nblk, k0 = 64 * kb, n0 = 32 * nb;
#pragma unroll 8
    for (int i = 0; i < 32; ++i) { const int kk = 2 * i + (lane >> 5); scr[kk * 33 + (lane & 31)] = W[(size_t)(k0 + kk) * N + n0 + (lane & 31)]; }
    LDS_WAIT(); asm volatile("" ::: "memory");
    const int c = lane & 7;
#pragma unroll
    for (int j = 0; j < 4; ++j) { const int n = (lane >> 3) + 8 * j; const LAS float* s = scr + (8 * c) * 33 + n;
        v4u o; o.x = pk2(s[0 * 33], s[1 * 33]); o.y = pk2(s[2 * 33], s[3 * 33]); o.z = pk2(s[4 * 33], s[5 * 33]); o.w = pk2(s[6 * 33], s[7 * 33]);
        *(GAS v4u*)(WT + (size_t)(row_off + n0 + n) * K + k0 + 8 * c) = o; }
    LDS_WAIT(); asm volatile("" ::: "memory");
}

__device__ __forceinline__ void p0_transpose64(const float* W, int N, int nblk, bf16* WT, int ldo, int item, int lane) {
    const int kb = item / nblk, nb = item % nblk, k0 = 64 * kb, n0 = 64 * nb, n4 = lane & 15, kq = lane >> 4;
    f32x4 v[16];
#pragma unroll
    for (int j = 0; j < 16; ++j) v[j] = *(const GAS f32x4*)(W + (size_t)(k0 + kq * 16 + j) * N + n0 + 4 * n4);
#pragma unroll
    for (int e = 0; e < 4; ++e) { v4u c0, c1;
        c0.x = pk2hw(v[0][e], v[1][e]); c0.y = pk2hw(v[2][e], v[3][e]); c0.z = pk2hw(v[4][e], v[5][e]); c0.w = pk2hw(v[6][e], v[7][e]);
        c1.x = pk2hw(v[8][e], v[9][e]); c1.y = pk2hw(v[10][e], v[11][e]); c1.z = pk2hw(v[12][e], v[13][e]); c1.w = pk2hw(v[14][e], v[15][e]);
        bf16* o = WT + (size_t)(n0 + 4 * n4 + e) * ldo + k0 + kq * 16; *(GAS v4u*)o = c0; *(GAS v4u*)(o + 8) = c1; }
}

__device__ __forceinline__ void dsincos(double x, double& s, double& c) {
    const double TWO_PI = 6.283185307179586476925287, HALF_PI = 1.570796326794896619231322;
    x -= TWO_PI * __builtin_rint(x * (1.0 / TWO_PI));
    const double kq = __builtin_rint(x * (1.0 / HALF_PI)); const double r = x - kq * HALF_PI; const int k = ((int)kq) & 3; const double r2 = r * r;
    double sp = -1.0 / 1307674368000.0; sp = sp * r2 + 1.0 / 6227020800.0; sp = sp * r2 - 1.0 / 39916800.0; sp = sp * r2 + 1.0 / 362880.0; sp = sp * r2 - 1.0 / 5040.0; sp = sp * r2 + 1.0 / 120.0; sp = sp * r2 - 1.0 / 6.0; sp = sp * r2 * r + r;
    double cp = 1.0 / 20922789888000.0; cp = cp * r2 - 1.0 / 87178291200.0; cp = cp * r2 + 1.0 / 479001600.0; cp = cp * r2 - 1.0 / 3628800.0; cp = cp * r2 + 1.0 / 40320.0; cp = cp * r2 - 1.0 / 720.0; cp = cp * r2 + 1.0 / 24.0; cp = cp * r2 - 0.5; cp = cp * r2 + 1.0;
    s = (k == 0) ? sp : (k == 1) ? cp : (k == 2) ? -sp : -cp;
    c = (k == 0) ? cp : (k == 1) ? -sp : (k == 2) ? -cp : sp;
}
__device__ __forceinline__ double dexp(double x) {
    const double LN2 = 0.693147180559945309417232; const double n = __builtin_rint(x * (1.0 / LN2)); const double r = x - n * LN2;
    double p = 1.0 / 6227020800.0; p = p * r + 1.0 / 479001600.0; p = p * r + 1.0 / 39916800.0; p = p * r + 1.0 / 3628800.0; p = p * r + 1.0 / 362880.0; p = p * r + 1.0 / 40320.0; p = p * r + 1.0 / 5040.0;
    p = p * r + 1.0 / 720.0; p = p * r + 1.0 / 120.0; p = p * r + 1.0 / 24.0; p = p * r + 1.0 / 6.0; p = p * r + 0.5; p = p * r + 1.0; p = p * r + 1.0;
    return __builtin_ldexp(p, (int)n);
}

enum { I_XP = 0, I_XS, I_CK, I_CV, I_SRE, I_SIM, I_SCONV, I_SPOOL, I_WIN, I_POOLW, I_PSCALE, I_ARE, I_AIM, I_LOGDT, I_BRE, I_BIM, I_CRE, I_CIM, I_SD, I_WGLU, I_CONVW, I_CONVB,
       I_LQ1, I_LK1, I_LQ2, I_LK2, I_SUBLN, I_WBR, I_WOUT, I_LN1G, I_LN1B, I_WUP, I_WDN, I_LN2G, I_LN2B };

constexpr int I_IN0 = (DM / 64) * (N_IN / 64);
__device__ __forceinline__ void p0_weights(Frame& F, const Args& A, int first, int last, int wv, int nw) {
    unsigned char* ws = F.ws;
    constexpr int I_IN = (DM / 64) * (N_IN / 64), I_BR = (BR_W / 64) * (DM / 64), I_OUT = (DM / 64) * (DM / 64), I_UP = (DM / 64) * (D_FF / 64), I_DN = (D_FF / 64) * (DM / 64), I_GLU = (512 / 64) * (512 / 64), I_PF = (512 / 8) * (DM / 64);
    constexpr int PER_L = I_IN + I_BR + I_OUT + I_UP + I_DN + I_GLU + I_PF;
    if (last > DEPTH * PER_L) last = DEPTH * PER_L;
    for (int it = first + wv; it < last; it += nw) {
        const int l = it / PER_L; int r = it % PER_L; unsigned char* wl = ws + WS_W + (size_t)l * W_LSTRIDE;
        if (r < I_IN) { p0_transpose64(A.in[I_WIN] + (size_t)l * DM * N_IN, N_IN, N_IN / 64, (bf16*)(wl + W_IN), DM, r, F.lane); continue; } r -= I_IN;
        if (r < I_BR) { if (r >= 8 * (DM / 64)) p0_transpose64(A.in[I_WBR] + (size_t)l * BR_W * DM, DM, DM / 64, (bf16*)(wl + W_BR), BR_W, r, F.lane); continue; } r -= I_BR;
        if (r < I_OUT) { p0_transpose64(A.in[I_WOUT] + (size_t)l * DM * DM, DM, DM / 64, (bf16*)(wl + W_OUT), DM, r, F.lane); continue; } r -= I_OUT;
        if (r < I_UP) { p0_transpose64(A.in[I_WUP] + (size_t)l * DM * D_FF, D_FF, D_FF / 64, (bf16*)(wl + W_UP), DM, r, F.lane); continue; } r -= I_UP;
        if (r < I_DN) { p0_transpose64(A.in[I_WDN] + (size_t)l * D_FF * DM, DM, DM / 64, (bf16*)(wl + W_DN), D_FF, r, F.lane); continue; } r -= I_DN;
        if (r < I_GLU) { p0_transpose64(A.in[I_WGLU] + (size_t)l * 512 * 512, 512, 512 / 64, (bf16*)(wl + W_GLU), 512, r, F.lane); continue; } r -= I_GLU;
        {
            const int k0 = (r >> 4) * 8, d = (r & 15) * 64 + F.lane, g = k0 >> 7;
            const float* pw = A.in[I_POOLW] + (((size_t)l * 4 + g) * 128 + (k0 & 127)) * 128; const float* sc = A.in[I_PSCALE] + (size_t)l * 512 + g * 128; const float* wb = A.in[I_WBR] + ((size_t)l * BR_W + g * 128) * DM + d;
            float acc8[8];
#pragma unroll
            for (int e = 0; e < 8; ++e) acc8[e] = 0.f;
#pragma unroll 1
            for (int jb = 0; jb < 128; jb += 8) {
                float w8[8]; f32x4 s4[2], p4[8][2];
#pragma unroll
                for (int jj = 0; jj < 8; ++jj) w8[jj] = *(const GAS float*)(wb + (size_t)(jb + jj) * DM);
                s4[0] = *(const GAS f32x4*)(sc + jb); s4[1] = *(const GAS f32x4*)(sc + jb + 4);
#pragma unroll
                for (int e = 0; e < 8; ++e) { p4[e][0] = *(const GAS f32x4*)(pw + e * 128 + jb); p4[e][1] = *(const GAS f32x4*)(pw + e * 128 + jb + 4); }
                __builtin_amdgcn_sched_barrier(0);
#pragma unroll
                for (int jj = 0; jj < 8; ++jj) { const float wv = s4[jj >> 2][jj & 3] * w8[jj];
#pragma unroll
                    for (int e = 0; e < 8; ++e) acc8[e] += p4[e][jj >> 2][jj & 3] * wv; }
                __builtin_amdgcn_sched_barrier(0);
            }
            v4u o; o.x = pk2(acc8[0], acc8[1]); o.y = pk2(acc8[2], acc8[3]); o.z = pk2(acc8[4], acc8[5]); o.w = pk2(acc8[6], acc8[7]);
            *(GAS v4u*)((bf16*)(wl + W_BR) + (size_t)d * BR_W + k0) = o; }
    }
}
__device__ __forceinline__ void p0_prologue(Frame& F, const Args& A) {
    LAS float* scr = (LAS float*)(F.lds + RING_OFF + F.wave * 16384);
    const int gw = F.vcu * NWAVES + F.wave, NGW = F.G * NWAVES;
    const int gt = gw * 64 + F.lane, NGT = NGW * 64;
    unsigned char* ws = F.ws;
    p0_weights(F, A, 0, I_IN0, gw, NGW);
    for (int m = gw; m < M_T; m += NGW) {
        const float* xr = m < M_P ? A.in[I_XP] + (size_t)m * DM : A.in[I_XS] + (size_t)(m - M_P) * DM;
        const GAS f32x4* x4 = (const GAS f32x4*)xr + F.lane; GAS unsigned long long* o8 = (GAS unsigned long long*)((bf16*)(ws + WS_XB) + (size_t)m * DM) + F.lane;
        f32x4 v[4];
#pragma unroll
        for (int j = 0; j < 4; ++j) v[j] = x4[64 * j];
#pragma unroll
        for (int j = 0; j < 4; ++j) o8[64 * j] = (unsigned long long)pk2(v[j].x, v[j].y) | ((unsigned long long)pk2(v[j].z, v[j].w) << 32);
    }
    for (int i = gt; i < SEQ * 8; i += NGT) { const int pos = i >> 3, k = i & 7;
        const double inv = dexp(-(double)k * (13.122363377404328 / 8.0)); double s, c; dsincos((double)pos * inv, s, c);
        float* rp = (float*)(ws + WS_ROPE) + (size_t)pos * 16; rp[k] = (float)c; rp[8 + k] = (float)s; }
    for (int i = gt; i < DEPTH * 2048; i += NGT) { const int l = i >> 11, gp = i & 2047, g = gp >> 6, p = gp & 63;
        unsigned char* sc = ws + WS_SSMC + (size_t)l * SSMC_LSTRIDE;
        const double dt = dexp((double)A.in[I_LOGDT][l * 32 + g]), are = (double)A.in[I_ARE][i], aim = (double)A.in[I_AIM][i];
        const double mag = dexp(are * dt); double sn, cs; dsincos(aim * dt, sn, cs);
        const double abr = mag * cs, abi = mag * sn, den = are * are + aim * aim;
        const double cr = ((abr - 1.0) * are + abi * aim) / den, ci = (abi * are - (abr - 1.0) * aim) / den;
        ((float2*)(sc + SC_AB))[gp] = make_float2((float)abr, (float)abi);
        const double m64 = dexp(are * dt * 64.0); double s64, c64; dsincos(aim * dt * 64.0, s64, c64);
        ((float2*)(sc + SC_A64))[gp] = make_float2((float)(m64 * c64), (float)(m64 * s64));
        bf16* BB = (bf16*)(sc + SC_BB) + (size_t)g * 128 * 16;
#pragma unroll 4
        for (int n = 0; n < 16; ++n) { const double bre = (double)A.in[I_BRE][(size_t)i * 16 + n], bim = (double)A.in[I_BIM][(size_t)i * 16 + n];
            BB[p * 16 + n] = (bf16)f2bf((float)(cr * bre - ci * bim)); BB[(64 + p) * 16 + n] = (bf16)f2bf((float)(cr * bim + ci * bre)); }
    }
    for (int i = gt; i < DEPTH * 32 * 16 * 64; i += NGT) { const int l = i >> 15, r = i & 32767, gn = r >> 6, p = r & 63;
        bf16* CM = (bf16*)(ws + WS_SSMC + (size_t)l * SSMC_LSTRIDE + SC_CM) + (size_t)gn * 128;
        CM[2 * p] = (bf16)f2bf(A.in[I_CRE][i]); CM[2 * p + 1] = (bf16)f2bf(-A.in[I_CIM][i]); }
}

__device__ __forceinline__ float gelu_tanh(float y) {
    const float z = 0.7978845608028654f * (y + 0.044715f * y * y * y);
    const float e = __builtin_amdgcn_exp2f(2.885390081777927f * z);
    const float th = 1.0f - 2.0f * __builtin_amdgcn_rcpf(1.0f + e);
    return 0.5f * y * (1.0f + th);
}
struct SsmGrp { float2 ab; bf16x8 bfr[4]; bf16x8 afr0, afr1; float sre, sim; bf16x8 cfr[4]; float dsk; };
template <bool PASSB> __device__ __forceinline__ SsmGrp ssm_load_group(Frame& F, const Args& A, int l, int ch, int g, bool smp, int row0) {
    const int lane = F.lane, r32 = lane & 31, hi = lane >> 5, fr = lane & 15, fq = lane >> 4;
    const unsigned char* sc = F.ws + WS_SSMC + (size_t)l * SSMC_LSTRIDE;
    const bf16* BB = (const bf16*)(sc + SC_BB); const bf16* CM = (const bf16*)(sc + SC_CM); const bf16* US = (const bf16*)(F.ws + WS_US);
    SsmGrp d;
    d.ab = ((const float2*)(sc + SC_AB))[g * 64 + lane];
#pragma unroll
    for (int cb = 0; cb < 4; ++cb) d.bfr[cb] = *(const bf16x8*)(BB + ((size_t)g * 128 + cb * 32 + r32) * 16 + 8 * hi);
    d.afr0 = *(const bf16x8*)(US + (size_t)(row0 + r32) * 512 + g * 16 + 8 * hi);
    d.afr1 = smp ? d.afr0 : *(const bf16x8*)(US + (size_t)(row0 + 32 + r32) * 512 + g * 16 + 8 * hi);
    d.sre = 0.f; d.sim = 0.f; d.dsk = 0.f;
#pragma unroll
    for (int kb = 0; kb < 4; ++kb) d.cfr[kb] = bf16x8{};
    if (PASSB) {
        if (smp) { const size_t si = ((size_t)(l * NB_S + (ch - NCH_P)) * 32 + g) * 64 + lane; d.sre = A.in[I_SRE][si]; d.sim = A.in[I_SIM][si]; }
        else { const float2 h = ((const float2*)(F.ws + WS_H))[((size_t)ch * 32 + g) * 64 + lane]; d.sre = h.x; d.sim = h.y; }
#pragma unroll
        for (int kb = 0; kb < 4; ++kb) d.cfr[kb] = *(const bf16x8*)(CM + ((size_t)g * 16 + fr) * 128 + kb * 32 + 8 * fq);
        d.dsk = A.in[I_SD][l * 512 + g * 16 + fr];
    }
    return d;
}
template <bool PASSB> __device__ __forceinline__ void ssm_pass(Frame& F, const Args& A, int l) {
    LAS unsigned char* wl = F.lds + RING_OFF + F.wave * 9728;
    LAS unsigned* ST32 = (LAS unsigned*)wl; LAS unsigned short* ST = (LAS unsigned short*)wl; LAS unsigned short* UT = (LAS unsigned short*)(wl + 8704);
    const int lane = F.lane, r32 = lane & 31, hi = lane >> 5, fr = lane & 15, fq = lane >> 4;
    unsigned char* ws = F.ws;
    bf16* VS_ = (bf16*)(ws + WS_VSSM); float2* Eb = (float2*)(ws + WS_E);
    const int nprompt = (NCH_P - F.vcu + F.G - 1) / F.G; const int nsmp = PASSB ? (NB_S * 32 - (F.vcu * NWAVES + F.wave) + F.G * NWAVES - 1) / (F.G * NWAVES) : 0;
#pragma unroll 1
    for (int it = 0; it < nprompt + nsmp; ++it) {
        const bool smp = it >= nprompt; const int sidx = F.vcu * NWAVES + F.wave + (it - nprompt) * F.G * NWAVES;
        const int ch = smp ? NCH_P + (sidx >> 5) : F.vcu + it * F.G; const int row0 = smp ? M_P + (ch - NCH_P) * 32 : ch * 64; const int nhalf = smp ? 1 : 2;
        const int g0 = smp ? (sidx & 31) : F.wave * 4, ng = smp ? 1 : 4;
        SsmGrp cur = ssm_load_group<PASSB>(F, A, l, ch, g0, smp, row0);
#pragma unroll 1
        for (int gi = 0; gi < ng; ++gi) {
            const int g = g0 + gi;
            const SsmGrp nxt = ssm_load_group<PASSB>(F, A, l, ch, g0 + (gi < ng - 1 ? gi + 1 : ng - 1), smp, row0);
            const float2 ab = cur.ab; float sre = cur.sre, sim = cur.sim;
#pragma unroll 1
            for (int hf = 0; hf < nhalf; ++hf) {
                const int rbase = row0 + hf * 32;
                const bf16x8 afr = hf ? cur.afr1 : cur.afr0;
                if (PASSB) *(LAS bf16x8*)(UT + r32 * 16 + 8 * hi) = afr;
                f32x16 c[4];
#pragma unroll
                for (int cb = 0; cb < 4; ++cb) c[cb] = __builtin_amdgcn_mfma_f32_32x32x16_bf16(afr, cur.bfr[cb], (f32x16){}, 0, 0, 0);
#pragma unroll
                for (int i = 0; i < 16; ++i) {
                    { auto rr = __builtin_amdgcn_permlane32_swap(__float_as_uint(c[0][i]), __float_as_uint(c[1][i]), false, false); c[0][i] = __uint_as_float(rr[0]); c[1][i] = __uint_as_float(rr[1]); }
                    { auto rr = __builtin_amdgcn_permlane32_swap(__float_as_uint(c[2][i]), __float_as_uint(c[3][i]), false, false); c[2][i] = __uint_as_float(rr[0]); c[3][i] = __uint_as_float(rr[1]); } }
#pragma unroll
                for (int t = 0; t < 32; ++t) {
                    const int i = (t & 3) + 4 * (t >> 3), h = (t >> 2) & 1;
                    const float bre = c[h][i], bim = c[2 + h][i];
                    float nre = __builtin_fmaf(ab.x, sre, __builtin_fmaf(-ab.y, sim, bre)); asm volatile("" : "+v"(nre));
                    const float nim = __builtin_fmaf(ab.x, sim, __builtin_fmaf(ab.y, sre, bim)); sre = nre; sim = nim;
                    if (PASSB) ST32[t * 68 + lane] = pk2hw(sre, sim);
                }
                if (PASSB) {
#pragma unroll
                    for (int q = 0; q < 2; ++q) {
                        pg8::f32x4 y = {0.f, 0.f, 0.f, 0.f};
#pragma unroll
                        for (int kb = 0; kb < 4; ++kb) { const bf16x8 a = *(const LAS bf16x8*)(ST + (16 * q + fr) * 136 + kb * 32 + 8 * fq); y = __builtin_amdgcn_mfma_f32_16x16x32_bf16(a, cur.cfr[kb], y, 0, 0, 0); }
#pragma unroll
                        for (int j = 0; j < 4; ++j) { const int tok = 16 * q + fq * 4 + j;
                            const float u = __uint_as_float((unsigned)UT[tok * 16 + fr] << 16); UT[tok * 16 + fr] = (unsigned short)f2bf(gelu_tanh(y[j] + cur.dsk * u)); }
                    }
                    { const v4u w = *(const LAS v4u*)(UT + (lane >> 1) * 16 + (lane & 1) * 8); *(GAS v4u*)(VS_ + (size_t)(rbase + (lane >> 1)) * 512 + g * 16 + (lane & 1) * 8) = w; }
                }
            }
            if (!PASSB) Eb[((size_t)ch * 32 + g) * 64 + lane] = make_float2(sre, sim);
            else if (smp) { const size_t oi = ((size_t)(l * NB_S + (ch - NCH_P)) * 32 + g) * 64 + lane; F.out[O_SRS + oi] = sre; F.out[O_SIS + oi] = sim; }
            else if ((ch & 255) == 255) { const size_t oi = ((size_t)(l * NB_P + (ch >> 8)) * 32 + g) * 64 + lane; F.out[O_SRP + oi] = sre; F.out[O_SIP + oi] = sim; }
            cur = nxt;
        }
    }
}
__device__ __forceinline__ void ssm_carry(Frame& F, int l) {
    const int gw = F.vcu * NWAVES + F.wave; if (gw >= NB_P * 32) return;
    const int b = gw >> 5, g = gw & 31;
    const float2 a = ((const float2*)(F.ws + WS_SSMC + (size_t)l * SSMC_LSTRIDE + SC_A64))[g * 64 + F.lane];
    const float2* Eb = (const float2*)(F.ws + WS_E) + ((size_t)b * 256 * 32 + g) * 64 + F.lane; float2* Hb = (float2*)(F.ws + WS_H) + ((size_t)b * 256 * 32 + g) * 64 + F.lane;
    float hr = 0.f, hi_ = 0.f;
    float2 cur[32], nxt[32];
#pragma unroll
    for (int j = 0; j < 32; ++j) cur[j] = Eb[(size_t)j * 2048];
#pragma unroll 1
    for (int c0 = 0; c0 < 256; c0 += 32) {
        if (c0 + 32 < 256) {
#pragma unroll
            for (int j = 0; j < 32; ++j) nxt[j] = Eb[(size_t)(c0 + 32 + j) * 2048]; }
#pragma unroll
        for (int j = 0; j < 32; ++j) { Hb[(size_t)(c0 + j) * 2048] = make_float2(hr, hi_);
            const float nr = a.x * hr - a.y * hi_ + cur[j].x, ni = a.x * hi_ + a.y * hr + cur[j].y; hr = nr; hi_ = ni; }
#pragma unroll
        for (int j = 0; j < 32; ++j) cur[j] = nxt[j];
    }
}

__device__ __forceinline__ void ld8b(const bf16* p, float (&v)[8]) { const v4u w = *(const GAS v4u*)p; v[0] = bfl(w.x); v[1] = bfh(w.x); v[2] = bfl(w.y); v[3] = bfh(w.y); v[4] = bfl(w.z); v[5] = bfh(w.z); v[6] = bfl(w.w); v[7] = bfh(w.w); }
__device__ __forceinline__ void ld8f(const float* p, float (&v)[8]) { const f32x4 a = *(const GAS f32x4*)p, b = *(const GAS f32x4*)(p + 4); v[0] = a.x; v[1] = a.y; v[2] = a.z; v[3] = a.w; v[4] = b.x; v[5] = b.y; v[6] = b.z; v[7] = b.w; }
__device__ __forceinline__ void st8b(bf16* p, const float (&v)[8]) { v4u w; w.x = pk2(v[0], v[1]); w.y = pk2(v[2], v[3]); w.z = pk2(v[4], v[5]); w.w = pk2(v[6], v[7]); *(GAS v4u*)p = w; }
__device__ __forceinline__ void st8f(float* p, const float (&v)[8]) { *(GAS f32x4*)p = (f32x4){v[0], v[1], v[2], v[3]}; *(GAS f32x4*)(p + 4) = (f32x4){v[4], v[5], v[6], v[7]}; }
__device__ __forceinline__ void up8(const v4u w, float (&v)[8]) { v[0] = bfl(w.x); v[1] = bfh(w.x); v[2] = bfl(w.y); v[3] = bfh(w.y); v[4] = bfl(w.z); v[5] = bfh(w.z); v[6] = bfl(w.w); v[7] = bfh(w.w); }
__device__ __forceinline__ v4u ldrow_or_hist(const bf16* cur, const float* hist, bool use_cur, bool use_hist) {
    if (use_cur) return *(const GAS v4u*)cur;
    if (use_hist) { float h[8]; ld8f(hist, h); v4u w; w.x = pk2(h[0], h[1]); w.y = pk2(h[2], h[3]); w.z = pk2(h[4], h[5]); w.w = pk2(h[6], h[7]); return w; }
    return (v4u){0u, 0u, 0u, 0u};
}
template <int W> __device__ __forceinline__ void pool8(const bf16* ZP, const float* hist  , bf16* UP, float* st_out  , int st_t0  ,
                                                       int row0, int t0, bool smp, int c0) {
    v4u zr[W + 7];
#pragma unroll
    for (int k = 0; k < W + 7; ++k) { const int tk = t0 - (W - 1) + k;
        zr[k] = ldrow_or_hist(ZP + (size_t)(row0 - (W - 1) + k) * 512 + c0, hist + (size_t)(15 + tk) * 512 + c0, tk >= 0, smp && tk < 0); }
    float S[8];
#pragma unroll
    for (int e = 0; e < 8; ++e) S[e] = 0.f;
#pragma unroll
    for (int k = 0; k < W - 1; ++k) { float z[8]; up8(zr[k], z);
#pragma unroll
        for (int e = 0; e < 8; ++e) S[e] += z[e]; }
#pragma unroll
    for (int i = 0; i < 8; ++i) { float z[8]; up8(zr[i + W - 1], z);
#pragma unroll
        for (int e = 0; e < 8; ++e) S[e] += z[e];
        const int t = t0 + i; const int cnt = smp ? W : (t + 1 < W ? t + 1 : W); const float inv = 1.0f / (float)cnt;
        float uo[8];
#pragma unroll
        for (int e = 0; e < 8; ++e) uo[e] = S[e] * inv - z[e];
        st8b(UP + (size_t)(row0 + i) * BR_W + c0, uo);
        if (st_out && t >= st_t0) st8f(st_out + (size_t)(t - st_t0) * 512 + c0, z);
        float zo[8]; up8(zr[i], zo);
#pragma unroll
        for (int e = 0; e < 8; ++e) S[e] -= zo[e]; }
}
template <int W> __device__ __forceinline__ void pool8_fast(const bf16* ZP, bf16* UP, float* st_out, int st_t0, int row0, int t0, bool smp, int c0) {
    v4u zr[W + 7];
#pragma unroll
    for (int k = 0; k < W + 7; ++k) { const int rk = row0 - (W - 1) + k; zr[k] = *(const GAS v4u*)(ZP + (size_t)(rk < 0 ? 0 : rk) * 512 + c0); }
#pragma unroll
    for (int k = 0; k < W - 1; ++k) { const bool neg = t0 - (W - 1) + k < 0; zr[k].x = neg ? 0u : zr[k].x; zr[k].y = neg ? 0u : zr[k].y; zr[k].z = neg ? 0u : zr[k].z; zr[k].w = neg ? 0u : zr[k].w; }
    float S[8];
#pragma unroll
    for (int e = 0; e < 8; ++e) S[e] = 0.f;
#pragma unroll
    for (int k = 0; k < W - 1; ++k) { float z[8]; up8(zr[k], z);
#pragma unroll
        for (int e = 0; e < 8; ++e) S[e] += z[e]; }
#pragma unroll
    for (int i = 0; i < 8; ++i) { float z[8]; up8(zr[i + W - 1], z);
#pragma unroll
        for (int e = 0; e < 8; ++e) S[e] += z[e];
        const int t = t0 + i; const int cnt = smp ? W : (t + 1 < W ? t + 1 : W); const float inv = 1.0f / (float)cnt;
        float uo[8];
#pragma unroll
        for (int e = 0; e < 8; ++e) uo[e] = S[e] * inv - z[e];
        st8b(UP + (size_t)(row0 + i) * BR_W + c0, uo);
        if (st_out && t >= st_t0) st8f(st_out + (size_t)(t - st_t0) * 512 + c0, z);
        float zo[8]; up8(zr[i], zo);
#pragma unroll
        for (int e = 0; e < 8; ++e) S[e] -= zo[e]; }
}
__device__ __forceinline__ void mixa_elem(Frame& F, const Args& A, int l) {
    unsigned char* ws = F.ws;
    const bf16* ZP = (const bf16*)(ws + WS_ZP); const bf16* HC = (const bf16*)(ws + WS_HC); const bf16* BC = (const bf16*)(ws + WS_BC); const bf16* CC = (const bf16*)(ws + WS_CC);
    bf16* OALL = (bf16*)(ws + WS_OALL); bf16* UP = OALL;
    const int gi = F.wave & 3, c0 = (gi * 16 + (F.lane & 15)) * 8, rsub = (F.wave >> 2) * 4 + (F.lane >> 4);
    float cw0[8], cw1[8], cw2[8], cbias[8];
    ld8f(A.in[I_CONVW] + (size_t)(l * 3 + 0) * 512 + c0, cw0); ld8f(A.in[I_CONVW] + (size_t)(l * 3 + 1) * 512 + c0, cw1); ld8f(A.in[I_CONVW] + (size_t)(l * 3 + 2) * 512 + c0, cw2); ld8f(A.in[I_CONVB] + (size_t)l * 512 + c0, cbias);
    const int nptile = (M_P / 64 - F.vcu + F.G - 1) / F.G; const int nstile = (64 - F.vcu + F.G - 1) / F.G;
#pragma unroll 1
    for (int it = 0; it < nptile + nstile; ++it) {
        const bool stile = it >= nptile; const int sidx = F.vcu + (it - nptile) * F.G;
        if (stile && F.wave != (sidx & 7)) continue;
        const int tile = stile ? M_P / 64 + (sidx >> 3) : F.vcu + it * F.G;
        const int row0 = tile * 64 + rsub * 8; const bool smp = row0 >= M_P; const int loc = row0 - M_P;
        const int t0 = smp ? (loc & 31) : (row0 & (SEQ - 1)), b = smp ? (loc >> 5) : (row0 >> 14);
        const float* hist = smp ? A.in[I_SPOOL] + (size_t)(l * NB_S + b) * 15 * 512 : nullptr;
        float* st_out = smp ? F.out + O_PS + (size_t)(l * NB_S + b) * 15 * 512 : F.out + O_PP + (size_t)(l * NB_P + b) * 15 * 512;
        const int L = smp ? SEQ_S : SEQ;
        if (t0 + 8 <= L - 15) st_out = nullptr;
        if (smp && t0 < 15) {
            if (gi == 0) pool8<2>(ZP, hist, UP, st_out, L - 15, row0, t0, smp, c0);
            else if (gi == 1) pool8<4>(ZP, hist, UP, st_out, L - 15, row0, t0, smp, c0);
            else if (gi == 2) pool8<8>(ZP, hist, UP, st_out, L - 15, row0, t0, smp, c0);
            else pool8<16>(ZP, hist, UP, st_out, L - 15, row0, t0, smp, c0);
            const float* chist = smp ? A.in[I_SCONV] + (size_t)(l * NB_S + b) * 2 * 512 : nullptr;
            float* cst = smp ? F.out + O_CS + (size_t)(l * NB_S + b) * 2 * 512 : F.out + O_CP + (size_t)(l * NB_P + b) * 2 * 512;
            v4u hr[10], cr[10], br[8];
    #pragma unroll
            for (int k = 0; k < 10; ++k) { const int tk = t0 - 2 + k;
                if (tk >= 0) { hr[k] = *(const GAS v4u*)(HC + (size_t)(row0 - 2 + k) * 512 + c0); cr[k] = *(const GAS v4u*)(CC + (size_t)(row0 - 2 + k) * 512 + c0); }
                else { hr[k] = (v4u){0u, 0u, 0u, 0u}; cr[k] = hr[k]; } }
    #pragma unroll
            for (int k = 0; k < 8; ++k) br[k] = *(const GAS v4u*)(BC + (size_t)(row0 + k) * 512 + c0);
            float z2[8], z1[8];
            {   float h_[8], c_[8];
                if (t0 >= 2 || !smp) { up8(hr[0], h_); up8(cr[0], c_);
    #pragma unroll
                    for (int e = 0; e < 8; ++e) z2[e] = h_[e] * c_[e]; } else ld8f(chist + (size_t)(t0) * 512 + c0, z2);
                if (t0 >= 1 || !smp) { up8(hr[1], h_); up8(cr[1], c_);
    #pragma unroll
                    for (int e = 0; e < 8; ++e) z1[e] = h_[e] * c_[e]; } else ld8f(chist + (size_t)(t0 + 1) * 512 + c0, z1); }
    #pragma unroll
            for (int i = 0; i < 8; ++i) { float h_[8], c_[8], z0[8], bb[8], y[8]; up8(hr[i + 2], h_); up8(cr[i + 2], c_); up8(br[i], bb);
    #pragma unroll
                for (int e = 0; e < 8; ++e) { z0[e] = h_[e] * c_[e]; y[e] = (cbias[e] + z2[e] * cw0[e] + z1[e] * cw1[e] + z0[e] * cw2[e]) * bb[e]; }
                st8b(OALL + (size_t)(row0 + i) * BR_W + 1024 + c0, y);
                const int t = t0 + i; if (t >= L - 2) st8f(cst + (size_t)(t - (L - 2)) * 512 + c0, z0);
    #pragma unroll
                for (int e = 0; e < 8; ++e) { z2[e] = z1[e]; z1[e] = z0[e]; } }
        } else {
            if (gi == 0) pool8_fast<2>(ZP, UP, st_out, L - 15, row0, t0, smp, c0);
            else if (gi == 1) pool8_fast<4>(ZP, UP, st_out, L - 15, row0, t0, smp, c0);
            else if (gi == 2) pool8_fast<8>(ZP, UP, st_out, L - 15, row0, t0, smp, c0);
            else pool8_fast<16>(ZP, UP, st_out, L - 15, row0, t0, smp, c0);
            float* cst = smp ? F.out + O_CS + (size_t)(l * NB_S + b) * 2 * 512 : F.out + O_CP + (size_t)(l * NB_P + b) * 2 * 512;
            v4u hr[10], cr[10], br[8];
#pragma unroll
            for (int k = 0; k < 10; ++k) { const int rk = row0 - 2 + k; const size_t ro = (size_t)(rk < 0 ? 0 : rk) * 512 + c0; hr[k] = *(const GAS v4u*)(HC + ro); cr[k] = *(const GAS v4u*)(CC + ro); }
#pragma unroll
            for (int k = 0; k < 8; ++k) br[k] = *(const GAS v4u*)(BC + (size_t)(row0 + k) * 512 + c0);
#pragma unroll
            for (int k = 0; k < 2; ++k) { const bool neg = t0 - 2 + k < 0; hr[k].x = neg ? 0u : hr[k].x; hr[k].y = neg ? 0u : hr[k].y; hr[k].z = neg ? 0u : hr[k].z; hr[k].w = neg ? 0u : hr[k].w; }
            float z2[8], z1[8];
            {   float h_[8], c_[8]; up8(hr[0], h_); up8(cr[0], c_);
#pragma unroll
                for (int e = 0; e < 8; ++e) z2[e] = h_[e] * c_[e];
                up8(hr[1], h_); up8(cr[1], c_);
#pragma unroll
                for (int e = 0; e < 8; ++e) z1[e] = h_[e] * c_[e]; }
#pragma unroll
            for (int i = 0; i < 8; ++i) { float h_[8], c_[8], z0[8], bb[8], y[8]; up8(hr[i + 2], h_); up8(cr[i + 2], c_); up8(br[i], bb);
#pragma unroll
                for (int e = 0; e < 8; ++e) { z0[e] = h_[e] * c_[e]; y[e] = (cbias[e] + z2[e] * cw0[e] + z1[e] * cw1[e] + z0[e] * cw2[e]) * bb[e]; }
                st8b(OALL + (size_t)(row0 + i) * BR_W + 1024 + c0, y);
                const int t = t0 + i; if (t >= L - 2) st8f(cst + (size_t)(t - (L - 2)) * 512 + c0, z0);
#pragma unroll
                for (int e = 0; e < 8; ++e) { z2[e] = z1[e]; z1[e] = z0[e]; } }
        }
    }
}

__device__ __forceinline__ void diff_subln(Frame& F, const Args& A, int l) {
    const int lane = F.lane; const int gw = F.vcu * NWAVES + F.wave, NGW = F.G * NWAVES;
    const float s1 = wave_sum(A.in[I_LQ1][l * 64 + lane] * A.in[I_LK1][l * 64 + lane]), s2 = wave_sum(A.in[I_LQ2][l * 64 + lane] * A.in[I_LK2][l * 64 + lane]);
    const float lam_init = 0.8f - 0.6f * expf(-0.3f * (float)l);
    const float lam = expf(s1) - expf(s2) + lam_init, coef = 1.0f - lam_init;
    const int h = lane >> 3, e0 = (lane & 7) * 16;
    float sw0[8], sw1[8]; ld8f(A.in[I_SUBLN] + (size_t)l * 128 + e0, sw0); ld8f(A.in[I_SUBLN] + (size_t)l * 128 + e0 + 8, sw1);
    const bf16* OA = (const bf16*)(F.ws + WS_OATT); bf16* OALL = (bf16*)(F.ws + WS_OALL);
    for (int m0 = gw; m0 < M_T; m0 += 4 * NGW) {
        v4u ra[4][4];
#pragma unroll
        for (int r = 0; r < 4; ++r) { int m = m0 + r * NGW; m = m < M_T ? m : m0; const bf16* p1 = OA + (size_t)m * 2048 + (2 * h) * 128 + e0;
            ra[r][0] = *(const GAS v4u*)p1; ra[r][1] = *(const GAS v4u*)(p1 + 8); ra[r][2] = *(const GAS v4u*)(p1 + 128); ra[r][3] = *(const GAS v4u*)(p1 + 136); }
        __builtin_amdgcn_sched_barrier(0);
#pragma unroll
        for (int r = 0; r < 4; ++r) { int m = m0 + r * NGW; m = m < M_T ? m : m0;
            float a0[8], a1[8], b0[8], b1[8]; up8(ra[r][0], a0); up8(ra[r][1], a1); up8(ra[r][2], b0); up8(ra[r][3], b1);
            float ss = 0.f;
#pragma unroll
            for (int e = 0; e < 8; ++e) { a0[e] = a0[e] - lam * b0[e]; a1[e] = a1[e] - lam * b1[e]; ss += a0[e] * a0[e] + a1[e] * a1[e]; }
            ss += swz_xor<1>(ss); ss += swz_xor<2>(ss); ss += swz_xor<4>(ss);
            const float rs = coef / sqrtf(ss * (1.0f / 128.0f) + LN_EPS);
#pragma unroll
            for (int e = 0; e < 8; ++e) { a0[e] = a0[e] * rs * sw0[e]; a1[e] = a1[e] * rs * sw1[e]; }
            bf16* o = OALL + (size_t)m * BR_W + 1536 + h * 128 + e0;
            { v4u w; w.x = pk2hw(a0[0], a0[1]); w.y = pk2hw(a0[2], a0[3]); w.z = pk2hw(a0[4], a0[5]); w.w = pk2hw(a0[6], a0[7]); *(GAS v4u*)o = w; }
            { v4u w; w.x = pk2hw(a1[0], a1[1]); w.y = pk2hw(a1[2], a1[3]); w.z = pk2hw(a1[4], a1[5]); w.w = pk2hw(a1[6], a1[7]); *(GAS v4u*)(o + 8) = w; } }
    }
}

__device__ __forceinline__ void ln_load_row(const void* Yv, bool ybf, int m, int lane, f32x4 (&v)[4]) {
    if (ybf) { const GAS v4u* xr = (const GAS v4u*)((const bf16*)Yv + (size_t)m * DM) + lane;
#pragma unroll
        for (int jj = 0; jj < 2; ++jj) { const v4u w = xr[64 * jj]; v[2 * jj] = (f32x4){bfl(w.x), bfh(w.x), bfl(w.y), bfh(w.y)}; v[2 * jj + 1] = (f32x4){bfl(w.z), bfh(w.z), bfl(w.w), bfh(w.w)}; } }
    else { const GAS f32x4* xr = (const GAS f32x4*)((const float*)Yv + (size_t)m * DM) + 2 * lane;
#pragma unroll
        for (int j = 0; j < 4; ++j) v[j] = xr[128 * (j >> 1) + (j & 1)]; }
}
__device__ __forceinline__ void ln_finish_row(f32x4 (&v)[4], const f32x4 (&g4)[4], const f32x4 (&b4)[4], int m, int lane, float* outf, bf16* outb) {
    float s = 0.f;
#pragma unroll
    for (int j = 0; j < 4; ++j) s += (v[j].x + v[j].y) + (v[j].z + v[j].w);
    const float mean = wave_sum(s) * (1.f / DM); float s2 = 0.f;
#pragma unroll
    for (int j = 0; j < 4; ++j) { v[j] = v[j] - mean; s2 += (v[j].x * v[j].x + v[j].y * v[j].y) + (v[j].z * v[j].z + v[j].w * v[j].w); }
    const float rstd = 1.f / sqrtf(wave_sum(s2) * (1.f / DM) + LN_EPS);
#pragma unroll
    for (int j = 0; j < 4; ++j) { v[j] = v[j] * rstd * g4[j] + b4[j];
        if (outf) ((GAS f32x4*)(outf + (size_t)m * DM))[2 * lane + 128 * (j >> 1) + (j & 1)] = v[j]; }
    if (outb) {
#pragma unroll
        for (int jj = 0; jj < 2; ++jj) { v4u w; w.x = pk2hw(v[2 * jj].x, v[2 * jj].y); w.y = pk2hw(v[2 * jj].z, v[2 * jj].w); w.z = pk2hw(v[2 * jj + 1].x, v[2 * jj + 1].y); w.w = pk2hw(v[2 * jj + 1].z, v[2 * jj + 1].w);
            ((GAS v4u*)(outb + (size_t)m * DM))[lane + 64 * jj] = w; } }
}
__device__ __forceinline__ void ln_rows(Frame& F, const void* Yv, bool ybf, const float* gam, const float* bet, float* outf, bf16* outb) {
    const int gw = F.vcu * NWAVES + F.wave, NGW = F.G * NWAVES;
    f32x4 g4[4], b4[4];
#pragma unroll
    for (int j = 0; j < 4; ++j) { g4[j] = ((const GAS f32x4*)gam)[2 * F.lane + 128 * (j >> 1) + (j & 1)]; b4[j] = ((const GAS f32x4*)bet)[2 * F.lane + 128 * (j >> 1) + (j & 1)]; }
    for (int m = gw; m < M_T; m += 2 * NGW) {
        const int m2 = m + NGW < M_T ? m + NGW : m;
        f32x4 va[4], vb[4];
        ln_load_row(Yv, ybf, m, F.lane, va);
        ln_load_row(Yv, ybf, m2, F.lane, vb);
        ln_finish_row(va, g4, b4, m, F.lane, outf, outb);
        ln_finish_row(vb, g4, b4, m2, F.lane, outf, outb);
    }
}

template <int MODE, int N = DM> __device__ __forceinline__ void skinny_gemm(Frame& F, const bf16* A  , const bf16* Bt, int K, const void* resid  , bool rbf = false, bool ybf = false) {
    const int lane = F.lane, r32 = lane & 31, hi = lane >> 5, w = F.wave;
    LAS float* part = (LAS float*)(F.lds + RING_OFF);
    for (int tile = F.vcu; tile < (M_S / 64) * (N / 32); tile += F.G) {
        const int rb = tile & 7, cb = tile >> 3, row0 = rb * 64, col0 = cb * 32;
        int ks0, nks;
        if (MODE == 1) { ks0 = w < 6 ? w * 16 : 96 + (w - 6) * 32; nks = w < 6 ? 16 : 32; }
        else { nks = K / 128; ks0 = w * nks; }
        const bf16* a0 = A + (size_t)(row0 + r32) * K + ks0 * 16 + 8 * hi; const bf16* a1 = a0 + (size_t)32 * K; const bf16* bp = Bt + (size_t)(col0 + r32) * K + ks0 * 16 + 8 * hi;
        f32x16 acc0 = {}, acc1 = {};
        bf16x8 pa0[4], pa1[4], pb[4], qa0[4], qa1[4], qb_[4];
#define SK_LOAD(X0, X1, XB, kk) do { _Pragma("unroll") for (int u = 0; u < 4; ++u) { X0[u] = *(const bf16x8*)(a0 + ((kk) + u) * 16); X1[u] = *(const bf16x8*)(a1 + ((kk) + u) * 16); XB[u] = *(const bf16x8*)(bp + ((kk) + u) * 16); } } while (0)
#define SK_MMA(X0, X1, XB) do { _Pragma("unroll") for (int u = 0; u < 4; ++u) { acc0 = __builtin_amdgcn_mfma_f32_32x32x16_bf16(X0[u], XB[u], acc0, 0, 0, 0); acc1 = __builtin_amdgcn_mfma_f32_32x32x16_bf16(X1[u], XB[u], acc1, 0, 0, 0); } } while (0)
        SK_LOAD(pa0, pa1, pb, 0);
#pragma unroll 1
        for (int k = 0; k < nks; k += 8) {
            const bool two = k + 4 < nks;
            if (two) SK_LOAD(qa0, qa1, qb_, k + 4);
            SK_MMA(pa0, pa1, pb);
            if (k + 8 < nks) SK_LOAD(pa0, pa1, pb, k + 8);
            if (two) SK_MMA(qa0, qa1, qb_);
        }
#undef SK_LOAD
#undef SK_MMA
        LAS float* mine = part + w * 2048;
#pragma unroll
        for (int r = 0; r < 16; ++r) { const int row = (r & 3) + 8 * (r >> 2) + 4 * hi; mine[row * 32 + r32] = acc0[r]; mine[(32 + row) * 32 + r32] = acc1[r]; }
        __syncthreads();
        {
            const int row = 8 * w + (lane >> 3), c4 = (lane & 7) * 4; const int grow = row0 + row, gcol = col0 + c4;
            f32x4 sum = {0.f, 0.f, 0.f, 0.f};
            if (MODE == 1) {
                const bf16* gp = (const bf16*)(F.ws + WS_G) + (size_t)(M_P + grow) * 4096 + gcol;
#pragma unroll
                for (int b = 0; b < 4; ++b) { const unsigned long long gw = *(const GAS unsigned long long*)(gp + b * 1024);
                    const f32x4 gv = {bfl((unsigned)gw), bfh((unsigned)gw), bfl((unsigned)(gw >> 32)), bfh((unsigned)(gw >> 32))};
                    const f32x4 pb = *(const LAS f32x4*)(part + (2 * b) * 2048 + row * 32 + c4) + *(const LAS f32x4*)(part + (2 * b + 1) * 2048 + row * 32 + c4);
                    sum += gv * pb; }
                *(GAS unsigned long long*)((bf16*)(F.ws + WS_MG) + (size_t)(M_P + grow) * 1024 + gcol) = (unsigned long long)pk2(sum.x, sum.y) | ((unsigned long long)pk2(sum.z, sum.w) << 32);
            } else if (MODE == 3) {
#pragma unroll
                for (int ww = 0; ww < 8; ++ww) sum += *(const LAS f32x4*)(part + ww * 2048 + row * 32 + c4);
                const unsigned long long vw = *(const GAS unsigned long long*)((const bf16*)(F.ws + WS_VSSM) + (size_t)(M_P + grow) * 512 + gcol);
                const f32x4 vv = {bfl((unsigned)vw), bfh((unsigned)vw), bfl((unsigned)(vw >> 32)), bfh((unsigned)(vw >> 32))};
#pragma unroll
                for (int e = 0; e < 4; ++e) sum[e] = vv[e] * pg8::fast_sigmoid(sum[e]);
                *(GAS unsigned long long*)((bf16*)(F.ws + WS_OALL) + (size_t)(M_P + grow) * BR_W + 512 + gcol) = (unsigned long long)pk2(sum.x, sum.y) | ((unsigned long long)pk2(sum.z, sum.w) << 32);
            } else if (MODE == 2) {
#pragma unroll
                for (int ww = 0; ww < 8; ++ww) sum += *(const LAS f32x4*)(part + ww * 2048 + row * 32 + c4);
#pragma unroll
                for (int e = 0; e < 4; ++e) { const float a = fmaxf(sum[e], 0.f); sum[e] = a * a; }
                *(GAS unsigned long long*)((bf16*)(F.ws + WS_G) + (size_t)(M_P + grow) * N + gcol) = (unsigned long long)pk2(sum.x, sum.y) | ((unsigned long long)pk2(sum.z, sum.w) << 32);
            } else {
#pragma unroll
                for (int ww = 0; ww < 8; ++ww) sum += *(const LAS f32x4*)(part + ww * 2048 + row * 32 + c4);
                f32x4 rv; if (rbf) { const unsigned long long w = *(const GAS unsigned long long*)((const bf16*)resid + (size_t)grow * 1024 + gcol); rv = (f32x4){bfl((unsigned)w), bfh((unsigned)w), bfl((unsigned)(w >> 32)), bfh((unsigned)(w >> 32))}; }
                else rv = *(const GAS f32x4*)((const float*)resid + (size_t)grow * 1024 + gcol);
                const f32x4 y = rv * DN_ALPHA + sum;
                if (ybf) *(GAS unsigned long long*)((bf16*)(F.ws + WS_YF) + (size_t)(M_P + grow) * 1024 + gcol) = (unsigned long long)pk2(y.x, y.y) | ((unsigned long long)pk2(y.z, y.w) << 32);
                else *(GAS f32x4*)((float*)(F.ws + WS_YF) + (size_t)(M_P + grow) * 1024 + gcol) = y;
            }
        }
        __syncthreads();
    }
}

__device__ __forceinline__ void attn_all(Frame& F, const Args& A, int l, char* lds_generic) {
    using abf = attn_body::bf16;
    const abf* Q = (const abf*)(F.ws + WS_Q); const abf* K = (const abf*)(F.ws + WS_K); const abf* V = (const abf*)(F.ws + WS_V);
    const abf* KS = (const abf*)(F.ws + WS_KS); const abf* VS = (const abf*)(F.ws + WS_VS); abf* OA = (abf*)(F.ws + WS_OATT);
#if ATTN_DV128
    constexpr int NU_P = NB_P * 16 * 64, NU_S = NB_S * 16;
    const bool bal = (F.G == 256);
    const int nmine = bal ? 8 + REP_SAMPLE : (NU_P + NU_S - F.vcu + F.G - 1) / F.G;
    struct AU { int mode, NT; const abf* Q; const abf* Kh; const abf* Vh; abf* O; const float* Kc; const float* Vc; };
    auto mk = [&](int i) -> AU {
        int mode, b, ph, qb = 0;
        if (bal) {
            const int spos = F.vcu % 9, ip = i < spos ? i : i - REP_SAMPLE;
            if (i < spos || i >= spos + REP_SAMPLE) { mode = 0; const int bp = F.vcu >> 3, s = F.vcu & 7, j = ip >> 1; b = bp >> 4; ph = bp & 15; qb = (ip & 1) ? s + 8 * j : 63 - s - 8 * j; }
            else { mode = 1; b = F.vcu >> 4; ph = F.vcu & 15; }
        } else {
            const int u = F.vcu + i * F.G;
            if (u < NU_P) { mode = 0; const int bp = u >> 6; qb = 63 - (u & 63); b = bp >> 4; ph = bp & 15; }
            else { mode = 1; const int su = u - NU_P; b = su >> 4; ph = su & 15; }
        }
        const size_t qrow = mode == 0 ? (size_t)b * SEQ + (size_t)qb * 256 : (size_t)M_P + (size_t)b * SEQ_S;
        AU u_;
        u_.mode = mode; u_.NT = mode == 0 ? 4 * (qb + 1) : KS_ROWS / 64;
        u_.Kh = (mode == 0 && KT_K) ? K + ((size_t)(b * 16 + ph) * 256) * 4096 : (mode == 0 ? K + (size_t)b * SEQ * 1024 : KS + (size_t)b * KS_ROWS * 1024) + ph * 64;
        u_.Vh = (mode == 0 && KT_V) ? V + ((size_t)(b * 8 + (ph >> 1)) * 256) * 8192 : (mode == 0 ? V + (size_t)b * SEQ * 1024 : VS + (size_t)b * KS_ROWS * 1024) + (ph >> 1) * 128;
        u_.Kc = mode == 0 ? nullptr : A.in[I_CK] + ((size_t)(l * NB_S + b) * PAST) * 1024 + ph * 64;
        u_.Vc = mode == 0 ? nullptr : A.in[I_CV] + ((size_t)(l * NB_S + b) * PAST) * 1024 + (ph >> 1) * 128;
        u_.Q = Q + qrow * 1024 + ph * 64; u_.O = OA + qrow * 2048 + ph * 128;
        return u_;
    };
    AU cur = mk(0); bool pre = false;
#pragma unroll 1
    for (int i = 0; i < nmine; ++i) {
        const bool hasn = i + 1 < nmine; const AU nx = mk(hasn ? i + 1 : i);
        const bool pfN = hasn && cur.mode == 0 && nx.mode == 0 && KT_K && KT_V;
        attn_body::attn_unit<4>(cur.mode, cur.NT, cur.Q, cur.Kh, cur.Vh, cur.O, lds_generic, cur.Kc, cur.Vc, F.tid, pre, pfN, nx.Kh, nx.Vh);
        pre = pfN; cur = nx;
    }
}
#else
    constexpr int NU_P = NB_P * 32 * 64, NU_S = NB_S * 32;
    const bool bal = (F.G == 256);
    const int nmine = bal ? 18 : (NU_P + NU_S - F.vcu + F.G - 1) / F.G;
    for (int i = 0; i < nmine; ++i) {
        int mode, b, vhd, qb = 0;
        if (bal) {
            if (i < 16) { mode = 0; const int bv = F.vcu >> 2, s = F.vcu & 3, j = i >> 1; b = bv >> 5; vhd = bv & 31; qb = (i & 1) ? s + 4 * j : 63 - s - 4 * j; }
            else { mode = 1; const int su = F.vcu + 256 * (i - 16); b = su >> 5; vhd = su & 31; }
        } else {
            const int u = F.vcu + i * F.G;
            if (u < NU_P) { mode = 0; const int bv = u >> 6; qb = 63 - (u & 63); b = bv >> 5; vhd = bv & 31; }
            else { mode = 1; const int su = u - NU_P; b = su >> 5; vhd = su & 31; }
        }
        const int ph = vhd >> 1, vh = vhd & 1;
        const size_t qrow = mode == 0 ? (size_t)b * SEQ + (size_t)qb * 256 : (size_t)M_P + (size_t)b * SEQ_S;
        const abf* Kh = (mode == 0 ? K + (size_t)b * SEQ * 1024 : KS + (size_t)b * KS_ROWS * 1024) + ph * 64;
        const abf* Vh = (mode == 0 ? V + (size_t)b * SEQ * 1024 : VS + (size_t)b * KS_ROWS * 1024) + (ph >> 1) * 128 + vh * 64;
        const int NT = mode == 0 ? 4 * (qb + 1) : KS_ROWS / 64;
        attn_body::attn_unit<8>(mode, NT, Q + qrow * 1024 + ph * 64, Kh, Vh, OA + qrow * 2048 + ph * 128 + vh * 64, lds_generic);
    }
}
#endif

__device__ __forceinline__ int grid_bar(const XcdBarrier& bar, int wave) { XcdBarrier b = bar; b.tid = wave * 64 + lane_id(); xcd_barrier(b); return 1; }
#ifndef REP_SK
#define REP_SK 1
#endif
#if REP_SK > 1
#define REP_SKLOOP _Pragma("unroll 1") for (int rs_ = 0; rs_ < REP_SK; ++rs_)
#else
#define REP_SKLOOP
#endif
__global__ void __launch_bounds__(NWAVES * 64, 2) hse_fwd(Args args) {
    extern __shared__ __attribute__((aligned(16))) unsigned char lds[];
    Frame F;
    F.lds = (LAS unsigned char*)lds;
    F.MISC = (volatile LAS unsigned*)(F.lds + MISC_OFF);
    F.tid = threadIdx.x; F.lane = F.tid & 63; F.wave = __builtin_amdgcn_readfirstlane(F.tid >> 6);
    F.G = gridDim.x; { const int bx = blockIdx.x; F.vcu = (F.G % 8 == 0) ? (bx % 8) * (F.G / 8) + bx / 8 : bx; }
    F.out = args.out; F.ws = args.ws; F.ctl = (gu32*)(args.ws + WS_CTL);
    for (int u = F.tid; u < (LDS_BYTES - LDSCTL_OFF) / 4; u += NWAVES * 64) ((LAS unsigned*)(F.lds + LDSCTL_OFF))[u] = 0u;
    __syncthreads();
    XcdBarrier bar; bar.bar = (unsigned*)(F.ctl + CW_BAR); bar.x = 0; bar.st = nullptr; bar.tid = 0;
#if MK_ONE_LAUNCH
    bar = xcd_barrier_post((unsigned*)(F.ctl + CW_BAR), F.MISC + 8);
#define GRID_BAR() grid_bar(bar, F.wave)
#else
#define GRID_BAR() do { if (F.tid == 0) __hip_atomic_store(F.ctl + CW_TMO, 0xBADBA0u, RLX_AGENT); } while (0)
#endif
    const int lo = args.ph_lo, hi = args.ph_hi;
#define IN(k) (lo <= (k) && (k) < hi)
#define SEAM(k) do { if (IN(k) && IN((k) + 1)) GRID_BAR(); } while (0)
#if MK_ONE_LAUNCH
#define REPEAT(N) _Pragma("unroll 1") for (int rp_ = 0; rp_ < (N); ++rp_) for (int once_ = (rp_ > 0 ? grid_bar(bar, F.wave) : 1); once_; once_ = 0)
#else
#define REPEAT(N)
#endif
#define PHASE_ENTER() Frame P = F; unsigned char* ws; { int t_ = F.wave * 64 + lane_id(); asm volatile("" : "+v"(t_)); P.tid = t_; P.lane = t_ & 63; P.wave = F.wave; \
        GAS unsigned char* w_ = (GAS unsigned char*)args.ws; asm volatile("" : "+s"(w_)); ws = (unsigned char*)w_; P.ws = ws; GAS float* o_ = (GAS float*)args.out; asm volatile("" : "+s"(o_)); P.out = (float*)o_; } \
        unsigned char* wl = ws + WS_W + (size_t)l * W_LSTRIDE; (void)wl

    { const int l = 0; if (IN(0)) { PHASE_ENTER(); p0_prologue(P, args); } } SEAM(0);

    for (int l = 0; l < DEPTH; ++l) {
        const int pb = 1 + l * PH_PER_LAYER;
        if (IN(pb + P_WIN)) { PHASE_ENTER();
            pg8::Gemm g{(const bf16*)(ws + WS_XB), (const bf16*)(wl + W_IN), M_T, N_IN, DM}; typedef pg8::StaticOrderT<M_T / 256, N_IN / 256> SO; SO S; S.init(M_T, N_IN, P.G, (int)blockIdx.x); S.tid = P.tid;
            pg8::EpiWin E{ws, P.out, l, attn_body::C2};
            pg8::gemm_phase<pg8::EpiWin, SO, true, true>(P.lds + RING_OFF, g, S, E);
            if (l == 0) {
                constexpr int NU = (M_T / 256) * (N_IN / 256); const int rounds = (NU + P.G - 1) / P.G, nlast = NU - (rounds - 1) * P.G;
                const int bx = (int)blockIdx.x;
                if (nlast >= P.G) p0_weights(P, args, I_IN0, 1 << 30, bx * NWAVES + P.wave, P.G * NWAVES);
                else if (bx >= nlast) p0_weights(P, args, I_IN0, 1 << 30, (bx - nlast) * NWAVES + P.wave, (P.G - nlast) * NWAVES);
            }
        }
        SEAM(pb + P_WIN);
        if (IN(pb + P_MIXA)) { PHASE_ENTER(); ssm_pass<false>(P, args, l); mixa_elem(P, args, l); }
        SEAM(pb + P_MIXA);
        if (IN(pb + P_ATTN)) { PHASE_ENTER(); ssm_carry(P, l); attn_all(P, args, l, (char*)lds + RING_OFF); }
#if REP_ATTN > 1
        GRID_BAR(); if (IN(pb + P_ATTN)) { PHASE_ENTER(); attn_all(P, args, l, (char*)lds + RING_OFF); }
#endif
        SEAM(pb + P_ATTN);
        if (IN(pb + P_MIXC)) { PHASE_ENTER(); ssm_pass<true>(P, args, l); diff_subln(P, args, l); }
        SEAM(pb + P_MIXC);
        if (IN(pb + P_PG)) { PHASE_ENTER();
            pg8::Gemm g{(const bf16*)(ws + WS_VSSM), (const bf16*)(wl + W_GLU), M_P, 512, 512}; typedef pg8::StaticOrderT<M_P / 256, 2> SO; SO S; S.init(M_P, 512, P.G, (int)blockIdx.x); S.tid = P.tid;
            pg8::EpiGlu E{ws};
            pg8::gemm_phase<pg8::EpiGlu, SO, true, true>(P.lds + RING_OFF, g, S, E);
            REP_SKLOOP skinny_gemm<3, 512>(P, (const bf16*)(ws + WS_VSSM) + (size_t)M_P * 512, (const bf16*)(wl + W_GLU), 512, nullptr);
        }
        SEAM(pb + P_PG);
        if (IN(pb + P_MERGE)) { PHASE_ENTER();
            pg8::Gemm g{(const bf16*)(ws + WS_OALL), (const bf16*)(wl + W_BR), M_P, DM, BR_W}; typedef pg8::StaticOrderT<M_P / 256, DM / 256> SO; SO S; S.init(M_P, DM, P.G, (int)blockIdx.x); S.tid = P.tid;
            pg8::EpiMerge E{ws, P.tid};
            pg8::gemm_phase<pg8::EpiMerge, SO, true, true>(P.lds + RING_OFF, g, S, E);
            REP_SKLOOP skinny_gemm<1>(P, (const bf16*)(ws + WS_OALL) + (size_t)M_P * BR_W, (const bf16*)(wl + W_BR), BR_W, nullptr);
        }
        SEAM(pb + P_MERGE);
        if (IN(pb + P_OUT)) { PHASE_ENTER();
            pg8::Gemm g{(const bf16*)(ws + WS_MG), (const bf16*)(wl + W_OUT), M_P, DM, DM}; typedef pg8::StaticOrderT<M_P / 256, DM / 256> SO; SO S; S.init(M_P, DM, P.G, (int)blockIdx.x); S.tid = P.tid;
            const void* rs = l == 0 ? (const void*)args.in[I_XS] : (const void*)((const bf16*)(ws + WS_XB) + (size_t)M_P * DM);
            pg8::EpiResid E{(const pg8::bf16_t*)(ws + WS_XB), ws, 1};
            pg8::gemm_phase<pg8::EpiResid, SO, true, true>(P.lds + RING_OFF, g, S, E);
            REP_SKLOOP skinny_gemm<0>(P, (const bf16*)(ws + WS_MG) + (size_t)M_P * DM, (const bf16*)(wl + W_OUT), DM, rs, l != 0, true);
        }
        SEAM(pb + P_OUT);
        if (IN(pb + P_LN1)) { PHASE_ENTER(); ln_rows(P, (const void*)(ws + WS_YF), true, args.in[I_LN1G] + (size_t)l * DM, args.in[I_LN1B] + (size_t)l * DM, nullptr, (bf16*)(ws + WS_XMB)); }
        SEAM(pb + P_LN1);
        if (IN(pb + P_UP)) { PHASE_ENTER();
            pg8::Gemm g{(const bf16*)(ws + WS_XMB), (const bf16*)(wl + W_UP), M_T, D_FF, DM}; typedef pg8::StaticOrderT<M_T / 256, D_FF / 256> SO; SO S; S.init(M_T, D_FF, P.G, (int)blockIdx.x); S.tid = P.tid;
            pg8::EpiUp E{ws};
            pg8::gemm_phase<pg8::EpiUp, SO, true, true>(P.lds + RING_OFF, g, S, E);
        }
        SEAM(pb + P_UP);
        if (IN(pb + P_DOWN)) { PHASE_ENTER();
            pg8::Gemm g{(const bf16*)(ws + WS_G), (const bf16*)(wl + W_DN), M_P, DM, D_FF}; typedef pg8::StaticOrderT<M_P / 256, DM / 256> SO; SO S; S.init(M_P, DM, P.G, (int)blockIdx.x); S.tid = P.tid;
            pg8::EpiResid E{(const pg8::bf16_t*)(ws + WS_XMB), ws, l + 1 < DEPTH ? 1 : 0};
            pg8::gemm_phase<pg8::EpiResid, SO, true, true>(P.lds + RING_OFF, g, S, E);
            REP_SKLOOP skinny_gemm<0>(P, (const bf16*)(ws + WS_G) + (size_t)M_P * D_FF, (const bf16*)(wl + W_DN), D_FF, (const bf16*)(ws + WS_XMB) + (size_t)M_P * DM, true, l + 1 < DEPTH);
        }
        SEAM(pb + P_DOWN);
        if (IN(pb + P_LN2)) { PHASE_ENTER();
            if (l + 1 < DEPTH) ln_rows(P, (const void*)(ws + WS_YF), true, args.in[I_LN2G] + (size_t)l * DM, args.in[I_LN2B] + (size_t)l * DM, nullptr, (bf16*)(ws + WS_XB));
            else ln_rows(P, (const void*)(ws + WS_YF), false, args.in[I_LN2G] + (size_t)l * DM, args.in[I_LN2B] + (size_t)l * DM, P.out + O_YP, nullptr);
        }
        SEAM(pb + P_LN2);
    }
#undef IN
#undef SEAM
}

extern "C" void kernel_launch(void* const* d_in, const int* in_sizes, int n_in, void* d_out, int out_size, void* d_ws, size_t ws_size, hipStream_t stream) {
    static int grid = 0;
    if (grid == 0) {
        if (n_in != 35 || (size_t)out_size != O_END || ws_size < WS_END) { fprintf(stderr, "kernel_launch: unexpected shapes: n_in %d out %d (want %zu) ws %zu (want %zu)\n", n_in, out_size, (size_t)O_END, ws_size, (size_t)WS_END); grid = -1; return; }
        int dev = 0, cus = 0, per_cu = 0;
        if (hipGetDevice(&dev) != hipSuccess || hipDeviceGetAttribute(&cus, hipDeviceAttributeMultiprocessorCount, dev) != hipSuccess) { grid = -1; return; }
        if (hipFuncSetAttribute((const void*)hse_fwd, hipFuncAttributeMaxDynamicSharedMemorySize, LDS_BYTES) != hipSuccess) { fprintf(stderr, "kernel_launch: hipFuncSetAttribute failed\n"); grid = -1; return; }
        if (hipOccupancyMaxActiveBlocksPerMultiprocessor(&per_cu, (const void*)hse_fwd, NWAVES * 64, LDS_BYTES) != hipSuccess || per_cu < 1) fprintf(stderr, "kernel_launch: occupancy query reports %d\n", per_cu);
        (void)hipGetLastError();
        grid = cus;
    }
    if (grid < 0) return;
    (void)hipMemsetAsync((char*)d_ws + WS_CTL, 0, CTL_ZERO_BYTES, stream);
    Args a{};
    for (int i = 0; i < 35; ++i) a.in[i] = (const float*)d_in[i];
    a.out = (float*)d_out; a.ws = (unsigned char*)d_ws; a.pad = 0;
#if MK_ONE_LAUNCH
    a.ph_lo = 0; a.ph_hi = NPH; a.li = 0;
    hipLaunchKernelGGL(hse_fwd, dim3(grid), dim3(NWAVES * 64), LDS_BYTES, stream, a);
#else
    for (int p = 0; p < NPH; ++p) { a.ph_lo = p; a.ph_hi = p + 1; a.li = p; hipLaunchKernelGGL(hse_fwd, dim3(grid), dim3(NWAVES * 64), LDS_BYTES, stream, a); }
#endif
}
```

```cpp
#include <hip/hip_runtime.h>
#include <hip/hip_bf16.h>
#include <cstdio>
#include <cstdint>
#include <cmath>

#define ATTN_DV128 1
#define KT_K 1
#define KT_V 1
#define REP_EPI 1
#define REP_GEMM 1
#define REP_THIN 1
#define REP_ATTN 1
#define REP_MIXA 1
#define REP_MIXC 1
#define REP_PRO 1
#define REP_WIN 1
#define REP_PG 1
#define REP_MERGE 1
#define REP_OUT 1
#define REP_UP 1
#define REP_DOWN 1
#define REP_SAMPLE 1

#ifndef MK_ONE_LAUNCH
#define MK_ONE_LAUNCH 1
#endif

constexpr int DM = 1024, NB_P = 2, SEQ = 16384, DEPTH = 2, NB_S = 16, SEQ_S = 32, PAST = 4096;
constexpr int M_P = NB_P * SEQ, M_S = NB_S * SEQ_S, M_T = M_P + M_S;
constexpr int N_IN = 9728, D_FF = 4096, BR_W = 2560;
constexpr int KS_ROWS = 4224;
constexpr int NCH_P = M_P / 64;
constexpr float LN_EPS = 1e-5f;
constexpr float DN_ALPHA = 1.41421356237309515f;

constexpr size_t O_YP = 0;
constexpr size_t O_YS = O_YP + (size_t)M_P * DM;
constexpr size_t O_KP = O_YS + (size_t)M_S * DM;
constexpr size_t O_VP = O_KP + (size_t)DEPTH * M_P * 1024;
constexpr size_t O_SRP = O_VP + (size_t)DEPTH * M_P * 1024;
constexpr size_t O_SIP = O_SRP + (size_t)DEPTH * NB_P * 2048;
constexpr size_t O_CP = O_SIP + (size_t)DEPTH * NB_P * 2048;
constexpr size_t O_PP = O_CP + (size_t)DEPTH * NB_P * 2 * 512;
constexpr size_t O_KS = O_PP + (size_t)DEPTH * NB_P * 15 * 512;
constexpr size_t O_VS = O_KS + (size_t)DEPTH * M_S * 1024;
constexpr size_t O_SRS = O_VS + (size_t)DEPTH * M_S * 1024;
constexpr size_t O_SIS = O_SRS + (size_t)DEPTH * NB_S * 2048;
constexpr size_t O_CS = O_SIS + (size_t)DEPTH * NB_S * 2048;
constexpr size_t O_PS = O_CS + (size_t)DEPTH * NB_S * 2 * 512;
constexpr size_t O_END = O_PS + (size_t)DEPTH * NB_S * 15 * 512;

constexpr size_t KiB = 1u << 10, MiB = 1u << 20;
constexpr size_t WS_CTL = 0, CTL_ZERO_BYTES = 64 * KiB;
constexpr size_t WS_W = 2 * MiB, W_LSTRIDE = 44 * MiB;
constexpr size_t W_IN = 0, W_BR = 19 * MiB, W_OUT = 24 * MiB, W_UP = 26 * MiB, W_DN = 34 * MiB, W_GLU = 42 * MiB, W_POOL = 42 * MiB + 512 * KiB;
constexpr size_t WS_ROPE = 90 * MiB;
constexpr size_t WS_SSMC = 91 * MiB, SSMC_LSTRIDE = 512 * KiB;
constexpr size_t SC_AB = 0, SC_A64 = 16 * KiB, SC_BB = 32 * KiB, SC_CM = 160 * KiB;
constexpr size_t WS_E = 92 * MiB, WS_H = 100 * MiB;
constexpr size_t WS_XB = 108 * MiB;
constexpr size_t WS_XF1 = 173 * MiB;
constexpr size_t WS_XMF = 303 * MiB, WS_XMB = 433 * MiB;
constexpr size_t WS_YF = 498 * MiB;
constexpr size_t WS_ZP = 628 * MiB, SZ_512 = (size_t)M_T * 512 * 2;
constexpr size_t WS_US = WS_ZP + SZ_512, WS_HC = WS_US + SZ_512, WS_BC = WS_HC + SZ_512, WS_CC = WS_BC + SZ_512, WS_UPOOL = WS_CC + SZ_512, WS_VSSM = WS_UPOOL + SZ_512;
constexpr size_t WS_Q = 856 * MiB, WS_K = 922 * MiB, WS_V = 986 * MiB;
constexpr size_t WS_KS = 1050 * MiB, WS_VS = 1182 * MiB;
constexpr size_t WS_G = 1314 * MiB;
constexpr size_t WS_OATT = 1574 * MiB;
constexpr size_t WS_OALL = 1704 * MiB;
constexpr size_t WS_MG = 1867 * MiB;
constexpr size_t WS_END = 1932 * MiB;
static_assert(WS_VSSM + SZ_512 <= WS_Q && WS_Q + (size_t)(M_T + 256) * 2048 <= WS_K && WS_KS + (size_t)NB_S * KS_ROWS * 2048 <= WS_VS && WS_VS + (size_t)NB_S * KS_ROWS * 2048 <= WS_G, "ws map 1");
static_assert(WS_G + (size_t)M_T * 8192 <= WS_OATT && WS_OATT + (size_t)M_T * 4096 <= WS_OALL && WS_OALL + (size_t)M_T * 5120 <= WS_MG && WS_MG + (size_t)M_T * 2048 <= WS_END, "ws map 2");
static_assert(WS_XB + (size_t)M_T * 2048 <= WS_XF1 && WS_XF1 + (size_t)M_T * 4096 <= WS_XMF && WS_XMF + (size_t)M_T * 4096 <= WS_XMB && WS_XMB + (size_t)M_T * 2048 <= WS_YF && WS_YF + (size_t)M_T * 4096 <= WS_ZP, "ws map 3");

#ifndef REP_EPI
#define REP_EPI 1
#endif
constexpr int EPI_REP = REP_EPI;
__device__ __forceinline__ int lane_id() { int l; asm volatile("v_mbcnt_lo_u32_b32 %0, -1, 0\n\tv_mbcnt_hi_u32_b32 %0, -1, %0" : "=v"(l)); return l; }
template <int X> __device__ __forceinline__ float swz_xor(float v) { return __int_as_float(__builtin_amdgcn_ds_swizzle(__float_as_int(v), 0x1f | (X << 10))); }
namespace pg8 {
#define PG8_LAS __attribute__((address_space(3)))
typedef unsigned short bf16_t;
typedef short bf16x8 __attribute__((ext_vector_type(8)));
typedef float f32x4 __attribute__((ext_vector_type(4)));
typedef unsigned u32x4 __attribute__((ext_vector_type(4)));
typedef unsigned u32x2 __attribute__((ext_vector_type(2)));
constexpr int BM = 256, BK = 64, HALF = 128, HTB = HALF * BK * 2  , STAGE_BYTES = 8 * HTB, NXCD = 8, WGM = 8;

__host__ __device__ __forceinline__ int lds_byte(int r, int c) { const int st = (r >> 4) * 2 + (c >> 5), rr = r & 15, cc = c & 31, ob = rr * 64 + cc * 2; return st * 1024 + (ob ^ (((ob >> 9) & 1) << 5)); }
__host__ __device__ __forceinline__ void stage_rc(int b, int& R, int& C) { const int st = b / 1024, sb = b % 1024, swz = sb ^ (((sb >> 9) & 1) << 5); R = (st >> 1) * 16 + swz / 64; C = (st & 1) * 32 + (swz % 64) / 2; }
__host__ __device__ __forceinline__ int perm32(int rho) { const int n = rho >> 4, i = rho & 15; return 8 * (i >> 2) + 4 * n + (i & 3); }

struct Unit { int pm, pn; };
struct Gemm { const bf16_t* A; const bf16_t* Bt; int M, N, K; };

template <int NM, int NN> struct StaticOrderT {
    static constexpr int nwg = NM * NN, TAIL = NM % WGM;
    static_assert(TAIL == 0 || TAIL == 1 || TAIL == 2 || TAIL == 4, "last row-panel group must be a power of two");
    int G, c, tid;
    __host__ __device__ void init(int, int, int G_, int c_) { G = G_; c = c_; tid = 0; }
    __host__ __device__ bool next(int i, Unit& u) const {
        const int L = i * G + c; if (L >= nwg) return false;
        int wgid = L; { constexpr int q = nwg / NXCD, r = nwg % NXCD; const int xcd = wgid % NXCD, off = wgid / NXCD; wgid = (xcd < r ? xcd * (q + 1) : r * (q + 1) + (xcd - r) * q) + off; }
        constexpr int nig = WGM * NN; const int gid = wgid / nig, fm = gid * WGM, x = wgid - gid * nig; const bool tail = (NM - fm) < WGM;
        const int sh = tail ? (TAIL == 4 ? 2 : TAIL == 2 ? 1 : 0) : 3;
        u.pm = fm + (x & ((1 << sh) - 1)); u.pn = x >> sh; return true;
    }
    __device__ __forceinline__ const char* abase(const Gemm& g, const Unit& u) const { return (const char*)g.A + (size_t)u.pm * (size_t)(BM * 2) * g.K; }
    __device__ __forceinline__ const char* bbase(const Gemm& g, const Unit& u) const { return (const char*)g.Bt + (size_t)u.pn * (size_t)(BM * 2) * g.K; }
    __device__ __forceinline__ void a_ready(const Unit&) const {}
    __device__ __forceinline__ void done(const Unit&) const {}
};
typedef float pkh_f2_t __attribute__((ext_vector_type(2))); typedef __bf16 pkh_b2_t __attribute__((ext_vector_type(2)));
__device__ __forceinline__ unsigned cvt_pk_bf16_hw(float lo, float hi);
__device__ __forceinline__ unsigned cvt_pk_bf16(float lo, float hi) { return cvt_pk_bf16_hw(lo, hi); }
__device__ __forceinline__ unsigned cvt_pk_bf16_hw(float lo, float hi) { const pkh_f2_t v = {lo, hi}; const pkh_b2_t b = __builtin_convertvector(v, pkh_b2_t); return __builtin_bit_cast(unsigned, b); }
__device__ __forceinline__ float bf_lo(unsigned w) { return __uint_as_float(w << 16); }
__device__ __forceinline__ float bf_hi(unsigned w) { return __uint_as_float(w & 0xffff0000u); }
__device__ __forceinline__ float fast_sigmoid(float x) { return __builtin_amdgcn_rcpf(1.0f + __builtin_amdgcn_exp2f(-1.4426950408889634f * x)); }

#define EPI_LOOP_ROWS for (int ai = 0; ai < 2; ++ai) _Pragma("unroll") for (int m = 0; m < 4; ++m)

struct EpiWin {
    static constexpr bool PERM = true, AFTER_DRAIN = false, MIDK = false, PROBE_REP = true; static constexpr bool PERM2 = false;
    unsigned char* ws; float* out; int l; float qscale;
    static __device__ __forceinline__ u32x4 pack8(const f32x4 v0, const f32x4 v1) { u32x4 w; w.x = cvt_pk_bf16_hw(v0[0], v0[1]); w.y = cvt_pk_bf16_hw(v0[2], v0[3]); w.z = cvt_pk_bf16_hw(v1[0], v1[1]); w.w = cvt_pk_bf16_hw(v1[2], v1[3]); return w; }
    template <bool GATE> __device__ __forceinline__ void plain(const f32x4 (&acc)[2][2][4][2], bf16_t* base, int ld, int row0, int col) const {
#pragma unroll
        EPI_LOOP_ROWS { bf16_t* rowp = base + (size_t)(row0 + ai * HALF + m * 16) * ld + col;
#pragma unroll
            for (int bj = 0; bj < 2; ++bj) { f32x4 v0 = acc[ai][bj][m][0], v1 = acc[ai][bj][m][1];
                if (GATE) {
#pragma unroll
                    for (int e = 0; e < 4; ++e) { v0[e] = fast_sigmoid(v0[e]); v1[e] = fast_sigmoid(v1[e]); } }
                *(u32x4*)(rowp + bj * HALF) = pack8(v0, v1); } }
    }
    __device__ __forceinline__ void gates(const f32x4 (&acc)[2][2][4][2], const Unit& u, int wave, int lane, int row0, int c8) const {
        const bool smp = u.pm >= M_P / BM;
        bf16_t* base = smp ? (bf16_t*)(ws + WS_G) + (size_t)row0 * 4096 + (u.pn - 22) * BM + c8 : (bf16_t*)(ws + WS_G) + ((size_t)u.pm * 16 + (u.pn - 22)) * 65536 + (size_t)(wave * 1024 + lane) * 8;
        const int sA = smp ? HALF * 4096 : 4096, sM = smp ? 16 * 4096 : 1024, sB = smp ? HALF : 512;
#pragma unroll
        EPI_LOOP_ROWS {
#pragma unroll
            for (int bj = 0; bj < 2; ++bj) { f32x4 v0 = acc[ai][bj][m][0], v1 = acc[ai][bj][m][1];
#pragma unroll
                for (int e = 0; e < 4; ++e) { v0[e] = fast_sigmoid(v0[e]); v1[e] = fast_sigmoid(v1[e]); }
                *(u32x4*)(base + (size_t)(ai * sA + m * sM + bj * sB)) = pack8(v0, v1); } }
    }
    template <int KIND, bool ROT> __device__ __forceinline__ void qkv(const f32x4 (&acc)[2][2][4][2], const Unit& u, int row0, int colt, int c8, int fq) const {
        const bool smp = u.pm >= M_P / BM;
        const float sg = fq == 0 ? -1.f : 1.f; const bool act = fq < 2;
#pragma unroll
        for (int ai = 0; ai < 2; ++ai) {
        f32x4 rt[4][4];
        if (ROT) {
#pragma unroll
            for (int m = 0; m < 4; ++m) { const int row = row0 + ai * HALF + m * 16, loc = row - M_P; const int pos = smp ? PAST + (loc & 31) : (row & (SEQ - 1)); const f32x4* rp = (const f32x4*)(ws + WS_ROPE) + (size_t)pos * 4;
                rt[m][0] = rp[0]; rt[m][1] = rp[1]; rt[m][2] = rp[2]; rt[m][3] = rp[3]; }
            __builtin_amdgcn_sched_barrier(0); }
#pragma unroll
        for (int m = 0; m < 4; ++m) {
            const int row = row0 + ai * HALF + m * 16, loc = row - M_P;
            f32x4 cs0, cs1, sn0, sn1;
            if (ROT) { cs0 = rt[m][0]; cs1 = rt[m][1]; sn0 = rt[m][2]; sn1 = rt[m][3];
#pragma unroll
                for (int e = 0; e < 4; ++e) { cs0[e] = act ? cs0[e] : 1.f; cs1[e] = act ? cs1[e] : 1.f; sn0[e] = act ? sg * sn0[e] : 0.f; sn1[e] = act ? sg * sn1[e] : 0.f; } }
            float* of = nullptr; bf16_t* ob;
            if (KIND == 0) ob = (bf16_t*)(ws + WS_Q) + (size_t)row * 1024 + colt + c8;
            else { const size_t fo = smp ? (KIND == 1 ? O_KS : O_VS) + (size_t)l * M_S * 1024 + (size_t)loc * 1024 : (KIND == 1 ? O_KP : O_VP) + (size_t)l * M_P * 1024 + (size_t)row * 1024;
                of = out + fo + colt + c8;
                ob = smp ? (bf16_t*)(ws + (KIND == 1 ? WS_KS : WS_VS)) + ((size_t)(loc >> 5) * KS_ROWS + PAST + (loc & 31)) * 1024 + colt + c8 : (bf16_t*)(ws + (KIND == 1 ? WS_K : WS_V)) + (size_t)row * 1024 + colt + c8; }
#pragma unroll
            for (int bj = 0; bj < 2; ++bj) { f32x4 v0 = acc[ai][bj][m][0], v1 = acc[ai][bj][m][1];
                if (ROT) { f32x4 p0, p1;
#pragma unroll
                    for (int e = 0; e < 4; ++e) { p0[e] = swz_xor<16>(v0[e]); p1[e] = swz_xor<16>(v1[e]); }
                    v0 = v0 * cs0 + p0 * sn0; v1 = v1 * cs1 + p1 * sn1; }
                if (KIND == 0) { v0 = v0 * qscale; v1 = v1 * qscale; }
                else { *(f32x4*)(of + bj * HALF) = v0; *(f32x4*)(of + bj * HALF + 4) = v1; }
                bf16_t* o2 = ob + bj * HALF;
                if (((KIND == 1 && KT_K) || (KIND == 2 && KT_V)) && !smp) {
                    const int col = colt + bj * HALF + c8, bt = row >> 14, tile = (row & (SEQ - 1)) >> 6, r = row & 63;
                    o2 = KIND == 1 ? (bf16_t*)(ws + WS_K) + ((((size_t)(bt * 16 + (col >> 6)) * 256 + tile) * 8 + ((col >> 3) & 7)) * 64 + r) * 8
                                   : (bf16_t*)(ws + WS_V) + ((((size_t)(bt * 8 + (col >> 7)) * 256 + tile) * 4 + ((col >> 5) & 3)) * 64 + r) * 32 + (col & 31); }
                *(u32x4*)o2 = pack8(v0, v1); } }
        }
    }
    __device__ __forceinline__ void operator()(const f32x4 (&acc)[2][2][4][2], const Unit& u, int wr, int wc, int fr, int fq) const {
        { const int ln_ = lane_id(); fr = ln_ & 15; fq = ln_ >> 4; }
        const int pn = u.pn, row0 = u.pm * BM + wr * 64 + fr, c8 = wc * 32 + 8 * fq;
        if (pn < 10) plain<false>(acc, (bf16_t*)(ws + WS_ZP + (size_t)(pn >> 1) * SZ_512), 512, row0, (pn & 1) * BM + c8);
        else if (pn >= 22) gates(acc, u, wr * 4 + wc, fq * 16 + fr, row0, c8);
        else { const bool rot = (wc & 1) == 0;
            if (pn < 14) { if (rot) qkv<0, true>(acc, u, row0, (pn - 10) * BM, c8, fq); else qkv<0, false>(acc, u, row0, (pn - 10) * BM, c8, fq); }
            else if (pn < 18) { if (rot) qkv<1, true>(acc, u, row0, (pn - 14) * BM, c8, fq); else qkv<1, false>(acc, u, row0, (pn - 14) * BM, c8, fq); }
            else qkv<2, false>(acc, u, row0, (pn - 18) * BM, c8, fq); }
    }
};

struct EpiGlu {
    static constexpr bool PERM = true, AFTER_DRAIN = false, MIDK = false; static constexpr bool PROBE_REP = false; static constexpr bool PERM2 = false;
    unsigned char* ws;
    __device__ __forceinline__ void operator()(const f32x4 (&acc)[2][2][4][2], const Unit& u, int wr, int wc, int fr, int fq) const {
        { const int ln_ = lane_id(); fr = ln_ & 15; fq = ln_ >> 4; }
        const int row0 = u.pm * BM + wr * 64 + fr, c8 = wc * 32 + 8 * fq, colt = u.pn * BM;
        u32x4 vv[2][4][2];
#pragma unroll
        EPI_LOOP_ROWS {
#pragma unroll
            for (int bj = 0; bj < 2; ++bj) vv[ai][m][bj] = *(const u32x4*)((const bf16_t*)(ws + WS_VSSM) + (size_t)(row0 + ai * HALF + m * 16) * 512 + colt + bj * HALF + c8); }
        __builtin_amdgcn_sched_barrier(0);
#pragma unroll
        EPI_LOOP_ROWS { const int row = row0 + ai * HALF + m * 16;
#pragma unroll
            for (int bj = 0; bj < 2; ++bj) { f32x4 v0 = acc[ai][bj][m][0], v1 = acc[ai][bj][m][1]; const int col = colt + bj * HALF + c8; const u32x4 x = vv[ai][m][bj];
#pragma unroll
                for (int e = 0; e < 4; ++e) { v0[e] = fast_sigmoid(v0[e]); v1[e] = fast_sigmoid(v1[e]); }
                v0[0] *= bf_lo(x.x); v0[1] *= bf_hi(x.x); v0[2] *= bf_lo(x.y); v0[3] *= bf_hi(x.y); v1[0] *= bf_lo(x.z); v1[1] *= bf_hi(x.z); v1[2] *= bf_lo(x.w); v1[3] *= bf_hi(x.w);
                u32x4 w; w.x = cvt_pk_bf16(v0[0], v0[1]); w.y = cvt_pk_bf16(v0[2], v0[3]); w.z = cvt_pk_bf16(v1[0], v1[1]); w.w = cvt_pk_bf16(v1[2], v1[3]);
                *(u32x4*)((bf16_t*)(ws + WS_OALL) + (size_t)row * BR_W + 512 + col) = w; } }
    }
};

struct EpiMerge {
    static constexpr bool PERM = true, AFTER_DRAIN = false, MIDK = true; static constexpr bool PROBE_REP = false; static constexpr bool PERM2 = false;
    unsigned char* ws; int tid;
    template <bool DEN> __device__ __forceinline__ void scale(f32x4 (&acc)[2][2][4][2], const Unit& u, int wr, int wc, int fr, int fq, int bnum, int bden) const {
        int tid_ = tid; asm volatile("" : "+v"(tid_));
        { const int l_ = tid_ & 63, w_ = tid_ >> 6; fr = l_ & 15; fq = l_ >> 4; wr = w_ >> 2; wc = w_ & 3; }
        const int wave = wr * 4 + wc, lane = fq * 16 + fr;
        const bf16_t* gb = (const bf16_t*)(ws + WS_G) + ((size_t)u.pm * 16 + u.pn) * 65536 + (size_t)(wave * 1024 + lane) * 8;
#pragma unroll
        for (int ai = 0; ai < 2; ++ai) {
            u32x4 ga[4][2], gd[4][2];
#pragma unroll
            for (int m = 0; m < 4; ++m)
#pragma unroll
                for (int bj = 0; bj < 2; ++bj) { const bf16_t* gp = gb + (size_t)(ai * 4096 + m * 1024 + bj * 512);
                    ga[m][bj] = *(const u32x4*)(gp + (size_t)bnum * 262144); if (DEN) gd[m][bj] = *(const u32x4*)(gp + (size_t)bden * 262144); }
            __builtin_amdgcn_sched_barrier(0);
#pragma unroll
            for (int m = 0; m < 4; ++m)
#pragma unroll
                for (int bj = 0; bj < 2; ++bj) { const u32x4 a = ga[m][bj];
                    f32x4 r0 = {bf_lo(a.x), bf_hi(a.x), bf_lo(a.y), bf_hi(a.y)}, r1 = {bf_lo(a.z), bf_hi(a.z), bf_lo(a.w), bf_hi(a.w)};
                    if (DEN) { const u32x4 b = gd[m][bj];
                        r0[0] *= __builtin_amdgcn_rcpf(bf_lo(b.x)); r0[1] *= __builtin_amdgcn_rcpf(bf_hi(b.x)); r0[2] *= __builtin_amdgcn_rcpf(bf_lo(b.y)); r0[3] *= __builtin_amdgcn_rcpf(bf_hi(b.y));
                        r1[0] *= __builtin_amdgcn_rcpf(bf_lo(b.z)); r1[1] *= __builtin_amdgcn_rcpf(bf_hi(b.z)); r1[2] *= __builtin_amdgcn_rcpf(bf_lo(b.w)); r1[3] *= __builtin_amdgcn_rcpf(bf_hi(b.w)); }
                    acc[ai][bj][m][0] *= r0; acc[ai][bj][m][1] *= r1; }
            __builtin_amdgcn_sched_barrier(0);
        }
    }
    __device__ __forceinline__ void mid(f32x4 (&acc)[2][2][4][2], const Unit& u, int wr, int wc, int fr, int fq, int t) const {
        if (t == 8 || t == 16 || t == 24) scale<true>(acc, u, wr, wc, fr, fq, (t >> 3) - 1, t >> 3);
    }
    __device__ __forceinline__ void operator()(f32x4 (&acc)[2][2][4][2], const Unit& u, int wr, int wc, int fr, int fq) const {
        { const int ln_ = lane_id(); fr = ln_ & 15; fq = ln_ >> 4; }
        scale<false>(acc, u, wr, wc, fr, fq, 3, -1);
        int row0 = u.pm * BM + wr * 64 + fr; const int c8 = wc * 32 + 8 * fq;
        asm volatile("" : "+v"(row0));
#pragma unroll
        EPI_LOOP_ROWS { bf16_t* rowp = (bf16_t*)(ws + WS_MG) + (size_t)(row0 + ai * HALF + m * 16) * 1024 + u.pn * BM + c8;
#pragma unroll
            for (int bj = 0; bj < 2; ++bj) { const f32x4 v0 = acc[ai][bj][m][0], v1 = acc[ai][bj][m][1];
                u32x4 w; w.x = cvt_pk_bf16(v0[0], v0[1]); w.y = cvt_pk_bf16(v0[2], v0[3]); w.z = cvt_pk_bf16(v1[0], v1[1]); w.w = cvt_pk_bf16(v1[2], v1[3]);
                *(u32x4*)(rowp + bj * HALF) = w; } }
    }
};

struct EpiResid {
    static constexpr bool PERM = true, AFTER_DRAIN = false, MIDK = false; static constexpr bool PROBE_REP = false; static constexpr bool PERM2 = false;
    const bf16_t* resP; unsigned char* ws; int ybf;
    __device__ __forceinline__ void operator()(const f32x4 (&acc)[2][2][4][2], const Unit& u, int wr, int wc, int fr, int fq) const {
        { const int ln_ = lane_id(); fr = ln_ & 15; fq = ln_ >> 4; }
        const int row0 = u.pm * BM + wr * 64 + fr, col0 = u.pn * BM + wc * 32 + 8 * fq;
        u32x4 rr[2][4][2];
#pragma unroll
        EPI_LOOP_ROWS {
#pragma unroll
            for (int bj = 0; bj < 2; ++bj) rr[ai][m][bj] = *(const u32x4*)(resP + (size_t)(row0 + ai * HALF + m * 16) * 1024 + col0 + bj * HALF); }
        __builtin_amdgcn_sched_barrier(0);
#pragma unroll
        EPI_LOOP_ROWS { const size_t yo = (size_t)(row0 + ai * HALF + m * 16) * 1024 + col0;
#pragma unroll
            for (int bj = 0; bj < 2; ++bj) { const u32x4 w = rr[ai][m][bj];
                const f32x4 y0 = (f32x4){bf_lo(w.x), bf_hi(w.x), bf_lo(w.y), bf_hi(w.y)} * DN_ALPHA + acc[ai][bj][m][0], y1 = (f32x4){bf_lo(w.z), bf_hi(w.z), bf_lo(w.w), bf_hi(w.w)} * DN_ALPHA + acc[ai][bj][m][1];
                if (ybf) { u32x4 o; o.x = cvt_pk_bf16(y0[0], y0[1]); o.y = cvt_pk_bf16(y0[2], y0[3]); o.z = cvt_pk_bf16(y1[0], y1[1]); o.w = cvt_pk_bf16(y1[2], y1[3]); *(u32x4*)((bf16_t*)(ws + WS_YF) + yo + bj * HALF) = o; }
                else { *(f32x4*)((float*)(ws + WS_YF) + yo + bj * HALF) = y0; *(f32x4*)((float*)(ws + WS_YF) + yo + bj * HALF + 4) = y1; } } }
    }
};

struct EpiUp {
    static constexpr bool PERM = true, AFTER_DRAIN = false, MIDK = false; static constexpr bool PROBE_REP = false; static constexpr bool PERM2 = false;
    unsigned char* ws;
    __device__ __forceinline__ void operator()(const f32x4 (&acc)[2][2][4][2], const Unit& u, int wr, int wc, int fr, int fq) const {
        { const int ln_ = lane_id(); fr = ln_ & 15; fq = ln_ >> 4; }
        const int row0 = u.pm * BM + wr * 64 + fr, c8 = wc * 32 + 8 * fq;
#pragma unroll
        EPI_LOOP_ROWS { bf16_t* rowp = (bf16_t*)(ws + WS_G) + (size_t)(row0 + ai * HALF + m * 16) * D_FF + u.pn * BM + c8;
#pragma unroll
            for (int bj = 0; bj < 2; ++bj) { f32x4 v0 = acc[ai][bj][m][0], v1 = acc[ai][bj][m][1];
#pragma unroll
                for (int e = 0; e < 4; ++e) { const float a = fmaxf(v0[e], 0.f), b = fmaxf(v1[e], 0.f); v0[e] = a * a; v1[e] = b * b; }
                u32x4 w; w.x = cvt_pk_bf16(v0[0], v0[1]); w.y = cvt_pk_bf16(v0[2], v0[3]); w.z = cvt_pk_bf16(v1[0], v1[1]); w.w = cvt_pk_bf16(v1[2], v1[3]);
                *(u32x4*)(rowp + bj * HALF) = w; } }
    }
};

template <class Epi, class Sched, bool ALIGN_EPI = false, bool SP2 = false>
__device__ __forceinline__ void gemm_phase(PG8_LAS unsigned char* lds, const Gemm g, const Sched& S, const Epi& E) {
    int tid0_ = S.tid; asm volatile("" : "+v"(tid0_));
    const int tid = tid0_, wid = __builtin_amdgcn_readfirstlane(tid >> 6), lane = tid & 63, wr = wid >> 2, wc = wid & 3, fr = lane & 15, fq = lane >> 4;
    const int K = g.K, nt = K / BK;
    unsigned voffA[2], voffB[2];
#pragma unroll
    for (int i = 0; i < 2; ++i) { int R, C; stage_rc(tid * 16 + i * 8192, R, C); const int Rb = Epi::PERM2 ? ((R >> 5) * 64 + perm32(R & 31)) : Epi::PERM ? ((R & ~31) + perm32(R & 31)) : R;
        voffA[i] = (unsigned)(R * K + C) * 2u; voffB[i] = (unsigned)(Rb * K + C) * 2u; }
    const size_t kstep = (size_t)(BK * 2);
    const size_t hstepB = Epi::PERM2 ? (size_t)32 * K * 2 : (size_t)HALF * K * 2;
    const size_t hstep = (size_t)HALF * K * 2;
    const unsigned ldsw = (unsigned)wid * 1024u;
    const int aoff = lds_byte(wr * 64 + fr, fq * 8), boff = lds_byte(wc * 32 + fr, fq * 8);
#define PG8_SA(b, h) (((b) * 2 + (h)) * HTB)
#define PG8_SB(b, h) ((4 + (b) * 2 + (h)) * HTB)
#define PG8_STAGE(bufoff, gbase, voff) do { _Pragma("unroll") for (int _i = 0; _i < 2; ++_i) \
        __builtin_amdgcn_global_load_lds((const unsigned*)((const char*)(gbase) + (voff)[_i]), (PG8_LAS unsigned*)(lds + (bufoff) + ldsw + _i * 8192), 16, 0, 0); } while (0)
#define PG8_LDA(dst, b, h) do { _Pragma("unroll") for (int m = 0; m < 4; ++m) _Pragma("unroll") for (int k = 0; k < 2; ++k) dst[m][k] = *(const PG8_LAS bf16x8*)(lds + PG8_SA(b, h) + aoff + m * 2048 + k * 1024); } while (0)
#define PG8_LDB(dst, b, h) do { _Pragma("unroll") for (int n = 0; n < 2; ++n) _Pragma("unroll") for (int k = 0; k < 2; ++k) dst[n][k] = *(const PG8_LAS bf16x8*)(lds + PG8_SB(b, h) + boff + n * 2048 + k * 1024); } while (0)
#define PG8_MMA(ai, bj, At, Bt) do { __builtin_amdgcn_s_setprio(1); _Pragma("unroll") for (int m = 0; m < 4; ++m) _Pragma("unroll") for (int n = 0; n < 2; ++n) _Pragma("unroll") for (int k = 0; k < 2; ++k) \
        acc[ai][bj][m][n] = __builtin_amdgcn_mfma_f32_16x16x32_bf16(Bt[n][k], At[m][k], acc[ai][bj][m][n], 0, 0, 0); __builtin_amdgcn_s_setprio(0); } while (0)
#define PG8_WAIT_V(n) asm volatile("s_waitcnt vmcnt(" #n ")" ::: "memory")
#define PG8_WAIT_L(n) asm volatile("s_waitcnt lgkmcnt(" #n ")" ::: "memory")
#define PG8_BAR __builtin_amdgcn_s_barrier()
#define PG8_SCHED __builtin_amdgcn_sched_barrier(0)
    Unit cur, nxt; int ui = 0;
    if (!S.next(0, cur)) return;
    f32x4 acc[2][2][4][2];
#pragma unroll
    for (int a = 0; a < 2; ++a)
#pragma unroll
        for (int b = 0; b < 2; ++b)
#pragma unroll
            for (int m = 0; m < 4; ++m)
#pragma unroll
                for (int n = 0; n < 2; ++n) acc[a][b][m][n] = (f32x4){0.f, 0.f, 0.f, 0.f};
    bf16x8 At[4][2], B0[2][2], B1[2][2];
    const char* cA = S.abase(g, cur); const char* cB = S.bbase(g, cur);
    S.a_ready(cur);
    if constexpr (SP2) {
        PG8_STAGE(PG8_SB(0, 0), cB, voffB); PG8_STAGE(PG8_SB(0, 1), cB + hstepB, voffB); PG8_STAGE(PG8_SA(0, 0), cA, voffA); PG8_STAGE(PG8_SA(0, 1), cA + hstep, voffA);
        if (wr == 1) PG8_BAR;
        PG8_WAIT_V(2); PG8_BAR;
        PG8_STAGE(PG8_SB(1, 0), cB + kstep, voffB); PG8_STAGE(PG8_SA(1, 0), cA + kstep, voffA); PG8_STAGE(PG8_SB(1, 1), cB + hstepB + kstep, voffB);
        PG8_WAIT_V(6); PG8_BAR;
    } else {
        PG8_STAGE(PG8_SB(0, 0), cB, voffB); PG8_STAGE(PG8_SA(0, 0), cA, voffA); PG8_STAGE(PG8_SB(0, 1), cB + hstepB, voffB); PG8_STAGE(PG8_SA(0, 1), cA + hstep, voffA);
        if (wr == 1) PG8_BAR;
        PG8_WAIT_V(4); PG8_BAR;
        PG8_STAGE(PG8_SB(1, 0), cB + kstep, voffB); PG8_STAGE(PG8_SA(1, 0), cA + kstep, voffA); PG8_STAGE(PG8_SB(1, 1), cB + hstepB + kstep, voffB);
        PG8_WAIT_V(6); PG8_BAR;
    }
    for (;;) {
        const bool has_next = S.next(ui + 1, nxt);
        const char* nA = has_next ? S.abase(g, nxt) : cA; const char* nB = has_next ? S.bbase(g, nxt) : cB;
        for (int t = 0; t < nt; t += 2) {
            const bool last = (t == nt - 2);
            const char* a1 = cA + (size_t)(t + 1) * kstep;
            const char* a2 = last ? nA : cA + (size_t)(t + 2) * kstep; const char* b2 = last ? nB : cB + (size_t)(t + 2) * kstep;
            const char* a3 = a2 + kstep; const char* b3 = b2 + kstep;
            if (last && has_next) S.a_ready(nxt);
            if constexpr (Epi::MIDK) E.mid(acc, cur, wr, wc, fr, fq, t);
            if constexpr (SP2) {
            PG8_LDB(B0, 0, 0); PG8_LDB(B1, 0, 1); PG8_SCHED; PG8_LDA(At, 0, 0); PG8_STAGE(PG8_SA(1, 1), a1 + hstep, voffA);
            PG8_WAIT_V(8); PG8_WAIT_L(0); PG8_BAR; PG8_MMA(0, 0, At, B0); PG8_MMA(0, 1, At, B1); PG8_BAR; PG8_SCHED;
            PG8_LDA(At, 0, 1); PG8_STAGE(PG8_SB(0, 0), b2, voffB); PG8_STAGE(PG8_SB(0, 1), b2 + hstepB, voffB); PG8_STAGE(PG8_SA(0, 0), a2, voffA);
            PG8_WAIT_V(8); PG8_WAIT_L(0); PG8_BAR; PG8_MMA(1, 0, At, B0); PG8_MMA(1, 1, At, B1); PG8_BAR; PG8_SCHED;
            PG8_LDB(B0, 1, 0); PG8_LDB(B1, 1, 1); PG8_SCHED; PG8_LDA(At, 1, 0); PG8_STAGE(PG8_SA(0, 1), a2 + hstep, voffA);
            PG8_WAIT_V(8); PG8_WAIT_L(0); PG8_BAR; PG8_MMA(0, 0, At, B0); PG8_MMA(0, 1, At, B1); PG8_BAR; PG8_SCHED;
            PG8_LDA(At, 1, 1); PG8_STAGE(PG8_SB(1, 0), b3, voffB); PG8_STAGE(PG8_SB(1, 1), b3 + hstepB, voffB); PG8_STAGE(PG8_SA(1, 0), a3, voffA);
            PG8_WAIT_V(8); PG8_WAIT_L(0); PG8_BAR; PG8_MMA(1, 0, At, B0); PG8_MMA(1, 1, At, B1); PG8_BAR; PG8_SCHED;
            } else {
            PG8_LDB(B0, 0, 0); PG8_SCHED; PG8_LDA(At, 0, 0); PG8_STAGE(PG8_SA(1, 1), a1 + hstep, voffA);
            PG8_WAIT_L(8); PG8_BAR; PG8_WAIT_L(0); PG8_MMA(0, 0, At, B0); PG8_BAR; PG8_SCHED;
            PG8_LDB(B1, 0, 1); PG8_STAGE(PG8_SB(0, 0), b2, voffB);
            PG8_BAR; PG8_WAIT_L(0); PG8_MMA(0, 1, At, B1); PG8_BAR;
            PG8_LDA(At, 0, 1); PG8_STAGE(PG8_SA(0, 0), a2, voffA);
            PG8_BAR; PG8_WAIT_L(0); PG8_MMA(1, 0, At, B0); PG8_BAR; PG8_SCHED;
            PG8_STAGE(PG8_SB(0, 1), b2 + hstepB, voffB);
            PG8_WAIT_V(6); PG8_BAR; PG8_MMA(1, 1, At, B1); PG8_BAR;
            PG8_LDB(B0, 1, 0); PG8_SCHED; PG8_LDA(At, 1, 0); PG8_STAGE(PG8_SA(0, 1), a2 + hstep, voffA);
            PG8_WAIT_L(8); PG8_BAR; PG8_WAIT_L(0); PG8_MMA(0, 0, At, B0); PG8_BAR; PG8_SCHED;
            PG8_LDB(B1, 1, 1); PG8_STAGE(PG8_SB(1, 0), b3, voffB);
            PG8_BAR; PG8_WAIT_L(0); PG8_MMA(0, 1, At, B1); PG8_BAR;
            PG8_LDA(At, 1, 1); PG8_STAGE(PG8_SA(1, 0), a3, voffA);
            PG8_BAR; PG8_WAIT_L(0); PG8_MMA(1, 0, At, B0); PG8_BAR; PG8_SCHED;
            PG8_STAGE(PG8_SB(1, 1), b3 + hstepB, voffB);
            PG8_WAIT_V(6); PG8_BAR; PG8_MMA(1, 1, At, B1); PG8_BAR;
            }
        }
        if constexpr (ALIGN_EPI) { if (wr == 0) PG8_BAR; }
        if constexpr (!Epi::AFTER_DRAIN) { E(acc, cur, wr, wc, fr, fq); if constexpr (EPI_REP > 1 && Epi::PROBE_REP) { _Pragma("unroll 1") for (int e_ = 1; e_ < EPI_REP; ++e_) { asm volatile("" ::: "memory"); E(acc, cur, wr, wc, fr, fq); } } S.done(cur); }
        if (!has_next) break;
#pragma unroll
        for (int a = 0; a < 2; ++a)
#pragma unroll
            for (int b = 0; b < 2; ++b)
#pragma unroll
                for (int m = 0; m < 4; ++m)
#pragma unroll
                    for (int n = 0; n < 2; ++n) acc[a][b][m][n] = (f32x4){0.f, 0.f, 0.f, 0.f};
        cur = nxt; cA = nA; cB = nB; ++ui;
        if constexpr (ALIGN_EPI) { if (wr == 1) PG8_BAR; }
    }
    PG8_WAIT_V(0);
    if constexpr (!ALIGN_EPI) { if (wr == 0) PG8_BAR; }
    PG8_BAR;
    if constexpr (Epi::AFTER_DRAIN) { E.fused(acc, cur, wr, wc, fr, fq, lds, wid, lane); S.done(cur); }
#undef PG8_SA
#undef PG8_SB
#undef PG8_STAGE
#undef PG8_LDA
#undef PG8_LDB
#undef PG8_MMA
#undef PG8_WAIT_V
#undef PG8_WAIT_L
#undef PG8_BAR
#undef PG8_SCHED
}
}

#include <hip/hip_bf16.h>
#include <cmath>
namespace attn_body {
using bf16=__hip_bfloat16;
using bf16x8=__attribute__((ext_vector_type(8)))short;
using s16x4=__attribute__((ext_vector_type(4)))short;
using f32x16=__attribute__((ext_vector_type(16)))float;
using u32x4=__attribute__((ext_vector_type(4)))unsigned;
constexpr int D=64,DM=1024,OPITCH=2048;
constexpr int NW=8,QBLK=32,QB=QBLK*NW,KVBLK=64;
constexpr int ATTN_UNIT_ROWS=QB;
__device__ __forceinline__ int crow(int r,int hi){return (r&3)+8*(r>>2)+4*hi;}
#define SBAR() __builtin_amdgcn_sched_barrier(0)
__device__ __forceinline__ void bmask(f32x16&p0,f32x16&p1,int jb,int wid,int mode){
  const float NEG=-INFINITY; bool m0,m1;
  if(mode==0){ m0=jb>(wid>>1); m1=m0; } else { m0=(jb==3); m1=(jb>=2); }
  if(m0){
    #pragma unroll
    for(int r=0;r<16;++r)p0[r]=NEG; }
  if(m1){
    #pragma unroll
    for(int r=0;r<16;++r)p1[r]=NEG; }
}

constexpr int NSLOT=3, SLOTB=8192;
constexpr int LDS_K=0, LDS_V=NSLOT*SLOTB, LDS_WS=3*NSLOT*SLOTB, LDS_OST=LDS_WS+NW*64*4, LDS_BYTES=LDS_OST+NW*4096;
constexpr float C2=0.125f*1.4426950408889634f;
__device__ __forceinline__ void glds16(const void*gsrc,unsigned lds_dst){unsigned keep;
  asm volatile("s_mov_b32 %0, m0\n\ts_mov_b32 m0, %2\n\ts_nop 0\n\tglobal_load_lds_dwordx4 %1, off\n\ts_mov_b32 m0, %0":"=&s"(keep):"v"(gsrc),"s"(lds_dst):"memory");}
__device__ __forceinline__ float max3f(float a,float b,float c){float r;asm("v_max3_f32 %0, %1, %2, %3":"=v"(r):"v"(a),"v"(b),"v"(c));return r;}
__device__ __forceinline__ float max2f(float a,float b){float r;asm("v_max_f32_e32 %0, %1, %2":"=v"(r):"v"(a),"v"(b));return r;}
__device__ __forceinline__ float fadd_s(float a,float b){float r;asm("v_add_f32_e32 %0, %1, %2":"=v"(r):"v"(a),"v"(b));return r;}
__device__ __forceinline__ float fsub_s(float a,float b){float r;asm("v_sub_f32_e32 %0, %1, %2":"=v"(r):"v"(a),"v"(b));return r;}
typedef float f32x2_t __attribute__((ext_vector_type(2))); typedef __bf16 bf16x2_t __attribute__((ext_vector_type(2)));
__device__ __forceinline__ unsigned cvtpk_s(float lo,float hi){f32x2_t v={lo,hi};bf16x2_t b=__builtin_convertvector(v,bf16x2_t);return __builtin_bit_cast(unsigned,b);}
#define WAIT_BAR(N) asm volatile("s_waitcnt vmcnt(" #N ") lgkmcnt(0)\n\ts_barrier":::"memory")

__device__ __forceinline__ void qkt(f32x16&p0,f32x16&p1,const char*Kslot,const bf16x8*qr,const f32x16&negm,int r32,int hi){
  const char*kb=Kslot+hi*1024+r32*16;
  #pragma unroll
  for(int d0=0;d0<4;++d0){
    const bf16x8 b0=*reinterpret_cast<const bf16x8*>(kb+d0*2048);
    const bf16x8 b1=*reinterpret_cast<const bf16x8*>(kb+d0*2048+512);
    if(d0==0){p0=__builtin_amdgcn_mfma_f32_32x32x16_bf16(b0,qr[0],negm,0,0,0);p1=__builtin_amdgcn_mfma_f32_32x32x16_bf16(b1,qr[0],negm,0,0,0);}
    else{p0=__builtin_amdgcn_mfma_f32_32x32x16_bf16(b0,qr[d0],p0,0,0,0);p1=__builtin_amdgcn_mfma_f32_32x32x16_bf16(b1,qr[d0],p1,0,0,0);}}
}
typedef __attribute__((address_space(3))) const char* lds_cptr;
typedef short v4i16_t __attribute__((ext_vector_type(4)));
__device__ __forceinline__ void kload8(bf16x8*kf,lds_cptr kp){
  kf[0]=*(const __attribute__((address_space(3))) bf16x8*)(kp);      kf[1]=*(const __attribute__((address_space(3))) bf16x8*)(kp+512);
  kf[2]=*(const __attribute__((address_space(3))) bf16x8*)(kp+2048); kf[3]=*(const __attribute__((address_space(3))) bf16x8*)(kp+2560);
  kf[4]=*(const __attribute__((address_space(3))) bf16x8*)(kp+4096); kf[5]=*(const __attribute__((address_space(3))) bf16x8*)(kp+4608);
  kf[6]=*(const __attribute__((address_space(3))) bf16x8*)(kp+6144); kf[7]=*(const __attribute__((address_space(3))) bf16x8*)(kp+6656);
}
__device__ __forceinline__ void kload2(bf16x8*kf,lds_cptr kp,int j){ kf[2*j]=*(const __attribute__((address_space(3))) bf16x8*)(kp+j*2048); kf[2*j+1]=*(const __attribute__((address_space(3))) bf16x8*)(kp+j*2048+512); }
__device__ __forceinline__ s16x4 vtr(lds_cptr p){ return __builtin_bit_cast(s16x4,__builtin_amdgcn_ds_read_tr16_b64_v4i16((__attribute__((address_space(3))) v4i16_t*)p)); }
__device__ __forceinline__ float rowmax(const f32x16&p0,const f32x16&p1){
  float a=max3f(p0[0],p0[1],p1[0]),b=max3f(p0[2],p0[3],p1[1]);a=max3f(a,p1[2],p1[3]);
  #pragma unroll
  for(int r=4;r<16;r+=4){a=max3f(a,p0[r],p0[r+1]);b=max3f(b,p0[r+2],p0[r+3]);a=max3f(a,p1[r],p1[r+1]);b=max3f(b,p1[r+2],p1[r+3]);}
  const float m=max2f(a,b);
  auto rr=__builtin_amdgcn_permlane32_swap(__float_as_uint(m),__float_as_uint(m),false,false);
  return max2f(__uint_as_float(rr[0]),__uint_as_float(rr[1]));
}
__device__ __forceinline__ void pv(f32x16*o,int vb,bf16x8 pa0,bf16x8 pa1,bf16x8 pa2,bf16x8 pa3){
  #pragma unroll
  for(int d0=0;d0<4;++d0){s16x4 lo[4],hi[4];
    #pragma unroll
    for(int ks=0;ks<4;++ks){
      asm volatile("ds_read_b64_tr_b16 %0,%1 offset:%c2":"=&v"(lo[ks]):"v"(vb),"i"(d0*4096+ks*1024):"memory");
      asm volatile("ds_read_b64_tr_b16 %0,%1 offset:%c2":"=&v"(hi[ks]):"v"(vb),"i"(d0*4096+ks*1024+512):"memory");}
    asm volatile("s_waitcnt lgkmcnt(0)":::"memory");SBAR();
    #define PK(k) (bf16x8){lo[k][0],lo[k][1],lo[k][2],lo[k][3],hi[k][0],hi[k][1],hi[k][2],hi[k][3]}
    o[d0]=__builtin_amdgcn_mfma_f32_32x32x16_bf16(pa0,PK(0),o[d0],0,0,0);
    o[d0]=__builtin_amdgcn_mfma_f32_32x32x16_bf16(pa1,PK(1),o[d0],0,0,0);
    o[d0]=__builtin_amdgcn_mfma_f32_32x32x16_bf16(pa2,PK(2),o[d0],0,0,0);
    o[d0]=__builtin_amdgcn_mfma_f32_32x32x16_bf16(pa3,PK(3),o[d0],0,0,0);
    #undef PK
  }
}

#ifndef ATTN_STORE16
#define ATTN_STORE16(p,v) (*(u32x4*)(p)=(v))
#endif

using f32x4=__attribute__((ext_vector_type(4)))float;
struct PChunk { f32x4 a, b; };
__device__ __forceinline__ void pchunk_geom(int id, int tk, int tv, int NT, bool& isk, bool& valid, int& kr, int& col, int& ldsoff) {
  isk = id < 512; const int v = id - 512;
  const int g = id & 7, rest = id >> 3, kc = (rest & 1) * 4 + (g & 3), krow = (rest >> 1) * 2 + (g >> 2);
  const int pc = v >> 6, ln = v & 63, vrow = 16 * (pc & 3) + (ln >> 2), vcol = (pc >> 2) * 32 + (ln & 3) * 8;
  const int tile = isk ? tk : tv, row = isk ? krow : vrow; col = isk ? kc * 8 : vcol;
  valid = (tile >= 0) && (tile < NT) && (id < 1536);
  kr = tile * 64 + row;
  const int slot = (tile + 3) % 3;
  ldsoff = isk ? LDS_K + slot * SLOTB + kc * 1024 + krow * 16 : LDS_V + slot * 2 * SLOTB + v * 16;
}
__device__ __forceinline__ PChunk pchunk_load(int id, int tk, int tv, int NT, const float* Kc, const float* Vc, const bf16* Kn, const bf16* Vn) {
  bool isk, valid; int kr, col, ldsoff; pchunk_geom(id, tk, tv, NT, isk, valid, kr, col, ldsoff);
  const char* pf = (const char*)((isk ? Kc : Vc) + (long)kr * 1024 + col);
  const char* pb = (const char*)((isk ? Kn : Vn) + (long)kr * 1024 + col);
  const char* p = (!valid || kr >= 4096 + 32) ? (const char*)Kc : (kr < 4096 ? pf : pb);
  PChunk c; c.a = *(const f32x4*)p; c.b = *(const f32x4*)(p + 16); return c;
}
__device__ __forceinline__ void pchunk_store(const PChunk& c, int id, int tk, int tv, int NT, char* shm) {
  bool isk, valid; int kr, col, ldsoff; pchunk_geom(id, tk, tv, NT, isk, valid, kr, col, ldsoff);
  u32x4 w; w.x = cvtpk_s(c.a[0], c.a[1]); w.y = cvtpk_s(c.a[2], c.a[3]); w.z = cvtpk_s(c.b[0], c.b[1]); w.w = cvtpk_s(c.b[2], c.b[3]);
  const u32x4 raw = __builtin_bit_cast(u32x4, c.a);
  const bool isnew = kr >= 4096 && kr < 4096 + 32, zero = kr >= 4096 + 32;
  w.x = zero ? 0u : isnew ? raw.x : w.x; w.y = zero ? 0u : isnew ? raw.y : w.y; w.z = zero ? 0u : isnew ? raw.z : w.z; w.w = zero ? 0u : isnew ? raw.w : w.w;
  if (valid) *(__attribute__((address_space(3))) u32x4*)((lds_cptr)shm + ldsoff) = w;
}
#define PBAR() asm volatile("s_waitcnt lgkmcnt(0)\n\ts_barrier":::"memory")
__device__ __forceinline__ void sample_producer(const int NT, const float* Kc, const float* Vc, const bf16* Kn, const bf16* Vn, char* shm, int wid, int lane) {
  const int p = (wid - 1) * 64 + lane;
  PChunk a0, a1, a2, a3, b0, b1, b2, b3, c0, c1, c2, c3;
  #define PLOAD(X,tk,tv) do{ X##0=pchunk_load(p,tk,tv,NT,Kc,Vc,Kn,Vn); X##1=pchunk_load(p+448,tk,tv,NT,Kc,Vc,Kn,Vn); X##2=pchunk_load(p+896,tk,tv,NT,Kc,Vc,Kn,Vn); X##3=pchunk_load(p+1344,tk,tv,NT,Kc,Vc,Kn,Vn); }while(0)
  #define PSTORE(X,tk,tv) do{ pchunk_store(X##0,p,tk,tv,NT,shm); pchunk_store(X##1,p+448,tk,tv,NT,shm); pchunk_store(X##2,p+896,tk,tv,NT,shm); pchunk_store(X##3,p+1344,tk,tv,NT,shm); }while(0)
  #define PSTEP(X,s) do{ PSTORE(X,(s)+3,(s)+1); PLOAD(X,(s)+6,(s)+4); PBAR(); }while(0)
  PLOAD(a,0,-1); PLOAD(b,1,0); PLOAD(c,2,-1);
  PSTORE(a,0,-1); PBAR();
  PLOAD(a,3,1);
  PSTORE(b,1,0); PSTORE(c,2,-1); PBAR();
  PLOAD(b,4,2); PLOAD(c,5,3);
  PSTORE(a,3,1); PLOAD(a,6,4); PBAR();
  int s = 1;
  for (; s + 2 <= NT - 2; s += 3) { PSTEP(b, s); PSTEP(c, s + 1); PSTEP(a, s + 2); }
  if (s <= NT - 2) { PSTEP(b, s); ++s; }
  if (s <= NT - 2) { PSTEP(c, s); ++s; }
  PBAR();
  #undef PLOAD
  #undef PSTORE
  #undef PSTEP
}
#undef PBAR
template<int THRL> __device__ __forceinline__ void attn_unit(const int mode,const int NT,const bf16*Qw0,const bf16*__restrict__ Kh,const bf16*__restrict__ Vh,bf16*Ow0,char*shm,const float*Kc,const float*Vc,const int tid_in,const bool pre,const bool pfN,const bf16*KhN,const bf16*VhN){
  int tid0_=tid_in; asm volatile("":"+v"(tid0_));
  const int tid=tid0_,lane=tid&63,r32=lane&31,hi=lane>>5; const int wid=__builtin_amdgcn_readfirstlane(tid>>6);
  const bf16*Qw=Qw0+(long)wid*QBLK*DM; const bool qvalid=(mode==0)||(wid==0); const bool dma=(mode==0);
  if(mode==1&&wid!=0){ sample_producer(NT,Kc,Vc,Kh,Vh,shm,wid,lane); return; }
  const unsigned lds0=(unsigned)(uintptr_t)shm;
  float*wsf=(float*)(shm+LDS_WS)+wid*64;
  const bf16*ksrc=Kh+wid*512+lane*8;
  const bf16*vsrc=Vh+(wid>>2)*2048+(wid&3)*512+lane*8;
  const unsigned kdst=lds0+LDS_K+wid*1024, vdst=lds0+LDS_V+wid*1024;
  #define DMA_K(t,slot) if(dma)glds16(ksrc+(long)(t)*4096,(unsigned)__builtin_amdgcn_readfirstlane(kdst+(slot)))
  #define DMA_V(t,slot) if(dma)do{ glds16(vsrc+(long)(t)*8192,(unsigned)__builtin_amdgcn_readfirstlane(vdst+2*(slot))); glds16(vsrc+(long)(t)*8192+4096,(unsigned)__builtin_amdgcn_readfirstlane(vdst+2*(slot)+8192)); }while(0)
  const int vb0=(int)(lds0+LDS_V)+((lane>>4)&1)*32+(lane&3)*8+(4*hi+((lane&15)>>2))*64;
  const char*Kbase=shm+LDS_K; bf16x8 kf[8];
  const lds_cptr shm3=(lds_cptr)shm; const lds_cptr kp0=shm3+LDS_K+hi*1024+r32*16; const lds_cptr vp0=shm3+LDS_V+((lane>>4)&1)*32+(lane&3)*8+(4*hi+((lane&15)>>2))*64;
  if(!pre){DMA_K(0,0);DMA_V(0,0);DMA_K(1,SLOTB);}
  bf16x8 qr[4];
  #pragma unroll
  for(int d0=0;d0<4;++d0){ if(qvalid)qr[d0]=*reinterpret_cast<const bf16x8*>(&Qw[(long)r32*DM+d0*16+hi*8]); else qr[d0]=bf16x8{}; }
  const lds_cptr qls=(lds_cptr)shm+LDS_OST+wid*4096+lane*16;
  #pragma unroll
  for(int d0=0;d0<4;++d0)*(__attribute__((address_space(3))) bf16x8*)((lds_cptr)qls+d0*1024)=qr[d0];
  #define QLD(d) (*(const __attribute__((address_space(3))) bf16x8*)(qls+(d)*1024))
  bf16x8 qa=qr[0],qb;
  float mhat=0.f,l_reg=0.f;f32x16 o[4];o[0]=f32x16{};o[1]=f32x16{};o[2]=f32x16{};o[3]=f32x16{};f32x16 negm=f32x16{};asm volatile("":"+v"(negm));
  #define CMASK(P0,P1,t) do{int jb_=(t)-(NT-4); if(jb_>=0)bmask(P0,P1,jb_,wid,mode);}while(0)
  bool resc=false;
  #define START(P0,P1) do{ const float rm=rowmax(P0,P1); resc=false; \
    { const float dl=rm; mhat=fadd_s(mhat,dl); \
      _Pragma("unroll") for(int r=0;r<16;++r){P0[r]=fsub_s(P0[r],dl);P1[r]=fsub_s(P1[r],dl);} \
      _Pragma("unroll") for(int r=0;r<16;++r)negm[r]=-mhat; asm volatile("":"+v"(negm)); } \
    _Pragma("unroll") for(int r=0;r<16;++r)P0[r]=__builtin_amdgcn_exp2f(P0[r]); }while(0)
  #define RESC() do{ if(resc){ asm volatile("s_waitcnt lgkmcnt(0)":::"memory"); \
      _Pragma("unroll") for(int d_=0;d_<4;++d_) _Pragma("unroll") for(int r=0;r<16;++r)o[d_][r]*=wsf[crow(r,hi)]; } }while(0)
  f32x16 pA0,pA1,pB0,pB1;
  int sl_prev=0,sl_cur=0,sl_next=SLOTB;
  #define ROT() do{sl_prev=sl_cur;sl_cur=sl_next;sl_next=(sl_next==(NSLOT-1)*SLOTB)?0:sl_next+SLOTB;}while(0)
  DMA_K(2,2*SLOTB);
  WAIT_BAR(4);
  qkt(pA0,pA1,Kbase,qr,negm,r32,hi);asm volatile("s_nop 15\n\ts_nop 7":"+v"(pA0),"+v"(pA1));CMASK(pA0,pA1,0);
  START(pA0,pA1);
  _Pragma("unroll") for(int r=0;r<16;++r)pA1[r]=__builtin_amdgcn_exp2f(pA1[r]);
  WAIT_BAR(0);
  DMA_K(3,0);DMA_V(1,SLOTB);
  ROT();
  kload8(kf,kp0+sl_cur);
  WAIT_BAR(3);
  s16x4 vlo[8],vhi[8]; u32x4 pw0,pw1,pw2,pw3;
  #define PKW(P,B) cvtpk_s(P[B],P[B+1])
  #define PAF(k) __builtin_bit_cast(bf16x8,pw##k)
  #define VFR(i) (bf16x8){vlo[i][0],vlo[i][1],vlo[i][2],vlo[i][3],vhi[i][0],vhi[i][1],vhi[i][2],vhi[i][3]}
  #define PIN(x) asm volatile("":"+v"(x))
  #define MX3(a,b,c) __builtin_fmaxf(__builtin_fmaxf((a),(b)),(c))
  #define GAPA(MF,A0,A1,A2,A3,W0,W1,PW) do{ MF; sacc+=A0; sacc+=A1; sacc+=A2; sacc+=A3; PIN(sacc); W0; W1; PIN(PW); SBAR(); }while(0)
  #define EX(v) __builtin_amdgcn_exp2f(v)
  #define GAPB(MF,X,B) do{ MF; X[B]=EX(X[B]); X[B+1]=EX(X[B+1]); X[B+2]=EX(X[B+2]); X[B+3]=EX(X[B+3]); PIN(X); SBAR(); }while(0)
  #define VRD(i) do{ vlo[i]=vtr(vp_+(((i)>>2)*4096+((i)&3)*1024)); vhi[i]=vtr(vp_+(((i)>>2)*4096+((i)&3)*1024+512)); }while(0)
  #define VRD2(s,i) do{ vlo[s]=vtr(vp_+(((i)>>2)*4096+((i)&3)*1024)); vhi[s]=vtr(vp_+(((i)>>2)*4096+((i)&3)*1024+512)); }while(0)
  #define GAPB2(MF,RD,X,B) do{ MF; RD; X[B]=EX(X[B]); X[B+1]=EX(X[B+1]); PIN(X); SBAR(); }while(0)
  #define KRD(G,j) do{ if(G){ kload2(kf,kp0+sl_next,j); SBAR(); } }while(0)
  #define STEP(C0,C1,P0,P1,t,GK,GV,GL) do{ SBAR(); \
    const lds_cptr vp_=vp0+2*sl_prev; \
    qb=QLD(1); VRD(0); SBAR(); float sacc=(P0[0]+P0[1]); \
    GAPA(C0=__builtin_amdgcn_mfma_f32_32x32x16_bf16(kf[0],qa,negm,0,0,0), P0[2],P0[3],P0[4],P0[5],     pw0[0]=PKW(P0,0), pw0[1]=PKW(P0,2), pw0); \
    VRD(4); SBAR(); GAPA(C1=__builtin_amdgcn_mfma_f32_32x32x16_bf16(kf[1],qa,negm,0,0,0), P0[6],P0[7],P0[8],P0[9],     pw0[2]=PKW(P0,4), pw0[3]=PKW(P0,6), pw0); \
    qa=QLD(2); VRD(1); SBAR(); GAPA(C0=__builtin_amdgcn_mfma_f32_32x32x16_bf16(kf[2],qb,C0,0,0,0),   P0[10],P0[11],P0[12],P0[13], pw1[0]=PKW(P0,8), pw1[1]=PKW(P0,10), pw1); \
    VRD(5); SBAR(); GAPA(C1=__builtin_amdgcn_mfma_f32_32x32x16_bf16(kf[3],qb,C1,0,0,0),   P0[14],P0[15],P1[0],P1[1],   pw1[2]=PKW(P0,12),pw1[3]=PKW(P0,14), pw1); \
    qb=QLD(3); VRD(2); SBAR(); GAPA(C0=__builtin_amdgcn_mfma_f32_32x32x16_bf16(kf[4],qa,C0,0,0,0),   P1[2],P1[3],P1[4],P1[5],     pw2[0]=PKW(P1,0), pw2[1]=PKW(P1,2), pw2); \
    VRD(6); SBAR(); GAPA(C1=__builtin_amdgcn_mfma_f32_32x32x16_bf16(kf[5],qa,C1,0,0,0),   P1[6],P1[7],P1[8],P1[9],     pw2[2]=PKW(P1,4), pw2[3]=PKW(P1,6), pw2); \
    VRD(3); SBAR(); GAPA(C0=__builtin_amdgcn_mfma_f32_32x32x16_bf16(kf[6],qb,C0,0,0,0),   P1[10],P1[11],P1[12],P1[13], pw3[0]=PKW(P1,8), pw3[1]=PKW(P1,10), pw3); \
    VRD(7); SBAR(); GAPA(C1=__builtin_amdgcn_mfma_f32_32x32x16_bf16(kf[7],qb,C1,0,0,0),   P1[14],P1[15],0.f,0.f,       pw3[2]=PKW(P1,12),pw3[3]=PKW(P1,14), pw3); \
    l_reg+=sacc; \
    if(GK){DMA_K((t)+3,sl_cur);} if(GV){DMA_V((t)+1,sl_next);} \
    CMASK(C0,C1,t); \
    SBAR(); float mxa_,mxb_,rm_; \
    do{ o[0]=__builtin_amdgcn_mfma_f32_32x32x16_bf16(PAF(0),VFR(0),o[0],0,0,0); VRD2(0,8); mxa_=MX3(C0[0],C0[1],C1[0]); mxb_=MX3(C0[2],C0[3],C1[1]); mxa_=MX3(mxa_,C1[2],C1[3]); mxa_=MX3(mxa_,C0[4],C0[5]); mxb_=MX3(mxb_,C0[6],C0[7]); PIN(mxa_); PIN(mxb_); SBAR(); }while(0); \
    do{ o[1]=__builtin_amdgcn_mfma_f32_32x32x16_bf16(PAF(0),VFR(4),o[1],0,0,0); VRD2(4,12); mxa_=MX3(mxa_,C1[4],C1[5]); mxb_=MX3(mxb_,C1[6],C1[7]); mxa_=MX3(mxa_,C0[8],C0[9]); mxb_=MX3(mxb_,C0[10],C0[11]); PIN(mxa_); PIN(mxb_); SBAR(); }while(0); \
    do{ o[0]=__builtin_amdgcn_mfma_f32_32x32x16_bf16(PAF(1),VFR(1),o[0],0,0,0); VRD2(1,9); mxa_=MX3(mxa_,C1[8],C1[9]); mxb_=MX3(mxb_,C1[10],C1[11]); mxa_=MX3(mxa_,C0[12],C0[13]); mxb_=MX3(mxb_,C0[14],C0[15]); PIN(mxa_); PIN(mxb_); SBAR(); }while(0); \
    do{ o[1]=__builtin_amdgcn_mfma_f32_32x32x16_bf16(PAF(1),VFR(5),o[1],0,0,0); VRD2(5,13); mxa_=MX3(mxa_,C1[12],C1[13]); mxb_=MX3(mxb_,C1[14],C1[15]); rm_=__builtin_fmaxf(mxa_,mxb_); { auto rr=__builtin_amdgcn_permlane32_swap(__float_as_uint(rm_),__float_as_uint(rm_),false,false); rm_=__builtin_fmaxf(__uint_as_float(rr[0]),__uint_as_float(rr[1])); } PIN(mxa_); PIN(mxb_); SBAR(); }while(0); \
    resc=false; \
    if(__builtin_expect(__any(rm_>(float)THRL),0)){ const float dl=__builtin_fmaxf(rm_,0.f); mhat+=dl; \
      _Pragma("unroll") for(int r=0;r<16;++r){C0[r]-=dl;C1[r]-=dl;} \
      _Pragma("unroll") for(int r=0;r<16;++r)negm[r]=-mhat; asm volatile("":"+v"(negm)); \
      const float f=__builtin_amdgcn_exp2f(-dl); l_reg*=f; if(hi==0)wsf[r32]=f; resc=true; } \
    SBAR(); \
    do{ o[0]=__builtin_amdgcn_mfma_f32_32x32x16_bf16(PAF(2),VFR(2),o[0],0,0,0); VRD2(2,10); C0[0]=EX(C0[0]); C0[1]=EX(C0[1]); PIN(C0); SBAR(); }while(0); \
    do{ o[1]=__builtin_amdgcn_mfma_f32_32x32x16_bf16(PAF(2),VFR(6),o[1],0,0,0); VRD2(6,14); C0[2]=EX(C0[2]); C0[3]=EX(C0[3]); PIN(C0); SBAR(); }while(0); \
    do{ o[0]=__builtin_amdgcn_mfma_f32_32x32x16_bf16(PAF(3),VFR(3),o[0],0,0,0); VRD2(3,11); C0[4]=EX(C0[4]); C0[5]=EX(C0[5]); PIN(C0); SBAR(); }while(0); \
    do{ o[1]=__builtin_amdgcn_mfma_f32_32x32x16_bf16(PAF(3),VFR(7),o[1],0,0,0); VRD2(7,15); C0[6]=EX(C0[6]); C0[7]=EX(C0[7]); PIN(C0); SBAR(); }while(0); \
    do{ o[2]=__builtin_amdgcn_mfma_f32_32x32x16_bf16(PAF(0),VFR(0),o[2],0,0,0); (void)0; C0[8]=EX(C0[8]); C0[9]=EX(C0[9]); C0[10]=EX(C0[10]); C0[11]=EX(C0[11]); PIN(C0); SBAR(); }while(0); \
    KRD(GL,0); do{ o[3]=__builtin_amdgcn_mfma_f32_32x32x16_bf16(PAF(0),VFR(4),o[3],0,0,0); (void)0; C0[12]=EX(C0[12]); C0[13]=EX(C0[13]); PIN(C0); SBAR(); }while(0); \
    KRD(GL,1); do{ o[2]=__builtin_amdgcn_mfma_f32_32x32x16_bf16(PAF(1),VFR(1),o[2],0,0,0); (void)0; C0[14]=EX(C0[14]); C0[15]=EX(C0[15]); PIN(C0); SBAR(); }while(0); \
    KRD(GL,2); do{ o[3]=__builtin_amdgcn_mfma_f32_32x32x16_bf16(PAF(1),VFR(5),o[3],0,0,0); (void)0; C1[0]=EX(C1[0]); C1[1]=EX(C1[1]); PIN(C1); SBAR(); }while(0); \
    KRD(GL,3); do{ o[2]=__builtin_amdgcn_mfma_f32_32x32x16_bf16(PAF(2),VFR(2),o[2],0,0,0); (void)0; C1[2]=EX(C1[2]); C1[3]=EX(C1[3]); PIN(C1); SBAR(); }while(0); \
    do{ o[3]=__builtin_amdgcn_mfma_f32_32x32x16_bf16(PAF(2),VFR(6),o[3],0,0,0); (void)0; C1[4]=EX(C1[4]); C1[5]=EX(C1[5]); C1[6]=EX(C1[6]); C1[7]=EX(C1[7]); PIN(C1); SBAR(); }while(0); \
    do{ o[2]=__builtin_amdgcn_mfma_f32_32x32x16_bf16(PAF(3),VFR(3),o[2],0,0,0); (void)0; C1[8]=EX(C1[8]); C1[9]=EX(C1[9]); C1[10]=EX(C1[10]); C1[11]=EX(C1[11]); PIN(C1); SBAR(); }while(0); \
    do{ o[3]=__builtin_amdgcn_mfma_f32_32x32x16_bf16(PAF(3),VFR(7),o[3],0,0,0); qa=QLD(0); C1[12]=EX(C1[12]); C1[13]=EX(C1[13]); C1[14]=EX(C1[14]); C1[15]=EX(C1[15]); PIN(C1); SBAR(); }while(0); \
    }while(0)
  int t=1;
  #undef CMASK
  #define CMASK(P0,P1,t) do{}while(0)
  for(;t+5<NT;t+=2){
    STEP(pB0,pB1,pA0,pA1,t,true,true,true);     WAIT_BAR(3); RESC(); ROT();
    STEP(pA0,pA1,pB0,pB1,t+1,true,true,true);   WAIT_BAR(3); RESC(); ROT();
  }
  #undef CMASK
  #define CMASK(P0,P1,t) do{int jb_=(t)-(NT-4); if(jb_>=0)bmask(P0,P1,jb_,wid,mode);}while(0)
  #define ENDW(tt) do{ if((tt)+3<NT){WAIT_BAR(3);} else if((tt)+2<NT){WAIT_BAR(2);} else {WAIT_BAR(0);} }while(0)
  for(;t+1<NT;t+=2){
    STEP(pB0,pB1,pA0,pA1,t,(t+3<NT),(t+1<NT),(t+1<NT));       ENDW(t);   RESC(); ROT();
    STEP(pA0,pA1,pB0,pB1,t+1,(t+4<NT),(t+2<NT),(t+2<NT));     ENDW(t+1); RESC(); ROT();
  }
  STEP(pB0,pB1,pA0,pA1,NT-1,false,false,false); RESC();
  { float sacc=pB0[0]+pB0[1]; _Pragma("unroll") for(int r=2;r<16;++r)sacc+=pB0[r]; _Pragma("unroll") for(int r=0;r<16;++r)sacc+=pB1[r]; l_reg+=sacc;
    pw0=(u32x4){PKW(pB0,0),PKW(pB0,2),PKW(pB0,4),PKW(pB0,6)};pw1=(u32x4){PKW(pB0,8),PKW(pB0,10),PKW(pB0,12),PKW(pB0,14)};pw2=(u32x4){PKW(pB1,0),PKW(pB1,2),PKW(pB1,4),PKW(pB1,6)};pw3=(u32x4){PKW(pB1,8),PKW(pB1,10),PKW(pB1,12),PKW(pB1,14)};
    SBAR(); pv(o,vb0+2*sl_cur,PAF(0),PAF(1),PAF(2),PAF(3)); }
  asm volatile("s_waitcnt lgkmcnt(0)\n\ts_barrier":::"memory");
  if(pfN){ const bf16*kn=KhN+wid*512+lane*8; const bf16*vn=VhN+(wid>>2)*2048+(wid&3)*512+lane*8;
    glds16(kn,(unsigned)__builtin_amdgcn_readfirstlane(kdst)); glds16(vn,(unsigned)__builtin_amdgcn_readfirstlane(vdst)); glds16(vn+4096,(unsigned)__builtin_amdgcn_readfirstlane(vdst+8192)); glds16(kn+4096,(unsigned)__builtin_amdgcn_readfirstlane(kdst+SLOTB)); }
  #undef PKW
  #undef PAF
  #undef VFR
  #undef PIN
  #undef MX3
  #undef GAPA
  #undef GAPB
  #undef EX
  #undef VRD
  #undef VRD2
  #undef QLD
  #undef GAPB2
  #undef KRD
  #undef STEP
  #undef ENDW
  {auto rr=__builtin_amdgcn_permlane32_swap(__float_as_uint(l_reg),__float_as_uint(l_reg),false,false);l_reg=__uint_as_float(rr[0])+__uint_as_float(rr[1]);}
  if(hi==0)wsf[32+r32]=l_reg;asm volatile("s_waitcnt lgkmcnt(0)":::"memory");
  float rli[16];
  #pragma unroll
  for(int r=0;r<16;++r)rli[r]=__builtin_amdgcn_rcpf(wsf[32+crow(r,hi)]);
  bf16*Ow=Ow0+(long)wid*QBLK*OPITCH;
  { bf16*stg=(bf16*)(shm+LDS_OST)+wid*2048;
    #pragma unroll
    for(int hp=0;hp<2;++hp){
      #pragma unroll
      for(int r=0;r<16;++r){const int orow=crow(r,hi);
        #pragma unroll
        for(int d0=0;d0<2;++d0)stg[orow*64+d0*32+r32]=__float2bfloat16(o[2*hp+d0][r]*rli[r]);}
      asm volatile("s_waitcnt lgkmcnt(0)":::"memory");
      #pragma unroll
      for(int i=0;i<4;++i){const int row=i*8+(lane>>3),ch=lane&7; const u32x4 v=*(const u32x4*)(stg+row*64+ch*8); if(qvalid)ATTN_STORE16(Ow+(long)row*OPITCH+hp*64+ch*8,v);}
      asm volatile("s_waitcnt lgkmcnt(0)":::"memory"); } }
  asm volatile("s_waitcnt lgkmcnt(0)":::"memory");
  #undef DMA_K
  #undef DMA_V
  #undef CMASK
  #undef START
  #undef RESC
  #undef ROT
}
constexpr int ATTN_LDS_BYTES=LDS_BYTES;
#undef SBAR
#undef WAIT_BAR
}

constexpr int NWAVES = 8;
constexpr int PH_PER_LAYER = 11, NPH = 1 + DEPTH * PH_PER_LAYER;
enum { P_WIN = 0, P_MIXA, P_ATTN, P_MIXC, P_PG, P_MERGE, P_OUT, P_LN1, P_UP, P_DOWN, P_LN2 };

constexpr int CW_TMO = 0, CW_CODE = 1, CW_BAR = 4096;

constexpr int RING_OFF = 0, RING_BYTES = 131072;
constexpr int LDSCTL_OFF = RING_BYTES, MISC_OFF = LDSCTL_OFF + 320;
constexpr int LDS_BYTES = 147456;
static_assert(MISC_OFF + 128 <= LDS_BYTES, "LDS map");

#define GAS __attribute__((address_space(1)))
#define LAS __attribute__((address_space(3)))
typedef unsigned short bf16;
typedef unsigned v4u __attribute__((ext_vector_type(4)));
typedef float f32x4 __attribute__((ext_vector_type(4)));
typedef float f32x16 __attribute__((ext_vector_type(16)));
typedef short bf16x8 __attribute__((ext_vector_type(8)));
typedef GAS unsigned gu32;
#define RLX_AGENT __ATOMIC_RELAXED, __HIP_MEMORY_SCOPE_AGENT
#define LDS_WAIT() asm volatile("s_waitcnt lgkmcnt(0)" ::: "memory")
#define VM_WAIT() asm volatile("s_waitcnt vmcnt(0)" ::: "memory")
__device__ __forceinline__ unsigned f2bf(float f) { unsigned u = __builtin_bit_cast(unsigned, f); return (u + 0x7fffu + ((u >> 16) & 1u)) >> 16; }
__device__ __forceinline__ unsigned pk2(float lo, float hi) { return f2bf(lo) | (f2bf(hi) << 16); }
typedef float pk_f2_t __attribute__((ext_vector_type(2))); typedef __bf16 pk_b2_t __attribute__((ext_vector_type(2)));
__device__ __forceinline__ unsigned pk2hw(float lo, float hi) { const pk_f2_t v = {lo, hi}; const pk_b2_t b = __builtin_convertvector(v, pk_b2_t); return __builtin_bit_cast(unsigned, b); }
__device__ __forceinline__ float bfl(unsigned w) { return __uint_as_float(w << 16); }
__device__ __forceinline__ float bfh(unsigned w) { return __uint_as_float(w & 0xffff0000u); }

#define XB_TMO      128
#define XB_XCNT(j)  (256  + 64 * (j))
#define XB_XSUB(j)  (1280 + 64 * (j))
#define XB_XGEN(j)  (2304 + 64 * (j))
#define XB_TOP      3328
#define XB_TOPGEN   3392
#define XCD_BAR_WORDS 3456
#define XB_SPIN_CAP (1u << 18)

__device__ __forceinline__ unsigned xb_ld(unsigned* p)              { return __hip_atomic_load(p, __ATOMIC_RELAXED, __HIP_MEMORY_SCOPE_AGENT); }
__device__ __forceinline__ unsigned xb_add(unsigned* p, unsigned v) { return __hip_atomic_fetch_add(p, v, __ATOMIC_RELAXED, __HIP_MEMORY_SCOPE_AGENT); }
__device__ __forceinline__ unsigned xb_xcc_id() { return (unsigned)__builtin_amdgcn_s_getreg((3 << 11) | 20) & 0xFu; }
#define XB_SPIN(cond, bar) do { unsigned _sp = 0; while (cond) { __builtin_amdgcn_s_sleep(1); \
    if ((++_sp & 255u) == 0u) { if (xb_ld(&(bar)[XB_TMO])) break; if (_sp > XB_SPIN_CAP) { atomicAdd(&(bar)[XB_TMO], 1u); break; } } } } while (0)

struct XcdBarrier {
    unsigned* bar; unsigned x; int tid;
    volatile LAS unsigned* st;
};

__device__ __forceinline__ XcdBarrier xcd_barrier_post(unsigned* bar, volatile LAS unsigned* st) {
    XcdBarrier b; b.bar = bar; b.x = xb_xcc_id(); b.st = st; b.tid = 0;
    if (threadIdx.x == 0) (void)xb_add(&bar[XB_XCNT(b.x)], 1u);
    return b;
}
__device__ __forceinline__ void xcd_barrier_complete(unsigned* bar, unsigned x, unsigned& nloc, unsigned& nx) {
    const unsigned G = gridDim.x * gridDim.y * gridDim.z;
    unsigned sum, cnt, mine, sp = 0u;
    for (;;) {
        sum = 0u; cnt = 0u; mine = 0u;
#pragma unroll
        for (unsigned j = 0; j < 16; ++j) { const unsigned c = xb_ld(&bar[XB_XCNT(j)]); sum += c; cnt += (c > 0u) ? 1u : 0u; mine = (j == x) ? c : mine; }
        if (sum == G) break;
        __builtin_amdgcn_s_sleep(1);
        if ((++sp & 255u) == 0u) { if (xb_ld(&bar[XB_TMO])) break; if (sp > XB_SPIN_CAP) { atomicAdd(&bar[XB_TMO], 1u); break; } }
    }
    nloc = mine > 0u ? mine : 1u; nx = cnt > 0u ? cnt : 1u;
}

__device__ __forceinline__ void xcd_barrier(const XcdBarrier& b) {
    asm volatile("s_waitcnt vmcnt(0)" ::: "memory");
    __syncthreads();
    if (b.tid == 0) {
        unsigned* bar = b.bar;
        __builtin_amdgcn_s_waitcnt(0);
        unsigned nloc = b.st[0], nx = b.st[1];
        if (nloc == 0u) { xcd_barrier_complete(bar, b.x, nloc, nx); b.st[0] = nloc; b.st[1] = nx; }
        const unsigned old = xb_add(&bar[XB_XSUB(b.x)], 1u);
        const unsigned gen = old / nloc;
        if (old + 1u == (gen + 1u) * nloc) {
            __builtin_amdgcn_fence(__ATOMIC_RELEASE, "agent");
            asm volatile("s_waitcnt vmcnt(0)" ::: "memory");
            const unsigned og = xb_add(&bar[XB_TOP], 1u);
            const unsigned tg = og / nx;
            if (og + 1u == (tg + 1u) * nx) xb_add(&bar[XB_TOPGEN], 1u);
            else XB_SPIN(xb_ld(&bar[XB_TOPGEN]) == tg, bar);
            __builtin_amdgcn_fence(__ATOMIC_ACQUIRE, "agent");
            xb_add(&bar[XB_XGEN(b.x)], 1u);
            asm volatile("s_waitcnt vmcnt(0)" ::: "memory");
        } else {
            XB_SPIN(xb_ld(&bar[XB_XGEN(b.x)]) == gen, bar);
            __builtin_amdgcn_fence(__ATOMIC_ACQUIRE, "agent");
            asm volatile("s_waitcnt vmcnt(0)" ::: "memory");
        }
    }
    __syncthreads();
}

struct Args { const float* in[35]; float* out; unsigned char* ws; int ph_lo, ph_hi, li, pad; };
struct Frame {
    LAS unsigned char* lds;
    volatile LAS unsigned* MISC;
    gu32* ctl;
    int tid, lane, wave;
    int vcu, G;
    float* out;
    unsigned char* ws;
};
__device__ __forceinline__ float wave_sum(float v) {
    v += swz_xor<1>(v); v += swz_xor<2>(v); v += swz_xor<4>(v); v += swz_xor<8>(v); v += swz_xor<16>(v);
    { auto rr = __builtin_amdgcn_permlane32_swap(__float_as_uint(v), __float_as_uint(v), false, false); v = __uint_as_float(rr[0]) + __uint_as_float(rr[1]); }
    return v;
}
__device__ __forceinline__ void p0_transpose_item(const float* W, int K, int N, bf16* WT, int row_off, LAS float* scr, int item, int lane) {
    const int nblk = N / 32, kb = item / nblk, nb = item % nblk, k0 = 64 * kb, n0 = 32 * nb;
#pragma unroll 8
    for (int i = 0; i < 32; ++i) { const int kk = 2 * i + (lane >> 5); scr[kk * 33 + (lane & 31)] = W[(size_t)(k0 + kk) * N + n0 + (lane & 31)]; }
    LDS_WAIT(); asm volatile("" ::: "memory");
    const int c = lane & 7;
#pragma unroll
    for (int j = 0; j < 4; ++j) { const int n = (lane >> 3) + 8 * j; const LAS float* s = scr + (8 * c) * 33 + n;
        v4u o; o.x = pk2(s[0 * 33], s[1 * 33]); o.y = pk2(s[2 * 33], s[3 * 33]); o.z = pk2(s[4 * 33], s[5 * 33]); o.w = pk2(s[6 * 33], s[7 * 33]);
        *(GAS v4u*)(WT + (size_t)(row_off + n0 + n) * K + k0 + 8 * c) = o; }
    LDS_WAIT(); asm volatile("" ::: "memory");
}

__device__ __forceinline__ void p0_transpose64(const float* W, int N, int nblk, bf16* WT, int ldo, int item, int lane) {
    const int kb = item / nblk, nb = item % nblk, k0 = 64 * kb, n0 = 64 * nb, n4 = lane & 15, kq = lane >> 4;
    f32x4 v[16];
#pragma unroll
    for (int j = 0; j < 16; ++j) v[j] = *(const GAS f32x4*)(W + (size_t)(k0 + kq * 16 + j) * N + n0 + 4 * n4);
#pragma unroll
    for (int e = 0; e < 4; ++e) { v4u c0, c1;
        c0.x = pk2hw(v[0][e], v[1][e]); c0.y = pk2hw(v[2][e], v[3][e]); c0.z = pk2hw(v[4][e], v[5][e]); c0.w = pk2hw(v[6][e], v[7][e]);
        c1.x = pk2hw(v[8][e], v[9][e]); c1.y = pk2hw(v[10][e], v[11][e]); c1.z = pk2hw(v[12][e], v[13][e]); c1.w = pk2hw(v[14][e], v[15][e]);
        bf16* o = WT + (size_t)(n0 + 4 * n4 + e) * ldo + k0 + kq * 16; *(GAS v4u*)o = c0; *(GAS v4u*)(o + 8) = c1; }
}

__device__ __forceinline__ void dsincos(double x, double& s, double& c) {
    const double TWO_PI = 6.283185307179586476925287, HALF_PI = 1.570796326794896619231322;
    x -= TWO_PI * __builtin_rint(x * (1.0 / TWO_PI));
    const double kq = __builtin_rint(x * (1.0 / HALF_PI)); const double r = x - kq * HALF_PI; const int k = ((int)kq) & 3; const double r2 = r * r;
    double sp = -1.0 / 1307674368000.0; sp = sp * r2 + 1.0 / 6227020800.0; sp = sp * r2 - 1.0 / 39916800.0; sp = sp * r2 + 1.0 / 362880.0; sp = sp * r2 - 1.0 / 5040.0; sp = sp * r2 + 1.0 / 120.0; sp = sp * r2 - 1.0 / 6.0; sp = sp * r2 * r + r;
    double cp = 1.0 / 20922789888000.0; cp = cp * r2 - 1.0 / 87178291200.0; cp = cp * r2 + 1.0 / 479001600.0; cp = cp * r2 - 1.0 / 3628800.0; cp = cp * r2 + 1.0 / 40320.0; cp = cp * r2 - 1.0 / 720.0; cp = cp * r2 + 1.0 / 24.0; cp = cp * r2 - 0.5; cp = cp * r2 + 1.0;
    s = (k == 0) ? sp : (k == 1) ? cp : (k == 2) ? -sp : -cp;
    c = (k == 0) ? cp : (k == 1) ? -sp : (k == 2) ? -cp : sp;
}
__device__ __forceinline__ double dexp(double x) {
    const double LN2 = 0.693147180559945309417232; const double n = __builtin_rint(x * (1.0 / LN2)); const double r = x - n * LN2;
    double p = 1.0 / 6227020800.0; p = p * r + 1.0 / 479001600.0; p = p * r + 1.0 / 39916800.0; p = p * r + 1.0 / 3628800.0; p = p * r + 1.0 / 362880.0; p = p * r + 1.0 / 40320.0; p = p * r + 1.0 / 5040.0;
    p = p * r + 1.0 / 720.0; p = p * r + 1.0 / 120.0; p = p * r + 1.0 / 24.0; p = p * r + 1.0 / 6.0; p = p * r + 0.5; p = p * r + 1.0; p = p * r + 1.0;
    return __builtin_ldexp(p, (int)n);
}

enum { I_XP = 0, I_XS, I_CK, I_CV, I_SRE, I_SIM, I_SCONV, I_SPOOL, I_WIN, I_POOLW, I_PSCALE, I_ARE, I_AIM, I_LOGDT, I_BRE, I_BIM, I_CRE, I_CIM, I_SD, I_WGLU, I_CONVW, I_CONVB,
       I_LQ1, I_LK1, I_LQ2, I_LK2, I_SUBLN, I_WBR, I_WOUT, I_LN1G, I_LN1B, I_WUP, I_WDN, I_LN2G, I_LN2B };

constexpr int I_IN0 = (DM / 64) * (N_IN / 64);
__device__ __forceinline__ void p0_weights(Frame& F, const Args& A, int first, int last, int wv, int nw) {
    unsigned char* ws = F.ws;
    constexpr int I_IN = (DM / 64) * (N_IN / 64), I_BR = (BR_W / 64) * (DM / 64), I_OUT = (DM / 64) * (DM / 64), I_UP = (DM / 64) * (D_FF / 64), I_DN = (D_FF / 64) * (DM / 64), I_GLU = (512 / 64) * (512 / 64), I_PF = (512 / 8) * (DM / 64);
    constexpr int PER_L = I_IN + I_BR + I_OUT + I_UP + I_DN + I_GLU + I_PF;
    if (last > DEPTH * PER_L) last = DEPTH * PER_L;
    for (int it = first + wv; it < last; it += nw) {
        const int l = it / PER_L; int r = it % PER_L; unsigned char* wl = ws + WS_W + (size_t)l * W_LSTRIDE;
        if (r < I_IN) { p0_transpose64(A.in[I_WIN] + (size_t)l * DM * N_IN, N_IN, N_IN / 64, (bf16*)(wl + W_IN), DM, r, F.lane); continue; } r -= I_IN;
        if (r < I_BR) { if (r >= 8 * (DM / 64)) p0_transpose64(A.in[I_WBR] + (size_t)l * BR_W * DM, DM, DM / 64, (bf16*)(wl + W_BR), BR_W, r, F.lane); continue; } r -= I_BR;
        if (r < I_OUT) { p0_transpose64(A.in[I_WOUT] + (size_t)l * DM * DM, DM, DM / 64, (bf16*)(wl + W_OUT), DM, r, F.lane); continue; } r -= I_OUT;
        if (r < I_UP) { p0_transpose64(A.in[I_WUP] + (size_t)l * DM * D_FF, D_FF, D_FF / 64, (bf16*)(wl + W_UP), DM, r, F.lane); continue; } r -= I_UP;
        if (r < I_DN) { p0_transpose64(A.in[I_WDN] + (size_t)l * D_FF * DM, DM, DM / 64, (bf16*)(wl + W_DN), D_FF, r, F.lane); continue; } r -= I_DN;
        if (r < I_GLU) { p0_transpose64(A.in[I_WGLU] + (size_t)l * 512 * 512, 512, 512 / 64, (bf16*)(wl + W_GLU), 512, r, F.lane); continue; } r -= I_GLU;
        {
            const int k0 = (r >> 4) * 8, d = (r & 15) * 64 + F.lane, g = k0 >> 7;
            const float* pw = A.in[I_POOLW] + (((size_t)l * 4 + g) * 128 + (k0 & 127)) * 128; const float* sc = A.in[I_PSCALE] + (size_t)l * 512 + g * 128; const float* wb = A.in[I_WBR] + ((size_t)l * BR_W + g * 128) * DM + d;
            float acc8[8];
#pragma unroll
            for (int e = 0; e < 8; ++e) acc8[e] = 0.f;
#pragma unroll 1
            for (int jb = 0; jb < 128; jb += 8) {
                float w8[8]; f32x4 s4[2], p4[8][2];
#pragma unroll
                for (int jj = 0; jj < 8; ++jj) w8[jj] = *(const GAS float*)(wb + (size_t)(jb + jj) * DM);
                s4[0] = *(const GAS f32x4*)(sc + jb); s4[1] = *(const GAS f32x4*)(sc + jb + 4);
#pragma unroll
                for (int e = 0; e < 8; ++e) { p4[e][0] = *(const GAS f32x4*)(pw + e * 128 + jb); p4[e][1] = *(const GAS f32x4*)(pw + e * 128 + jb + 4); }
                __builtin_amdgcn_sched_barrier(0);
#pragma unroll
                for (int jj = 0; jj < 8; ++jj) { const float wv = s4[jj >> 2][jj & 3] * w8[jj];
#pragma unroll
                    for (int e = 0; e < 8; ++e) acc8[e] += p4[e][jj >> 2][jj & 3] * wv; }
                __builtin_amdgcn_sched_barrier(0);
            }
            v4u o; o.x = pk2(acc8[0], acc8[1]); o.y = pk2(acc8[2], acc8[3]); o.z = pk2(acc8[4], acc8[5]); o.w = pk2(acc8[6], acc8[7]);
            *(GAS v4u*)((bf16*)(wl + W_BR) + (size_t)d * BR_W + k0) = o; }
    }
}
__device__ __forceinline__ void p0_prologue(Frame& F, const Args& A) {
    LAS float* scr = (LAS float*)(F.lds + RING_OFF + F.wave * 16384);
    const int gw = F.vcu * NWAVES + F.wave, NGW = F.G * NWAVES;
    const int gt = gw * 64 + F.lane, NGT = NGW * 64;
    unsigned char* ws = F.ws;
    p0_weights(F, A, 0, I_IN0, gw, NGW);
    for (int m = gw; m < M_T; m += 2 * NGW) {
        const int m2 = m + NGW < M_T ? m + NGW : m;
        const float* xa = m < M_P ? A.in[I_XP] + (size_t)m * DM : A.in[I_XS] + (size_t)(m - M_P) * DM; const float* xb = m2 < M_P ? A.in[I_XP] + (size_t)m2 * DM : A.in[I_XS] + (size_t)(m2 - M_P) * DM;
        const GAS f32x4* xa4 = (const GAS f32x4*)xa + F.lane; const GAS f32x4* xb4 = (const GAS f32x4*)xb + F.lane;
        f32x4 va[4], vb[4];
#pragma unroll
        for (int j = 0; j < 4; ++j) { va[j] = xa4[64 * j]; vb[j] = xb4[64 * j]; }
        GAS unsigned long long* oa = (GAS unsigned long long*)((bf16*)(ws + WS_XB) + (size_t)m * DM) + F.lane; GAS unsigned long long* ob = (GAS unsigned long long*)((bf16*)(ws + WS_XB) + (size_t)m2 * DM) + F.lane;
#pragma unroll
        for (int j = 0; j < 4; ++j) oa[64 * j] = (unsigned long long)pk2(va[j].x, va[j].y) | ((unsigned long long)pk2(va[j].z, va[j].w) << 32);
#pragma unroll
        for (int j = 0; j < 4; ++j) ob[64 * j] = (unsigned long long)pk2(vb[j].x, vb[j].y) | ((unsigned long long)pk2(vb[j].z, vb[j].w) << 32);
    }
    for (int i = gt; i < SEQ * 8; i += NGT) { const int pos = i >> 3, k = i & 7;
        const double inv = dexp(-(double)k * (13.122363377404328 / 8.0)); double s, c; dsincos((double)pos * inv, s, c);
        float* rp = (float*)(ws + WS_ROPE) + (size_t)pos * 16; rp[k] = (float)c; rp[8 + k] = (float)s; }
    for (int i = gt; i < DEPTH * 2048; i += NGT) { const int l = i >> 11, gp = i & 2047, g = gp >> 6, p = gp & 63;
        unsigned char* sc = ws + WS_SSMC + (size_t)l * SSMC_LSTRIDE;
        const double dt = dexp((double)A.in[I_LOGDT][l * 32 + g]), are = (double)A.in[I_ARE][i], aim = (double)A.in[I_AIM][i];
        const double mag = dexp(are * dt); double sn, cs; dsincos(aim * dt, sn, cs);
        const double abr = mag * cs, abi = mag * sn, den = are * are + aim * aim;
        const double cr = ((abr - 1.0) * are + abi * aim) / den, ci = (abi * are - (abr - 1.0) * aim) / den;
        ((float2*)(sc + SC_AB))[gp] = make_float2((float)abr, (float)abi);
        const double m64 = dexp(are * dt * 64.0); double s64, c64; dsincos(aim * dt * 64.0, s64, c64);
        ((float2*)(sc + SC_A64))[gp] = make_float2((float)(m64 * c64), (float)(m64 * s64));
        bf16* BB = (bf16*)(sc + SC_BB) + (size_t)g * 128 * 16;
#pragma unroll 4
        for (int n = 0; n < 16; ++n) { const double bre = (double)A.in[I_BRE][(size_t)i * 16 + n], bim = (double)A.in[I_BIM][(size_t)i * 16 + n];
            BB[p * 16 + n] = (bf16)f2bf((float)(cr * bre - ci * bim)); BB[(64 + p) * 16 + n] = (bf16)f2bf((float)(cr * bim + ci * bre)); }
    }
    for (int i = gt; i < DEPTH * 32 * 16 * 64; i += NGT) { const int l = i >> 15, r = i & 32767, gn = r >> 6, p = r & 63;
        bf16* CM = (bf16*)(ws + WS_SSMC + (size_t)l * SSMC_LSTRIDE + SC_CM) + (size_t)gn * 128;
        CM[2 * p] = (bf16)f2bf(A.in[I_CRE][i]); CM[2 * p + 1] = (bf16)f2bf(-A.in[I_CIM][i]); }
}

__device__ __forceinline__ float gelu_tanh(float y) {
    const float z = 0.7978845608028654f * (y + 0.044715f * y * y * y);
    const float e = __builtin_amdgcn_exp2f(2.885390081777927f * z);
    const float th = 1.0f - 2.0f * __builtin_amdgcn_rcpf(1.0f + e);
    return 0.5f * y * (1.0f + th);
}
struct SsmGrp { float2 ab; bf16x8 bfr[4]; bf16x8 afr0, afr1; float sre, sim; bf16x8 cfr[4]; float dsk; };
template <bool PASSB> __device__ __forceinline__ SsmGrp ssm_load_group(Frame& F, const Args& A, int l, int ch, int g, bool smp, int row0) {
    const int lane = F.lane, r32 = lane & 31, hi = lane >> 5, fr = lane & 15, fq = lane >> 4;
    const unsigned char* sc = F.ws + WS_SSMC + (size_t)l * SSMC_LSTRIDE;
    const bf16* BB = (const bf16*)(sc + SC_BB); const bf16* CM = (const bf16*)(sc + SC_CM); const bf16* US = (const bf16*)(F.ws + WS_US);
    SsmGrp d;
    d.ab = ((const float2*)(sc + SC_AB))[g * 64 + lane];
#pragma unroll
    for (int cb = 0; cb < 4; ++cb) d.bfr[cb] = *(const bf16x8*)(BB + ((size_t)g * 128 + cb * 32 + r32) * 16 + 8 * hi);
    d.afr0 = *(const bf16x8*)(US + (size_t)(row0 + r32) * 512 + g * 16 + 8 * hi);
    d.afr1 = smp ? d.afr0 : *(const bf16x8*)(US + (size_t)(row0 + 32 + r32) * 512 + g * 16 + 8 * hi);
    d.sre = 0.f; d.sim = 0.f; d.dsk = 0.f;
#pragma unroll
    for (int kb = 0; kb < 4; ++kb) d.cfr[kb] = bf16x8{};
    if (PASSB) {
        if (smp) { const size_t si = ((size_t)(l * NB_S + (ch - NCH_P)) * 32 + g) * 64 + lane; d.sre = A.in[I_SRE][si]; d.sim = A.in[I_SIM][si]; }
        else { const float2 h = ((const float2*)(F.ws + WS_H))[((size_t)ch * 32 + g) * 64 + lane]; d.sre = h.x; d.sim = h.y; }
#pragma unroll
        for (int kb = 0; kb < 4; ++kb) d.cfr[kb] = *(const bf16x8*)(CM + ((size_t)g * 16 + fr) * 128 + kb * 32 + 8 * fq);
        d.dsk = A.in[I_SD][l * 512 + g * 16 + fr];
    }
    return d;
}
template <bool PASSB> __device__ __forceinline__ void ssm_pass(Frame& F, const Args& A, int l) {
    LAS unsigned char* wl = F.lds + RING_OFF + F.wave * 9728;
    LAS unsigned* ST32 = (LAS unsigned*)wl; LAS unsigned short* ST = (LAS unsigned short*)wl; LAS unsigned short* UT = (LAS unsigned short*)(wl + 8704);
    const int lane = F.lane, r32 = lane & 31, hi = lane >> 5, fr = lane & 15, fq = lane >> 4;
    unsigned char* ws = F.ws;
    bf16* VS_ = (bf16*)(ws + WS_VSSM); float2* Eb = (float2*)(ws + WS_E);
    const int nprompt = (NCH_P - F.vcu + F.G - 1) / F.G; const int nsmp = PASSB ? (NB_S * 32 - (F.vcu * NWAVES + F.wave) + F.G * NWAVES - 1) / (F.G * NWAVES) : 0;
#pragma unroll 1
    for (int it = 0; it < nprompt + nsmp; ++it) {
        const bool smp = it >= nprompt; const int sidx = F.vcu * NWAVES + F.wave + (it - nprompt) * F.G * NWAVES;
        const int ch = smp ? NCH_P + (sidx >> 5) : F.vcu + it * F.G; const int row0 = smp ? M_P + (ch - NCH_P) * 32 : ch * 64; const int nhalf = smp ? 1 : 2;
        const int g0 = smp ? (sidx & 31) : F.wave * 4, ng = smp ? 1 : 4;
        SsmGrp cur = ssm_load_group<PASSB>(F, A, l, ch, g0, smp, row0);
#pragma unroll 1
        for (int gi = 0; gi < ng; ++gi) {
            const int g = g0 + gi;
            const SsmGrp nxt = ssm_load_group<PASSB>(F, A, l, ch, g0 + (gi < ng - 1 ? gi + 1 : ng - 1), smp, row0);
            const float2 ab = cur.ab; float sre = cur.sre, sim = cur.sim;
#pragma unroll 1
            for (int hf = 0; hf < nhalf; ++hf) {
                const int rbase = row0 + hf * 32;
                const bf16x8 afr = hf ? cur.afr1 : cur.afr0;
                if (PASSB) *(LAS bf16x8*)(UT + r32 * 16 + 8 * hi) = afr;
                f32x16 c[4];
#pragma unroll
                for (int cb = 0; cb < 4; ++cb) c[cb] = __builtin_amdgcn_mfma_f32_32x32x16_bf16(afr, cur.bfr[cb], (f32x16){}, 0, 0, 0);
#pragma unroll
                for (int i = 0; i < 16; ++i) {
                    { auto rr = __builtin_amdgcn_permlane32_swap(__float_as_uint(c[0][i]), __float_as_uint(c[1][i]), false, false); c[0][i] = __uint_as_float(rr[0]); c[1][i] = __uint_as_float(rr[1]); }
                    { auto rr = __builtin_amdgcn_permlane32_swap(__float_as_uint(c[2][i]), __float_as_uint(c[3][i]), false, false); c[2][i] = __uint_as_float(rr[0]); c[3][i] = __uint_as_float(rr[1]); } }
#pragma unroll
                for (int t = 0; t < 32; ++t) {
                    const int i = (t & 3) + 4 * (t >> 3), h = (t >> 2) & 1;
                    const float bre = c[h][i], bim = c[2 + h][i];
                    float nre = __builtin_fmaf(ab.x, sre, __builtin_fmaf(-ab.y, sim, bre)); asm volatile("" : "+v"(nre));
                    const float nim = __builtin_fmaf(ab.x, sim, __builtin_fmaf(ab.y, sre, bim)); sre = nre; sim = nim;
                    if (PASSB) ST32[t * 68 + lane] = pk2hw(sre, sim);
                }
                if (PASSB) {
#pragma unroll
                    for (int q = 0; q < 2; ++q) {
                        pg8::f32x4 y = {0.f, 0.f, 0.f, 0.f};
#pragma unroll
                        for (int kb = 0; kb < 4; ++kb) { const bf16x8 a = *(const LAS bf16x8*)(ST + (16 * q + fr) * 136 + kb * 32 + 8 * fq); y = __builtin_amdgcn_mfma_f32_16x16x32_bf16(a, cur.cfr[kb], y, 0, 0, 0); }
#pragma unroll
                        for (int j = 0; j < 4; ++j) { const int tok = 16 * q + fq * 4 + j;
                            const float u = __uint_as_float((unsigned)UT[tok * 16 + fr] << 16); UT[tok * 16 + fr] = (unsigned short)f2bf(gelu_tanh(y[j] + cur.dsk * u)); }
                    }
                    { const v4u w = *(const LAS v4u*)(UT + (lane >> 1) * 16 + (lane & 1) * 8); *(GAS v4u*)(VS_ + (size_t)(rbase + (lane >> 1)) * 512 + g * 16 + (lane & 1) * 8) = w; }
                }
            }
            if (!PASSB) Eb[((size_t)ch * 32 + g) * 64 + lane] = make_float2(sre, sim);
            else if (smp) { const size_t oi = ((size_t)(l * NB_S + (ch - NCH_P)) * 32 + g) * 64 + lane; F.out[O_SRS + oi] = sre; F.out[O_SIS + oi] = sim; }
            else if ((ch & 255) == 255) { const size_t oi = ((size_t)(l * NB_P + (ch >> 8)) * 32 + g) * 64 + lane; F.out[O_SRP + oi] = sre; F.out[O_SIP + oi] = sim; }
            cur = nxt;
        }
    }
}
__device__ __forceinline__ void ssm_carry(Frame& F, int l) {
    const int gw = F.vcu * NWAVES + F.wave; if (gw >= NB_P * 32) return;
    const int b = gw >> 5, g = gw & 31;
    const float2 a = ((const float2*)(F.ws + WS_SSMC + (size_t)l * SSMC_LSTRIDE + SC_A64))[g * 64 + F.lane];
    const float2* Eb = (const float2*)(F.ws + WS_E) + ((size_t)b * 256 * 32 + g) * 64 + F.lane; float2* Hb = (float2*)(F.ws + WS_H) + ((size_t)b * 256 * 32 + g) * 64 + F.lane;
    float hr = 0.f, hi_ = 0.f;
    float2 cur[32], nxt[32];
#pragma unroll
    for (int j = 0; j < 32; ++j) cur[j] = Eb[(size_t)j * 2048];
#pragma unroll 1
    for (int c0 = 0; c0 < 256; c0 += 32) {
        if (c0 + 32 < 256) {
#pragma unroll
            for (int j = 0; j < 32; ++j) nxt[j] = Eb[(size_t)(c0 + 32 + j) * 2048]; }
#pragma unroll
        for (int j = 0; j < 32; ++j) { Hb[(size_t)(c0 + j) * 2048] = make_float2(hr, hi_);
            const float nr = a.x * hr - a.y * hi_ + cur[j].x, ni = a.x * hi_ + a.y * hr + cur[j].y; hr = nr; hi_ = ni; }
#pragma unroll
        for (int j = 0; j < 32; ++j) cur[j] = nxt[j];
    }
}

__device__ __forceinline__ void ld8b(const bf16* p, float (&v)[8]) { const v4u w = *(const GAS v4u*)p; v[0] = bfl(w.x); v[1] = bfh(w.x); v[2] = bfl(w.y); v[3] = bfh(w.y); v[4] = bfl(w.z); v[5] = bfh(w.z); v[6] = bfl(w.w); v[7] = bfh(w.w); }
__device__ __forceinline__ void ld8f(const float* p, float (&v)[8]) { const f32x4 a = *(const GAS f32x4*)p, b = *(const GAS f32x4*)(p + 4); v[0] = a.x; v[1] = a.y; v[2] = a.z; v[3] = a.w; v[4] = b.x; v[5] = b.y; v[6] = b.z; v[7] = b.w; }
__device__ __forceinline__ void st8b(bf16* p, const float (&v)[8]) { v4u w; w.x = pk2(v[0], v[1]); w.y = pk2(v[2], v[3]); w.z = pk2(v[4], v[5]); w.w = pk2(v[6], v[7]); *(GAS v4u*)p = w; }
__device__ __forceinline__ void st8f(float* p, const float (&v)[8]) { *(GAS f32x4*)p = (f32x4){v[0], v[1], v[2], v[3]}; *(GAS f32x4*)(p + 4) = (f32x4){v[4], v[5], v[6], v[7]}; }
__device__ __forceinline__ void up8(const v4u w, float (&v)[8]) { v[0] = bfl(w.x); v[1] = bfh(w.x); v[2] = bfl(w.y); v[3] = bfh(w.y); v[4] = bfl(w.z); v[5] = bfh(w.z); v[6] = bfl(w.w); v[7] = bfh(w.w); }
__device__ __forceinline__ v4u ldrow_or_hist(const bf16* cur, const float* hist, bool use_cur, bool use_hist) {
    if (use_cur) return *(const GAS v4u*)cur;
    if (use_hist) { float h[8]; ld8f(hist, h); v4u w; w.x = pk2(h[0], h[1]); w.y = pk2(h[2], h[3]); w.z = pk2(h[4], h[5]); w.w = pk2(h[6], h[7]); return w; }
    return (v4u){0u, 0u, 0u, 0u};
}
template <int W> __device__ __forceinline__ void pool8(const bf16* ZP, const float* hist  , bf16* UP, float* st_out  , int st_t0  ,
                                                       int row0, int t0, bool smp, int c0) {
    v4u zr[W + 7];
#pragma unroll
    for (int k = 0; k < W + 7; ++k) { const int tk = t0 - (W - 1) + k;
        zr[k] = ldrow_or_hist(ZP + (size_t)(row0 - (W - 1) + k) * 512 + c0, hist + (size_t)(15 + tk) * 512 + c0, tk >= 0, smp && tk < 0); }
    float S[8];
#pragma unroll
    for (int e = 0; e < 8; ++e) S[e] = 0.f;
#pragma unroll
    for (int k = 0; k < W - 1; ++k) { float z[8]; up8(zr[k], z);
#pragma unroll
        for (int e = 0; e < 8; ++e) S[e] += z[e]; }
#pragma unroll
    for (int i = 0; i < 8; ++i) { float z[8]; up8(zr[i + W - 1], z);
#pragma unroll
        for (int e = 0; e < 8; ++e) S[e] += z[e];
        const int t = t0 + i; const int cnt = smp ? W : (t + 1 < W ? t + 1 : W); const float inv = 1.0f / (float)cnt;
        float uo[8];
#pragma unroll
        for (int e = 0; e < 8; ++e) uo[e] = S[e] * inv - z[e];
        st8b(UP + (size_t)(row0 + i) * BR_W + c0, uo);
        if (st_out && t >= st_t0) st8f(st_out + (size_t)(t - st_t0) * 512 + c0, z);
        float zo[8]; up8(zr[i], zo);
#pragma unroll
        for (int e = 0; e < 8; ++e) S[e] -= zo[e]; }
}
template <int W> __device__ __forceinline__ void pool8_fast(const bf16* ZP, bf16* UP, float* st_out, int st_t0, int row0, int t0, bool smp, int c0) {
    v4u zr[W + 7];
#pragma unroll
    for (int k = 0; k < W + 7; ++k) { const int rk = row0 - (W - 1) + k; zr[k] = *(const GAS v4u*)(ZP + (size_t)(rk < 0 ? 0 : rk) * 512 + c0); }
#pragma unroll
    for (int k = 0; k < W - 1; ++k) { const bool neg = t0 - (W - 1) + k < 0; zr[k].x = neg ? 0u : zr[k].x; zr[k].y = neg ? 0u : zr[k].y; zr[k].z = neg ? 0u : zr[k].z; zr[k].w = neg ? 0u : zr[k].w; }
    float S[8];
#pragma unroll
    for (int e = 0; e < 8; ++e) S[e] = 0.f;
#pragma unroll
    for (int k = 0; k < W - 1; ++k) { float z[8]; up8(zr[k], z);
#pragma unroll
        for (int e = 0; e < 8; ++e) S[e] += z[e]; }
#pragma unroll
    for (int i = 0; i < 8; ++i) { float z[8]; up8(zr[i + W - 1], z);
#pragma unroll
        for (int e = 0; e < 8; ++e) S[e] += z[e];
        const int t = t0 + i; const int cnt = smp ? W : (t + 1 < W ? t + 1 : W); const float inv = 1.0f / (float)cnt;
        float uo[8];
#pragma unroll
        for (int e = 0; e < 8; ++e) uo[e] = S[e] * inv - z[e];
        st8b(UP + (size_t)(row0 + i) * BR_W + c0, uo);
        if (st_out && t >= st_t0) st8f(st_out + (size_t)(t - st_t0) * 512 + c0, z);
        float zo[8]; up8(zr[i], zo);
#pragma unroll
        for (int e = 0; e < 8; ++e) S[e] -= zo[e]; }
}
__device__ __forceinline__ void mixa_elem(Frame& F, const Args& A, int l) {
    unsigned char* ws = F.ws;
    const bf16* ZP = (const bf16*)(ws + WS_ZP); const bf16* HC = (const bf16*)(ws + WS_HC); const bf16* BC = (const bf16*)(ws + WS_BC); const bf16* CC = (const bf16*)(ws + WS_CC);
    bf16* OALL = (bf16*)(ws + WS_OALL); bf16* UP = OALL;
    const int gi = F.wave & 3, c0 = (gi * 16 + (F.lane & 15)) * 8, rsub = (F.wave >> 2) * 4 + (F.lane >> 4);
    float cw0[8], cw1[8], cw2[8], cbias[8];
    ld8f(A.in[I_CONVW] + (size_t)(l * 3 + 0) * 512 + c0, cw0); ld8f(A.in[I_CONVW] + (size_t)(l * 3 + 1) * 512 + c0, cw1); ld8f(A.in[I_CONVW] + (size_t)(l * 3 + 2) * 512 + c0, cw2); ld8f(A.in[I_CONVB] + (size_t)l * 512 + c0, cbias);
    const int nptile = (M_P / 64 - F.vcu + F.G - 1) / F.G; const int nstile = (64 - F.vcu + F.G - 1) / F.G;
#pragma unroll 1
    for (int it = 0; it < nptile + nstile; ++it) {
        const bool stile = it >= nptile; const int sidx = F.vcu + (it - nptile) * F.G;
        if (stile && F.wave != (sidx & 7)) continue;
        const int tile = stile ? M_P / 64 + (sidx >> 3) : F.vcu + it * F.G;
        const int row0 = tile * 64 + rsub * 8; const bool smp = row0 >= M_P; const int loc = row0 - M_P;
        const int t0 = smp ? (loc & 31) : (row0 & (SEQ - 1)), b = smp ? (loc >> 5) : (row0 >> 14);
        const float* hist = smp ? A.in[I_SPOOL] + (size_t)(l * NB_S + b) * 15 * 512 : nullptr;
        float* st_out = smp ? F.out + O_PS + (size_t)(l * NB_S + b) * 15 * 512 : F.out + O_PP + (size_t)(l * NB_P + b) * 15 * 512;
        const int L = smp ? SEQ_S : SEQ;
        if (t0 + 8 <= L - 15) st_out = nullptr;
        if (smp && t0 < 15) {
            if (gi == 0) pool8<2>(ZP, hist, UP, st_out, L - 15, row0, t0, smp, c0);
            else if (gi == 1) pool8<4>(ZP, hist, UP, st_out, L - 15, row0, t0, smp, c0);
            else if (gi == 2) pool8<8>(ZP, hist, UP, st_out, L - 15, row0, t0, smp, c0);
            else pool8<16>(ZP, hist, UP, st_out, L - 15, row0, t0, smp, c0);
            const float* chist = smp ? A.in[I_SCONV] + (size_t)(l * NB_S + b) * 2 * 512 : nullptr;
            float* cst = smp ? F.out + O_CS + (size_t)(l * NB_S + b) * 2 * 512 : F.out + O_CP + (size_t)(l * NB_P + b) * 2 * 512;
            v4u hr[10], cr[10], br[8];
    #pragma unroll
            for (int k = 0; k < 10; ++k) { const int tk = t0 - 2 + k;
                if (tk >= 0) { hr[k] = *(const GAS v4u*)(HC + (size_t)(row0 - 2 + k) * 512 + c0); cr[k] = *(const GAS v4u*)(CC + (size_t)(row0 - 2 + k) * 512 + c0); }
                else { hr[k] = (v4u){0u, 0u, 0u, 0u}; cr[k] = hr[k]; } }
    #pragma unroll
            for (int k = 0; k < 8; ++k) br[k] = *(const GAS v4u*)(BC + (size_t)(row0 + k) * 512 + c0);
            float z2[8], z1[8];
            {   float h_[8], c_[8];
                if (t0 >= 2 || !smp) { up8(hr[0], h_); up8(cr[0], c_);
    #pragma unroll
                    for (int e = 0; e < 8; ++e) z2[e] = h_[e] * c_[e]; } else ld8f(chist + (size_t)(t0) * 512 + c0, z2);
                if (t0 >= 1 || !smp) { up8(hr[1], h_); up8(cr[1], c_);
    #pragma unroll
                    for (int e = 0; e < 8; ++e) z1[e] = h_[e] * c_[e]; } else ld8f(chist + (size_t)(t0 + 1) * 512 + c0, z1); }
    #pragma unroll
            for (int i = 0; i < 8; ++i) { float h_[8], c_[8], z0[8], bb[8], y[8]; up8(hr[i + 2], h_); up8(cr[i + 2], c_); up8(br[i], bb);
    #pragma unroll
                for (int e = 0; e < 8; ++e) { z0[e] = h_[e] * c_[e]; y[e] = (cbias[e] + z2[e] * cw0[e] + z1[e] * cw1[e] + z0[e] * cw2[e]) * bb[e]; }
                st8b(OALL + (size_t)(row0 + i) * BR_W + 1024 + c0, y);
                const int t = t0 + i; if (t >= L - 2) st8f(cst + (size_t)(t - (L - 2)) * 512 + c0, z0);
    #pragma unroll
                for (int e = 0; e < 8; ++e) { z2[e] = z1[e]; z1[e] = z0[e]; } }
        } else {
            if (gi == 0) pool8_fast<2>(ZP, UP, st_out, L - 15, row0, t0, smp, c0);
            else if (gi == 1) pool8_fast<4>(ZP, UP, st_out, L - 15, row0, t0, smp, c0);
            else if (gi == 2) pool8_fast<8>(ZP, UP, st_out, L - 15, row0, t0, smp, c0);
            else pool8_fast<16>(ZP, UP, st_out, L - 15, row0, t0, smp, c0);
            float* cst = smp ? F.out + O_CS + (size_t)(l * NB_S + b) * 2 * 512 : F.out + O_CP + (size_t)(l * NB_P + b) * 2 * 512;
            v4u hr[10], cr[10], br[8];
#pragma unroll
            for (int k = 0; k < 10; ++k) { const int rk = row0 - 2 + k; const size_t ro = (size_t)(rk < 0 ? 0 : rk) * 512 + c0; hr[k] = *(const GAS v4u*)(HC + ro); cr[k] = *(const GAS v4u*)(CC + ro); }
#pragma unroll
            for (int k = 0; k < 8; ++k) br[k] = *(const GAS v4u*)(BC + (size_t)(row0 + k) * 512 + c0);
#pragma unroll
            for (int k = 0; k < 2; ++k) { const bool neg = t0 - 2 + k < 0; hr[k].x = neg ? 0u : hr[k].x; hr[k].y = neg ? 0u : hr[k].y; hr[k].z = neg ? 0u : hr[k].z; hr[k].w = neg ? 0u : hr[k].w; }
            float z2[8], z1[8];
            {   float h_[8], c_[8]; up8(hr[0], h_); up8(cr[0], c_);
#pragma unroll
                for (int e = 0; e < 8; ++e) z2[e] = h_[e] * c_[e];
                up8(hr[1], h_); up8(cr[1], c_);
#pragma unroll
                for (int e = 0; e < 8; ++e) z1[e] = h_[e] * c_[e]; }
#pragma unroll
            for (int i = 0; i < 8; ++i) { float h_[8], c_[8], z0[8], bb[8], y[8]; up8(hr[i + 2], h_); up8(cr[i + 2], c_); up8(br[i], bb);
#pragma unroll
                for (int e = 0; e < 8; ++e) { z0[e] = h_[e] * c_[e]; y[e] = (cbias[e] + z2[e] * cw0[e] + z1[e] * cw1[e] + z0[e] * cw2[e]) * bb[e]; }
                st8b(OALL + (size_t)(row0 + i) * BR_W + 1024 + c0, y);
                const int t = t0 + i; if (t >= L - 2) st8f(cst + (size_t)(t - (L - 2)) * 512 + c0, z0);
#pragma unroll
                for (int e = 0; e < 8; ++e) { z2[e] = z1[e]; z1[e] = z0[e]; } }
        }
    }
}

__device__ __forceinline__ void diff_subln(Frame& F, const Args& A, int l) {
    const int lane = F.lane; const int gw = F.vcu * NWAVES + F.wave, NGW = F.G * NWAVES;
    const float s1 = wave_sum(A.in[I_LQ1][l * 64 + lane] * A.in[I_LK1][l * 64 + lane]), s2 = wave_sum(A.in[I_LQ2][l * 64 + lane] * A.in[I_LK2][l * 64 + lane]);
    const float lam_init = 0.8f - 0.6f * expf(-0.3f * (float)l);
    const float lam = expf(s1) - expf(s2) + lam_init, coef = 1.0f - lam_init;
    const int h = lane >> 3, e0 = (lane & 7) * 16;
    float sw0[8], sw1[8]; ld8f(A.in[I_SUBLN] + (size_t)l * 128 + e0, sw0); ld8f(A.in[I_SUBLN] + (size_t)l * 128 + e0 + 8, sw1);
    const bf16* OA = (const bf16*)(F.ws + WS_OATT); bf16* OALL = (bf16*)(F.ws + WS_OALL);
    for (int m0 = gw; m0 < M_T; m0 += 4 * NGW) {
        v4u ra[4][4];
#pragma unroll
        for (int r = 0; r < 4; ++r) { int m = m0 + r * NGW; m = m < M_T ? m : m0; const bf16* p1 = OA + (size_t)m * 2048 + (2 * h) * 128 + e0;
            ra[r][0] = *(const GAS v4u*)p1; ra[r][1] = *(const GAS v4u*)(p1 + 8); ra[r][2] = *(const GAS v4u*)(p1 + 128); ra[r][3] = *(const GAS v4u*)(p1 + 136); }
        __builtin_amdgcn_sched_barrier(0);
#pragma unroll
        for (int r = 0; r < 4; ++r) { int m = m0 + r * NGW; m = m < M_T ? m : m0;
            float a0[8], a1[8], b0[8], b1[8]; up8(ra[r][0], a0); up8(ra[r][1], a1); up8(ra[r][2], b0); up8(ra[r][3], b1);
            float ss = 0.f;
#pragma unroll
            for (int e = 0; e < 8; ++e) { a0[e] = a0[e] - lam * b0[e]; a1[e] = a1[e] - lam * b1[e]; ss += a0[e] * a0[e] + a1[e] * a1[e]; }
            ss += swz_xor<1>(ss); ss += swz_xor<2>(ss); ss += swz_xor<4>(ss);
            const float rs = coef / sqrtf(ss * (1.0f / 128.0f) + LN_EPS);
#pragma unroll
            for (int e = 0; e < 8; ++e) { a0[e] = a0[e] * rs * sw0[e]; a1[e] = a1[e] * rs * sw1[e]; }
            bf16* o = OALL + (size_t)m * BR_W + 1536 + h * 128 + e0;
            { v4u w; w.x = pk2hw(a0[0], a0[1]); w.y = pk2hw(a0[2], a0[3]); w.z = pk2hw(a0[4], a0[5]); w.w = pk2hw(a0[6], a0[7]); *(GAS v4u*)o = w; }
            { v4u w; w.x = pk2hw(a1[0], a1[1]); w.y = pk2hw(a1[2], a1[3]); w.z = pk2hw(a1[4], a1[5]); w.w = pk2hw(a1[6], a1[7]); *(GAS v4u*)(o + 8) = w; } }
    }
}

__device__ __forceinline__ void ln_load_row(const void* Yv, bool ybf, int m, int lane, f32x4 (&v)[4]) {
    if (ybf) { const GAS v4u* xr = (const GAS v4u*)((const bf16*)Yv + (size_t)m * DM) + lane;
#pragma unroll
        for (int jj = 0; jj < 2; ++jj) { const v4u w = xr[64 * jj]; v[2 * jj] = (f32x4){bfl(w.x), bfh(w.x), bfl(w.y), bfh(w.y)}; v[2 * jj + 1] = (f32x4){bfl(w.z), bfh(w.z), bfl(w.w), bfh(w.w)}; } }
    else { const GAS f32x4* xr = (const GAS f32x4*)((const float*)Yv + (size_t)m * DM) + 2 * lane;
#pragma unroll
        for (int j = 0; j < 4; ++j) v[j] = xr[128 * (j >> 1) + (j & 1)]; }
}
__device__ __forceinline__ void ln_finish_row(f32x4 (&v)[4], const f32x4 (&g4)[4], const f32x4 (&b4)[4], int m, int lane, float* outf, bf16* outb) {
    float s = 0.f;
#pragma unroll
    for (int j = 0; j < 4; ++j) s += (v[j].x + v[j].y) + (v[j].z + v[j].w);
    const float mean = wave_sum(s) * (1.f / DM); float s2 = 0.f;
#pragma unroll
    for (int j = 0; j < 4; ++j) { v[j] = v[j] - mean; s2 += (v[j].x * v[j].x + v[j].y * v[j].y) + (v[j].z * v[j].z + v[j].w * v[j].w); }
    const float rstd = 1.f / sqrtf(wave_sum(s2) * (1.f / DM) + LN_EPS);
#pragma unroll
    for (int j = 0; j < 4; ++j) { v[j] = v[j] * rstd * g4[j] + b4[j];
        if (outf) ((GAS f32x4*)(outf + (size_t)m * DM))[2 * lane + 128 * (j >> 1) + (j & 1)] = v[j]; }
    if (outb) {
#pragma unroll
        for (int jj = 0; jj < 2; ++jj) { v4u w; w.x = pk2hw(v[2 * jj].x, v[2 * jj].y); w.y = pk2hw(v[2 * jj].z, v[2 * jj].w); w.z = pk2hw(v[2 * jj + 1].x, v[2 * jj + 1].y); w.w = pk2hw(v[2 * jj + 1].z, v[2 * jj + 1].w);
            ((GAS v4u*)(outb + (size_t)m * DM))[lane + 64 * jj] = w; } }
}
__device__ __forceinline__ void ln_rows(Frame& F, const void* Yv, bool ybf, const float* gam, const float* bet, float* outf, bf16* outb) {
    const int gw = F.vcu * NWAVES + F.wave, NGW = F.G * NWAVES;
    f32x4 g4[4], b4[4];
#pragma unroll
    for (int j = 0; j < 4; ++j) { g4[j] = ((const GAS f32x4*)gam)[2 * F.lane + 128 * (j >> 1) + (j & 1)]; b4[j] = ((const GAS f32x4*)bet)[2 * F.lane + 128 * (j >> 1) + (j & 1)]; }
    for (int m = gw; m < M_T; m += 2 * NGW) {
        const int m2 = m + NGW < M_T ? m + NGW : m;
        f32x4 va[4], vb[4];
        ln_load_row(Yv, ybf, m, F.lane, va);
        ln_load_row(Yv, ybf, m2, F.lane, vb);
        ln_finish_row(va, g4, b4, m, F.lane, outf, outb);
        ln_finish_row(vb, g4, b4, m2, F.lane, outf, outb);
    }
}

template <int MODE, int N = DM> __device__ __forceinline__ void skinny_gemm(Frame& F, const bf16* A  , const bf16* Bt, int K, const void* resid  , bool rbf = false, bool ybf = false) {
    const int lane = F.lane, r32 = lane & 31, hi = lane >> 5, w = F.wave;
    LAS float* part = (LAS float*)(F.lds + RING_OFF);
    for (int tile = F.vcu; tile < (M_S / 64) * (N / 32); tile += F.G) {
        const int rb = tile & 7, cb = tile >> 3, row0 = rb * 64, col0 = cb * 32;
        int ks0, nks;
        if (MODE == 1) { ks0 = w < 6 ? w * 16 : 96 + (w - 6) * 32; nks = w < 6 ? 16 : 32; }
        else { nks = K / 128; ks0 = w * nks; }
        const bf16* a0 = A + (size_t)(row0 + r32) * K + ks0 * 16 + 8 * hi; const bf16* a1 = a0 + (size_t)32 * K; const bf16* bp = Bt + (size_t)(col0 + r32) * K + ks0 * 16 + 8 * hi;
        f32x16 acc0 = {}, acc1 = {};
        bf16x8 pa0[4], pa1[4], pb[4], qa0[4], qa1[4], qb_[4];
#define SK_LOAD(X0, X1, XB, kk) do { _Pragma("unroll") for (int u = 0; u < 4; ++u) { X0[u] = *(const bf16x8*)(a0 + ((kk) + u) * 16); X1[u] = *(const bf16x8*)(a1 + ((kk) + u) * 16); XB[u] = *(const bf16x8*)(bp + ((kk) + u) * 16); } } while (0)
#define SK_MMA(X0, X1, XB) do { _Pragma("unroll") for (int u = 0; u < 4; ++u) { acc0 = __builtin_amdgcn_mfma_f32_32x32x16_bf16(X0[u], XB[u], acc0, 0, 0, 0); acc1 = __builtin_amdgcn_mfma_f32_32x32x16_bf16(X1[u], XB[u], acc1, 0, 0, 0); } } while (0)
        SK_LOAD(pa0, pa1, pb, 0);
#pragma unroll 1
        for (int k = 0; k < nks; k += 8) {
            const bool two = k + 4 < nks;
            if (two) SK_LOAD(qa0, qa1, qb_, k + 4);
            SK_MMA(pa0, pa1, pb);
            if (k + 8 < nks) SK_LOAD(pa0, pa1, pb, k + 8);
            if (two) SK_MMA(qa0, qa1, qb_);
        }
#undef SK_LOAD
#undef SK_MMA
        LAS float* mine = part + w * 2048;
#pragma unroll
        for (int r = 0; r < 16; ++r) { const int row = (r & 3) + 8 * (r >> 2) + 4 * hi; mine[row * 32 + r32] = acc0[r]; mine[(32 + row) * 32 + r32] = acc1[r]; }
        __syncthreads();
        {
            const int row = 8 * w + (lane >> 3), c4 = (lane & 7) * 4; const int grow = row0 + row, gcol = col0 + c4;
            f32x4 sum = {0.f, 0.f, 0.f, 0.f};
            if (MODE == 1) {
                const bf16* gp = (const bf16*)(F.ws + WS_G) + (size_t)(M_P + grow) * 4096 + gcol;
#pragma unroll
                for (int b = 0; b < 4; ++b) { const unsigned long long gw = *(const GAS unsigned long long*)(gp + b * 1024);
                    const f32x4 gv = {bfl((unsigned)gw), bfh((unsigned)gw), bfl((unsigned)(gw >> 32)), bfh((unsigned)(gw >> 32))};
                    const f32x4 pb = *(const LAS f32x4*)(part + (2 * b) * 2048 + row * 32 + c4) + *(const LAS f32x4*)(part + (2 * b + 1) * 2048 + row * 32 + c4);
                    sum += gv * pb; }
                *(GAS unsigned long long*)((bf16*)(F.ws + WS_MG) + (size_t)(M_P + grow) * 1024 + gcol) = (unsigned long long)pk2(sum.x, sum.y) | ((unsigned long long)pk2(sum.z, sum.w) << 32);
            } else if (MODE == 3) {
#pragma unroll
                for (int ww = 0; ww < 8; ++ww) sum += *(const LAS f32x4*)(part + ww * 2048 + row * 32 + c4);
                const unsigned long long vw = *(const GAS unsigned long long*)((const bf16*)(F.ws + WS_VSSM) + (size_t)(M_P + grow) * 512 + gcol);
                const f32x4 vv = {bfl((unsigned)vw), bfh((unsigned)vw), bfl((unsigned)(vw >> 32)), bfh((unsigned)(vw >> 32))};
#pragma unroll
                for (int e = 0; e < 4; ++e) sum[e] = vv[e] * pg8::fast_sigmoid(sum[e]);
                *(GAS unsigned long long*)((bf16*)(F.ws + WS_OALL) + (size_t)(M_P + grow) * BR_W + 512 + gcol) = (unsigned long long)pk2(sum.x, sum.y) | ((unsigned long long)pk2(sum.z, sum.w) << 32);
            } else if (MODE == 2) {
#pragma unroll
                for (int ww = 0; ww < 8; ++ww) sum += *(const LAS f32x4*)(part + ww * 2048 + row * 32 + c4);
#pragma unroll
                for (int e = 0; e < 4; ++e) { const float a = fmaxf(sum[e], 0.f); sum[e] = a * a; }
                *(GAS unsigned long long*)((bf16*)(F.ws + WS_G) + (size_t)(M_P + grow) * N + gcol) = (unsigned long long)pk2(sum.x, sum.y) | ((unsigned long long)pk2(sum.z, sum.w) << 32);
            } else {
#pragma unroll
                for (int ww = 0; ww < 8; ++ww) sum += *(const LAS f32x4*)(part + ww * 2048 + row * 32 + c4);
                f32x4 rv; if (rbf) { const unsigned long long w = *(const GAS unsigned long long*)((const bf16*)resid + (size_t)grow * 1024 + gcol); rv = (f32x4){bfl((unsigned)w), bfh((unsigned)w), bfl((unsigned)(w >> 32)), bfh((unsigned)(w >> 32))}; }
                else rv = *(const GAS f32x4*)((const float*)resid + (size_t)grow * 1024 + gcol);
                const f32x4 y = rv * DN_ALPHA + sum;
                if (ybf) *(GAS unsigned long long*)((bf16*)(F.ws + WS_YF) + (size_t)(M_P + grow) * 1024 + gcol) = (unsigned long long)pk2(y.x, y.y) | ((unsigned long long)pk2(y.z, y.w) << 32);
                else *(GAS f32x4*)((float*)(F.ws + WS_YF) + (size_t)(M_P + grow) * 1024 + gcol) = y;
            }
        }
        __syncthreads();
    }
}

__device__ __forceinline__ void attn_all(Frame& F, const Args& A, int l, char* lds_generic) {
    using abf = attn_body::bf16;
    const abf* Q = (const abf*)(F.ws + WS_Q); const abf* K = (const abf*)(F.ws + WS_K); const abf* V = (const abf*)(F.ws + WS_V);
    const abf* KS = (const abf*)(F.ws + WS_KS); const abf* VS = (const abf*)(F.ws + WS_VS); abf* OA = (abf*)(F.ws + WS_OATT);
#if ATTN_DV128
    constexpr int NU_P = NB_P * 16 * 64, NU_S = NB_S * 16;
    const bool bal = (F.G == 256);
    const int nmine = bal ? 8 + REP_SAMPLE : (NU_P + NU_S - F.vcu + F.G - 1) / F.G;
    struct AU { int mode, NT; const abf* Q; const abf* Kh; const abf* Vh; abf* O; const float* Kc; const float* Vc; };
    auto mk = [&](int i) -> AU {
        int mode, b, ph, qb = 0;
        if (bal) {
            const int spos = F.vcu % 9, ip = i < spos ? i : i - REP_SAMPLE;
            if (i < spos || i >= spos + REP_SAMPLE) { mode = 0; const int bp = F.vcu >> 3, s = F.vcu & 7, j = ip >> 1; b = bp >> 4; ph = bp & 15; qb = (ip & 1) ? s + 8 * j : 63 - s - 8 * j; }
            else { mode = 1; b = F.vcu >> 4; ph = F.vcu & 15; }
        } else {
            const int u = F.vcu + i * F.G;
            if (u < NU_P) { mode = 0; const int bp = u >> 6; qb = 63 - (u & 63); b = bp >> 4; ph = bp & 15; }
            else { mode = 1; const int su = u - NU_P; b = su >> 4; ph = su & 15; }
        }
        const size_t qrow = mode == 0 ? (size_t)b * SEQ + (size_t)qb * 256 : (size_t)M_P + (size_t)b * SEQ_S;
        AU u_;
        u_.mode = mode; u_.NT = mode == 0 ? 4 * (qb + 1) : KS_ROWS / 64;
        u_.Kh = (mode == 0 && KT_K) ? K + ((size_t)(b * 16 + ph) * 256) * 4096 : (mode == 0 ? K + (size_t)b * SEQ * 1024 : KS + (size_t)b * KS_ROWS * 1024) + ph * 64;
        u_.Vh = (mode == 0 && KT_V) ? V + ((size_t)(b * 8 + (ph >> 1)) * 256) * 8192 : (mode == 0 ? V + (size_t)b * SEQ * 1024 : VS + (size_t)b * KS_ROWS * 1024) + (ph >> 1) * 128;
        u_.Kc = mode == 0 ? nullptr : A.in[I_CK] + ((size_t)(l * NB_S + b) * PAST) * 1024 + ph * 64;
        u_.Vc = mode == 0 ? nullptr : A.in[I_CV] + ((size_t)(l * NB_S + b) * PAST) * 1024 + (ph >> 1) * 128;
        u_.Q = Q + qrow * 1024 + ph * 64; u_.O = OA + qrow * 2048 + ph * 128;
        return u_;
    };
    AU cur = mk(0); bool pre = false;
#pragma unroll 1
    for (int i = 0; i < nmine; ++i) {
        const bool hasn = i + 1 < nmine; const AU nx = mk(hasn ? i + 1 : i);
        const bool pfN = hasn && cur.mode == 0 && nx.mode == 0 && KT_K && KT_V;
        attn_body::attn_unit<8>(cur.mode, cur.NT, cur.Q, cur.Kh, cur.Vh, cur.O, lds_generic, cur.Kc, cur.Vc, F.tid, pre, pfN, nx.Kh, nx.Vh);
        pre = pfN; cur = nx;
    }
}
#else
    constexpr int NU_P = NB_P * 32 * 64, NU_S = NB_S * 32;
    const bool bal = (F.G == 256);
    const int nmine = bal ? 18 : (NU_P + NU_S - F.vcu + F.G - 1) / F.G;
    for (int i = 0; i < nmine; ++i) {
        int mode, b, vhd, qb = 0;
        if (bal) {
            if (i < 16) { mode = 0; const int bv = F.vcu >> 2, s = F.vcu & 3, j = i >> 1; b = bv >> 5; vhd = bv & 31; qb = (i & 1) ? s + 4 * j : 63 - s - 4 * j; }
            else { mode = 1; const int su = F.vcu + 256 * (i - 16); b = su >> 5; vhd = su & 31; }
        } else {
            const int u = F.vcu + i * F.G;
            if (u < NU_P) { mode = 0; const int bv = u >> 6; qb = 63 - (u & 63); b = bv >> 5; vhd = bv & 31; }
            else { mode = 1; const int su = u - NU_P; b = su >> 5; vhd = su & 31; }
        }
        const int ph = vhd >> 1, vh = vhd & 1;
        const size_t qrow = mode == 0 ? (size_t)b * SEQ + (size_t)qb * 256 : (size_t)M_P + (size_t)b * SEQ_S;
        const abf* Kh = (mode == 0 ? K + (size_t)b * SEQ * 1024 : KS + (size_t)b * KS_ROWS * 1024) + ph * 64;
        const abf* Vh = (mode == 0 ? V + (size_t)b * SEQ * 1024 : VS + (size_t)b * KS_ROWS * 1024) + (ph >> 1) * 128 + vh * 64;
        const int NT = mode == 0 ? 4 * (qb + 1) : KS_ROWS / 64;
        attn_body::attn_unit<8>(mode, NT, Q + qrow * 1024 + ph * 64, Kh, Vh, OA + qrow * 2048 + ph * 128 + vh * 64, lds_generic);
    }
}
#endif

__device__ __forceinline__ int grid_bar(const XcdBarrier& bar, int wave) { XcdBarrier b = bar; b.tid = wave * 64 + lane_id(); xcd_barrier(b); return 1; }
#ifndef REP_SK
#define REP_SK 1
#endif
#if REP_SK > 1
#define REP_SKLOOP _Pragma("unroll 1") for (int rs_ = 0; rs_ < REP_SK; ++rs_)
#else
#define REP_SKLOOP
#endif
__global__ void __launch_bounds__(NWAVES * 64, 2) hse_fwd(Args args) {
    extern __shared__ __attribute__((aligned(16))) unsigned char lds[];
    Frame F;
    F.lds = (LAS unsigned char*)lds;
    F.MISC = (volatile LAS unsigned*)(F.lds + MISC_OFF);
    F.tid = threadIdx.x; F.lane = F.tid & 63; F.wave = __builtin_amdgcn_readfirstlane(F.tid >> 6);
    F.G = gridDim.x; { const int bx = blockIdx.x; F.vcu = (F.G % 8 == 0) ? (bx % 8) * (F.G / 8) + bx / 8 : bx; }
    F.out = args.out; F.ws = args.ws; F.ctl = (gu32*)(args.ws + WS_CTL);
    for (int u = F.tid; u < (LDS_BYTES - LDSCTL_OFF) / 4; u += NWAVES * 64) ((LAS unsigned*)(F.lds + LDSCTL_OFF))[u] = 0u;
    __syncthreads();
    XcdBarrier bar; bar.bar = (unsigned*)(F.ctl + CW_BAR); bar.x = 0; bar.st = nullptr; bar.tid = 0;
#if MK_ONE_LAUNCH
    bar = xcd_barrier_post((unsigned*)(F.ctl + CW_BAR), F.MISC + 8);
#define GRID_BAR() grid_bar(bar, F.wave)
#else
#define GRID_BAR() do { if (F.tid == 0) __hip_atomic_store(F.ctl + CW_TMO, 0xBADBA0u, RLX_AGENT); } while (0)
#endif
    const int lo = args.ph_lo, hi = args.ph_hi;
#define IN(k) (lo <= (k) && (k) < hi)
#define SEAM(k) do { if (IN(k) && IN((k) + 1)) GRID_BAR(); } while (0)
#if MK_ONE_LAUNCH
#define REPEAT(N) _Pragma("unroll 1") for (int rp_ = 0; rp_ < (N); ++rp_) for (int once_ = (rp_ > 0 ? grid_bar(bar, F.wave) : 1); once_; once_ = 0)
#else
#define REPEAT(N)
#endif
#define PHASE_ENTER() Frame P = F; unsigned char* ws; { int t_ = F.wave * 64 + lane_id(); asm volatile("" : "+v"(t_)); P.tid = t_; P.lane = t_ & 63; P.wave = F.wave; \
        GAS unsigned char* w_ = (GAS unsigned char*)args.ws; asm volatile("" : "+s"(w_)); ws = (unsigned char*)w_; P.ws = ws; GAS float* o_ = (GAS float*)args.out; asm volatile("" : "+s"(o_)); P.out = (float*)o_; } \
        unsigned char* wl = ws + WS_W + (size_t)l * W_LSTRIDE; (void)wl

    { const int l = 0; if (IN(0)) { PHASE_ENTER(); p0_prologue(P, args); } } SEAM(0);

    for (int l = 0; l < DEPTH; ++l) {
        const int pb = 1 + l * PH_PER_LAYER;
        if (IN(pb + P_WIN)) { PHASE_ENTER();
            pg8::Gemm g{(const bf16*)(ws + WS_XB), (const bf16*)(wl + W_IN), M_T, N_IN, DM}; typedef pg8::StaticOrderT<M_T / 256, N_IN / 256> SO; SO S; S.init(M_T, N_IN, P.G, (int)blockIdx.x); S.tid = P.tid;
            pg8::EpiWin E{ws, P.out, l, attn_body::C2};
            pg8::gemm_phase<pg8::EpiWin, SO, true, true>(P.lds + RING_OFF, g, S, E);
            if (l == 0) {
                constexpr int NU = (M_T / 256) * (N_IN / 256); const int rounds = (NU + P.G - 1) / P.G, nlast = NU - (rounds - 1) * P.G;
                const int bx = (int)blockIdx.x;
                if (nlast >= P.G) p0_weights(P, args, I_IN0, 1 << 30, bx * NWAVES + P.wave, P.G * NWAVES);
                else if (bx >= nlast) p0_weights(P, args, I_IN0, 1 << 30, (bx - nlast) * NWAVES + P.wave, (P.G - nlast) * NWAVES);
            }
        }
        SEAM(pb + P_WIN);
        if (IN(pb + P_MIXA)) { PHASE_ENTER(); ssm_pass<false>(P, args, l); mixa_elem(P, args, l); }
        SEAM(pb + P_MIXA);
        if (IN(pb + P_ATTN)) { PHASE_ENTER(); ssm_carry(P, l); attn_all(P, args, l, (char*)lds + RING_OFF); }
#if REP_ATTN > 1
        GRID_BAR(); if (IN(pb + P_ATTN)) { PHASE_ENTER(); attn_all(P, args, l, (char*)lds + RING_OFF); }
#endif
        SEAM(pb + P_ATTN);
        if (IN(pb + P_MIXC)) { PHASE_ENTER(); ssm_pass<true>(P, args, l); diff_subln(P, args, l); }
        SEAM(pb + P_MIXC);
        if (IN(pb + P_PG)) { PHASE_ENTER();
            pg8::Gemm g{(const bf16*)(ws + WS_VSSM), (const bf16*)(wl + W_GLU), M_P, 512, 512}; typedef pg8::StaticOrderT<M_P / 256, 2> SO; SO S; S.init(M_P, 512, P.G, (int)blockIdx.x); S.tid = P.tid;
            pg8::EpiGlu E{ws};
            pg8::gemm_phase<pg8::EpiGlu, SO, true, true>(P.lds + RING_OFF, g, S, E);
            REP_SKLOOP skinny_gemm<3, 512>(P, (const bf16*)(ws + WS_VSSM) + (size_t)M_P * 512, (const bf16*)(wl + W_GLU), 512, nullptr);
        }
        SEAM(pb + P_PG);
        if (IN(pb + P_MERGE)) { PHASE_ENTER();
            pg8::Gemm g{(const bf16*)(ws + WS_OALL), (const bf16*)(wl + W_BR), M_P, DM, BR_W}; typedef pg8::StaticOrderT<M_P / 256, DM / 256> SO; SO S; S.init(M_P, DM, P.G, (int)blockIdx.x); S.tid = P.tid;
            pg8::EpiMerge E{ws, P.tid};
            pg8::gemm_phase<pg8::EpiMerge, SO, true, true>(P.lds + RING_OFF, g, S, E);
            REP_SKLOOP skinny_gemm<1>(P, (const bf16*)(ws + WS_OALL) + (size_t)M_P * BR_W, (const bf16*)(wl + W_BR), BR_W, nullptr);
        }
        SEAM(pb + P_MERGE);
        if (IN(pb + P_OUT)) { PHASE_ENTER();
            pg8::Gemm g{(const bf16*)(ws + WS_MG), (const bf16*)(wl + W_OUT), M_P, DM, DM}; typedef pg8::StaticOrderT<M_P / 256, DM / 256> SO; SO S; S.init(M_P, DM, P.G, (int)blockIdx.x); S.tid = P.tid;
            const void* rs = l == 0 ? (const void*)args.in[I_XS] : (const void*)((const bf16*)(ws + WS_XB) + (size_t)M_P * DM);
            pg8::EpiResid E{(const pg8::bf16_t*)(ws + WS_XB), ws, 1};
            pg8::gemm_phase<pg8::EpiResid, SO, true, true>(P.lds + RING_OFF, g, S, E);
            REP_SKLOOP skinny_gemm<0>(P, (const bf16*)(ws + WS_MG) + (size_t)M_P * DM, (const bf16*)(wl + W_OUT), DM, rs, l != 0, true);
        }
        SEAM(pb + P_OUT);
        if (IN(pb + P_LN1)) { PHASE_ENTER(); ln_rows(P, (const void*)(ws + WS_YF), true, args.in[I_LN1G] + (size_t)l * DM, args.in[I_LN1B] + (size_t)l * DM, nullptr, (bf16*)(ws + WS_XMB)); }
        SEAM(pb + P_LN1);
        if (IN(pb + P_UP)) { PHASE_ENTER();
            pg8::Gemm g{(const bf16*)(ws + WS_XMB), (const bf16*)(wl + W_UP), M_T, D_FF, DM}; typedef pg8::StaticOrderT<M_T / 256, D_FF / 256> SO; SO S; S.init(M_T, D_FF, P.G, (int)blockIdx.x); S.tid = P.tid;
            pg8::EpiUp E{ws};
            pg8::gemm_phase<pg8::EpiUp, SO, true, true>(P.lds + RING_OFF, g, S, E);
        }
        SEAM(pb + P_UP);
        if (IN(pb + P_DOWN)) { PHASE_ENTER();
            pg8::Gemm g{(const bf16*)(ws + WS_G), (const bf16*)(wl + W_DN), M_P, DM, D_FF}; typedef pg8::StaticOrderT<M_P / 256, DM / 256> SO; SO S; S.init(M_P, DM, P.G, (int)blockIdx.x); S.tid = P.tid;
            pg8::EpiResid E{(const pg8::bf16_t*)(ws + WS_XMB), ws, l + 1 < DEPTH ? 1 : 0};
            pg8::gemm_phase<pg8::EpiResid, SO, true, true>(P.lds + RING_OFF, g, S, E);
            REP_SKLOOP skinny_gemm<0>(P, (const bf16*)(ws + WS_G) + (size_t)M_P * D_FF, (const bf16*)(wl + W_DN), D_FF, (const bf16*)(ws + WS_XMB) + (size_t)M_P * DM, true, l + 1 < DEPTH);
        }
        SEAM(pb + P_DOWN);
        if (IN(pb + P_LN2)) { PHASE_ENTER();
            if (l + 1 < DEPTH) ln_rows(P, (const void*)(ws + WS_YF), true, args.in[I_LN2G] + (size_t)l * DM, args.in[I_LN2B] + (size_t)l * DM, nullptr, (bf16*)(ws + WS_XB));
            else ln_rows(P, (const void*)(ws + WS_YF), false, args.in[I_LN2G] + (size_t)l * DM, args.in[I_LN2B] + (size_t)l * DM, P.out + O_YP, nullptr);
        }
        SEAM(pb + P_LN2);
    }
#undef IN
#undef SEAM
}

extern "C" void kernel_launch(void* const* d_in, const int* in_sizes, int n_in, void* d_out, int out_size, void* d_ws, size_t ws_size, hipStream_t stream) {
    static int grid = 0;
    if (grid == 0) {
        if (n_in != 35 || (size_t)out_size != O_END || ws_size < WS_END) { fprintf(stderr, "kernel_launch: unexpected shapes: n_in %d out %d (want %zu) ws %zu (want %zu)\n", n_in, out_size, (size_t)O_END, ws_size, (size_t)WS_END); grid = -1; return; }
        int dev = 0, cus = 0, per_cu = 0;
        if (hipGetDevice(&dev) != hipSuccess || hipDeviceGetAttribute(&cus, hipDeviceAttributeMultiprocessorCount, dev) != hipSuccess) { grid = -1; return; }
        if (hipFuncSetAttribute((const void*)hse_fwd, hipFuncAttributeMaxDynamicSharedMemorySize, LDS_BYTES) != hipSuccess) { fprintf(stderr, "kernel_launch: hipFuncSetAttribute failed\n"); grid = -1; return; }
        if (hipOccupancyMaxActiveBlocksPerMultiprocessor(&per_cu, (const void*)hse_fwd, NWAVES * 64, LDS_BYTES) != hipSuccess || per_cu < 1) fprintf(stderr, "kernel_launch: occupancy query reports %d\n", per_cu);
        (void)hipGetLastError();
        grid = cus;
    }
    if (grid < 0) return;
    (void)hipMemsetAsync((char*)d_ws + WS_CTL, 0, CTL_ZERO_BYTES, stream);
    Args a{};
    for (int i = 0; i < 35; ++i) a.in[i] = (const float*)d_in[i];
    a.out = (float*)d_out; a.ws = (unsigned char*)d_ws; a.pad = 0;
#if MK_ONE_LAUNCH
    a.ph_lo = 0; a.ph_hi = NPH; a.li = 0;
    hipLaunchKernelGGL(hse_fwd, dim3(grid), dim3(NWAVES * 64), LDS_BYTES, stream, a);
#else
    for (int p = 0; p < NPH; ++p) { a.ph_lo = p; a.ph_hi = p + 1; a.li = p; hipLaunchKernelGGL(hse_fwd, dim3(grid), dim3(NWAVES * 64), LDS_BYTES, stream, a); }
#endif
}
```
